# Optimizing an MI355X kernel written in HIP

```python
import jax
import jax.numpy as jnp
from jax import lax
import numpy as np

D_MODEL = 1024
BATCH = 4
SEQ = 4096
DEPTH = 2

D_FF = 2816
RWKV_HEADS = 8
RWKV_HEAD_DIM = 64
RWKV_WIDTH = RWKV_HEADS * RWKV_HEAD_DIM
RWKV_DECAY_RANK = 32
RWKV_A_RANK = 32
RWKV_GATE_RANK = 96
MLSTM_HEADS = 4
MLSTM_HEAD_DIM = 128
MLSTM_WIDTH = MLSTM_HEADS * MLSTM_HEAD_DIM
MLSTM_CONV = 4
MLSTM_CHUNK = 128
RWKV_COLS = 3 * RWKV_WIDTH + RWKV_DECAY_RANK + RWKV_A_RANK + RWKV_GATE_RANK
MLSTM_COLS = 4 * MLSTM_WIDTH + 2 * MLSTM_HEADS
GATE_COLS = 2 * D_MODEL
N_IN = RWKV_COLS + MLSTM_COLS + GATE_COLS
RMS_EPS = 1e-6
RWKV_GN_EPS = 64e-5
MLSTM_NORM_EPS = 1e-5
L2_EPS = 1e-12

kernel_name = 'hybrid_rwkv7_mlstm_macaron_adaln'


def rms_norm(x, g):
    xf = x.astype(jnp.float32)
    y = xf * lax.rsqrt(jnp.mean(xf * xf, axis=-1, keepdims=True) + RMS_EPS)
    return (y * g.astype(jnp.float32)).astype(x.dtype)


def modulate(h, shift, scale):
    return h * (1 + scale[:, None, :]) + shift[:, None, :]


def swiglu(h, w_in, w_out):
    gate, up = jnp.split(h @ w_in, 2, axis=-1)
    return (jax.nn.silu(gate) * up) @ w_out


def head_norm(y, eps):
    mu = jnp.mean(y, axis=-1, keepdims=True)
    yc = y - mu
    return yc * lax.rsqrt(jnp.mean(yc * yc, axis=-1, keepdims=True) + eps)


def causal_depthwise_conv(x, w, b):
    width, chans = w.shape
    y = lax.conv_general_dilated(x, w[:, None, :], window_strides=(1,), padding=[(width - 1, 0)],
                                 dimension_numbers=('NWC', 'WIO', 'NWC'), feature_group_count=chans)
    return y + b


def rwkv7_recurrence(r, w, k, v, a, b):
    bsz, _, heads, n = r.shape

    def step(s, inp):
        r_t, w_t, k_t, v_t, a_t, b_t = inp
        sa = jnp.einsum('bhvk,bhk->bhv', s, a_t)
        s = s * w_t[:, :, None, :] + sa[..., None] * b_t[:, :, None, :] + v_t[..., None] * k_t[:, :, None, :]
        return s, jnp.einsum('bhvk,bhk->bhv', s, r_t)

    xs = tuple(jnp.moveaxis(t, 1, 0) for t in (r, w, k, v, a, b))
    s0 = jnp.zeros((bsz, heads, n, n), jnp.float32)
    _, y = lax.scan(step, s0, xs)
    return jnp.moveaxis(y, 0, 1)


def rwkv7_branch(p, mu, w0, w_up, a0, a_up, g_up, k_k, k_a, r_k, ln_g, ln_b):
    bsz, t_len, _ = p.shape
    hd = (bsz, t_len, RWKV_HEADS, RWKV_HEAD_DIM)
    pf = p.astype(jnp.float32)
    prev = jnp.pad(pf, ((0, 0), (1, 0), (0, 0)))[:, :-1]
    pf = pf + (prev - pf) * mu
    o1 = RWKV_WIDTH
    o4 = 3 * o1 + RWKV_DECAY_RANK
    o5 = o4 + RWKV_A_RANK
    r, k, v, w_lo, a_lo, g_lo = jnp.split(pf, [o1, 2 * o1, 3 * o1, o4, o5], axis=-1)
    w = w0 + jnp.tanh(w_lo) @ w_up
    w = -jax.nn.softplus(-w) - 0.5
    decay = jnp.exp(-jnp.exp(w))
    a = jax.nn.sigmoid(a0 + a_lo @ a_up)
    g = jax.nn.sigmoid(g_lo) @ g_up
    kk = (k * k_k).reshape(hd)
    kk = kk / jnp.maximum(jnp.sqrt(jnp.sum(kk * kk, axis=-1, keepdims=True)), L2_EPS)
    k = k * (1 + (a - 1) * k_a)
    r, k, v, decay, a = (t.reshape(hd) for t in (r, k, v, decay, a))
    y = rwkv7_recurrence(r, decay, k, v, -kk, kk * a)
    y = head_norm(y, RWKV_GN_EPS).reshape(bsz, t_len, RWKV_WIDTH) * ln_g + ln_b
    bonus = (jnp.sum(r * k * r_k, axis=-1, keepdims=True) * v).reshape(bsz, t_len, RWKV_WIDTH)
    return (y + bonus) * g


def mlstm_branch(p, conv_w, conv_b, gate_b, ln_g):
    bsz, t_len, _ = p.shape
    nh, dh, blk = MLSTM_HEADS, MLSTM_HEAD_DIM, MLSTM_CHUNK
    nc = t_len // blk
    wd = MLSTM_WIDTH
    pf = p.astype(jnp.float32)
    qk, v, o, gates = jnp.split(pf, [2 * wd, 3 * wd, 4 * wd], axis=-1)
    qk = jax.nn.silu(causal_depthwise_conv(qk, conv_w.astype(jnp.float32), conv_b))
    q, k = jnp.split(qk, 2, axis=-1)
    i_pre, f_pre = jnp.split(gates + gate_b, 2, axis=-1)

    def chunks(t):
        t = t.reshape((bsz, nc, blk, nh) + t.shape[3:])
        return jnp.moveaxis(t, 3, 1)

    q = chunks(q.reshape(bsz, t_len, nh, dh)) * dh ** -0.5
    k = chunks(k.reshape(bsz, t_len, nh, dh))
    v = chunks(v.reshape(bsz, t_len, nh, dh))
    log_i = chunks(i_pre)
    log_f = jax.nn.log_sigmoid(chunks(f_pre))
    b = jnp.cumsum(log_f, axis=-1)
    b_end = b[..., -1]
    causal = jnp.tril(jnp.ones((blk, blk), dtype=bool))
    d = jnp.where(causal, b[..., :, None] - b[..., None, :] + log_i[..., None, :], -jnp.inf)
    g_end = b_end[..., None] - b + log_i

    def step(carry, inp):
        c_st, n_st, m_st = carry
        k_c, v_c, g_c, be = inp
        m_new = jnp.maximum(be + m_st, jnp.max(g_c, axis=-1))
        keep = jnp.exp(be + m_st - m_new)
        wgt = jnp.exp(g_c - m_new[..., None])
        c_new = keep[..., None, None] * c_st + jnp.einsum('bhl,bhld,bhle->bhde', wgt, k_c, v_c)
        n_new = keep[..., None] * n_st + jnp.einsum('bhl,bhld->bhd', wgt, k_c)
        return (c_new, n_new, m_new), (c_st, n_st, m_st)

    init = (jnp.zeros((bsz, nh, dh, dh), jnp.float32), jnp.zeros((bsz, nh, dh), jnp.float32),
            jnp.full((bsz, nh), -jnp.inf, jnp.float32))
    xs = (jnp.moveaxis(k, 2, 0), jnp.moveaxis(v, 2, 0), jnp.moveaxis(g_end, 2, 0), jnp.moveaxis(b_end, 2, 0))
    _, (c_prev, n_prev, m_prev) = lax.scan(step, init, xs)
    c_prev = jnp.moveaxis(c_prev, 0, 2)
    n_prev = jnp.moveaxis(n_prev, 0, 2)
    m_prev = jnp.moveaxis(m_prev, 0, 2)
    m_inter = b + m_prev[..., None]
    m_t = jnp.maximum(m_inter, jnp.max(d, axis=-1))
    scores = jnp.einsum('bhcld,bhcsd->bhcls', q, k) * jnp.exp(d - m_t[..., None])
    inter = jnp.exp(m_inter - m_t)
    num = jnp.einsum('bhcls,bhcse->bhcle', scores, v) + inter[..., None] * jnp.einsum('bhcld,bhcde->bhcle', q, c_prev)
    den = jnp.sum(scores, axis=-1) + inter * jnp.einsum('bhcld,bhcd->bhcl', q, n_prev)
    h = num / jnp.maximum(jnp.abs(den), jnp.exp(-m_t))[..., None]
    h = jnp.moveaxis(h, 1, 3).reshape(bsz, t_len, nh, dh)
    h = head_norm(h, MLSTM_NORM_EPS).reshape(bsz, t_len, wd) * ln_g
    return jax.nn.sigmoid(o) * h


def token_mixer(h, w_in, rwkv_mu, rwkv_w0, rwkv_w_up, rwkv_a0, rwkv_a_up, rwkv_g_up, rwkv_k_k, rwkv_k_a,
                rwkv_r_k, rwkv_ln_g, rwkv_ln_b, mlstm_conv_w, mlstm_conv_b, mlstm_gate_b, mlstm_ln_g,
                branch_w_rwkv, branch_w_mlstm, w_out):
    p = h @ w_in
    p_r, p_m, p_g = jnp.split(p, [RWKV_COLS, RWKV_COLS + MLSTM_COLS], axis=-1)
    y_r = rwkv7_branch(p_r, rwkv_mu, rwkv_w0, rwkv_w_up, rwkv_a0, rwkv_a_up, rwkv_g_up, rwkv_k_k, rwkv_k_a,
                       rwkv_r_k, rwkv_ln_g, rwkv_ln_b) @ branch_w_rwkv
    y_m = mlstm_branch(p_m, mlstm_conv_w, mlstm_conv_b, mlstm_gate_b, mlstm_ln_g) @ branch_w_mlstm
    g_r, g_m = jnp.split(jax.nn.sigmoid(p_g.astype(jnp.float32)), 2, axis=-1)
    return ((g_r * y_r + g_m * y_m) @ w_out).astype(h.dtype)


def setup_inputs(seed: int = 0) -> dict:
    key = jax.random.key(seed)
    ks = jax.random.split(key, 32)
    f32 = jnp.float32

    def nrm(k, shape, scale):
        return jax.random.normal(k, shape, f32) * scale

    dm, w, mw = D_MODEL, RWKV_WIDTH, MLSTM_WIDTH
    return {
        'x': nrm(ks[0], (BATCH, SEQ, dm), 1.0),
        'c': nrm(ks[1], (BATCH, dm), 1.0),
        'ada_w': nrm(ks[2], (DEPTH, dm, 9 * dm), 0.1 * dm ** -0.5),
        'ada_b': nrm(ks[3], (DEPTH, 9 * dm), 0.02),
        'norm_g': 1.0 + nrm(ks[4], (DEPTH, 3, dm), 0.02),
        'ffn_w_in': nrm(ks[5], (DEPTH, 2, dm, 2 * D_FF), dm ** -0.5),
        'ffn_w_out': nrm(ks[6], (DEPTH, 2, D_FF, dm), D_FF ** -0.5),
        'mix_w_in': nrm(ks[7], (DEPTH, dm, N_IN), dm ** -0.5),
        'rwkv_mu': jax.random.uniform(ks[8], (DEPTH, RWKV_COLS), f32, 0.1, 0.9),
        'rwkv_w0': jnp.linspace(-6.0, -1.0, w, dtype=f32)[None, :] + nrm(ks[9], (DEPTH, w), 0.1),
        'rwkv_w_up': nrm(ks[10], (DEPTH, RWKV_DECAY_RANK, w), 0.1 * RWKV_DECAY_RANK ** -0.5),
        'rwkv_a0': nrm(ks[11], (DEPTH, w), 0.1),
        'rwkv_a_up': nrm(ks[12], (DEPTH, RWKV_A_RANK, w), 0.5 * RWKV_A_RANK ** -0.5),
        'rwkv_g_up': nrm(ks[13], (DEPTH, RWKV_GATE_RANK, w), RWKV_GATE_RANK ** -0.5),
        'rwkv_k_k': 0.85 + nrm(ks[14], (DEPTH, w), 0.02),
        'rwkv_k_a': 1.0 + nrm(ks[15], (DEPTH, w), 0.02),
        'rwkv_r_k': nrm(ks[16], (DEPTH, RWKV_HEADS, RWKV_HEAD_DIM), 0.1),
        'rwkv_ln_g': 1.0 + nrm(ks[17], (DEPTH, w), 0.02),
        'rwkv_ln_b': nrm(ks[18], (DEPTH, w), 0.02),
        'mlstm_conv_w': nrm(ks[19], (DEPTH, MLSTM_CONV, 2 * mw), MLSTM_CONV ** -0.5),
        'mlstm_conv_b': nrm(ks[20], (DEPTH, 2 * mw), 0.02),
        'mlstm_gate_b': jnp.concatenate([
            nrm(ks[21], (DEPTH, MLSTM_HEADS), 0.1),
            jnp.linspace(3.0, 6.0, MLSTM_HEADS, dtype=f32)[None, :] + nrm(ks[22], (DEPTH, MLSTM_HEADS), 0.1)],
            axis=-1),
        'mlstm_ln_g': 1.0 + nrm(ks[23], (DEPTH, mw), 0.02),
        'branch_w_rwkv': nrm(ks[24], (DEPTH, w, dm), w ** -0.5),
        'branch_w_mlstm': nrm(ks[25], (DEPTH, mw, dm), mw ** -0.5),
        'mix_w_out': nrm(ks[26], (DEPTH, dm, dm), dm ** -0.5),
        'final_g': 1.0 + nrm(ks[27], (dm,), 0.02),
    }


def reference(x, c, ada_w, ada_b, norm_g, ffn_w_in, ffn_w_out, mix_w_in, rwkv_mu, rwkv_w0, rwkv_w_up,
              rwkv_a0, rwkv_a_up, rwkv_g_up, rwkv_k_k, rwkv_k_a, rwkv_r_k, rwkv_ln_g, rwkv_ln_b,
              mlstm_conv_w, mlstm_conv_b, mlstm_gate_b, mlstm_ln_g, branch_w_rwkv, branch_w_mlstm,
              mix_w_out, final_g):
    cond = jax.nn.silu(c)
    for l in range(DEPTH):
        mod = cond @ ada_w[l] + ada_b[l]
        sh0, sc0, gt0, sh1, sc1, gt1, sh2, sc2, gt2 = jnp.split(mod, 9, axis=-1)
        h = modulate(rms_norm(x, norm_g[l, 0]), sh0, sc0)
        x = x + (0.5 * (1 + gt0))[:, None, :] * swiglu(h, ffn_w_in[l, 0], ffn_w_out[l, 0])
        h = modulate(rms_norm(x, norm_g[l, 1]), sh1, sc1)
        x = x + (1 + gt1)[:, None, :] * token_mixer(
            h, mix_w_in[l], rwkv_mu[l], rwkv_w0[l], rwkv_w_up[l], rwkv_a0[l], rwkv_a_up[l], rwkv_g_up[l],
            rwkv_k_k[l], rwkv_k_a[l], rwkv_r_k[l], rwkv_ln_g[l], rwkv_ln_b[l], mlstm_conv_w[l], mlstm_conv_b[l],
            mlstm_gate_b[l], mlstm_ln_g[l], branch_w_rwkv[l], branch_w_mlstm[l], mix_w_out[l])
        h = modulate(rms_norm(x, norm_g[l, 2]), sh2, sc2)
        x = x + (0.5 * (1 + gt2))[:, None, :] * swiglu(h, ffn_w_in[l, 1], ffn_w_out[l, 1])
    return rms_norm(x, final_g)
```

```cpp
#ifndef EMU
#include <hip/hip_runtime.h>
#include <cstdio>
#include <cstdint>
#define LAS __attribute__((address_space(3)))
#define GAS __attribute__((address_space(1)))
#endif

#ifndef CFG_B
#define CFG_B 4
#endif
#ifndef CFG_T
#define CFG_T 4096
#endif

typedef unsigned short bf16;
typedef short bf16x8 __attribute__((ext_vector_type(8)));
typedef float f32x4 __attribute__((ext_vector_type(4)));
typedef float f32x2 __attribute__((ext_vector_type(2)));
typedef unsigned u32x4 __attribute__((ext_vector_type(4)));
typedef unsigned u32x2 __attribute__((ext_vector_type(2)));

constexpr int NB = CFG_B, SEQ = CFG_T, MTOK = NB * SEQ, DM = 1024, FF = 2816, DEPTH = 2;
constexpr int RH = 8, RD = 64, RW = 512, MH = 4, MD = 128, MW = 512;
constexpr int RCOLS = 1696, MCOLS = 2056, NIN = 5800, PW = 3840;
constexpr int NC1 = SEQ / 64, NC2 = SEQ / 128;
constexpr int NIT1 = NB * RH * NC1, NIT2 = NB * MH * NC2;
static_assert(MTOK % 256 == 0 && SEQ % 256 == 0, "token tiles");
constexpr int PC_R = 0, PC_K = 512, PC_V = 1024, PC_LORA = 1536, PC_GLO = 1600;
constexpr int PC_MQ = 1696, PC_MK = 2208, PC_MV = 2720, PC_MO = 3232, PC_MI = 3744, PC_MF = 3748;

constexpr size_t MiB = 1u << 20;
constexpr size_t WS_CTL = 0, CTL_ZERO_BYTES = 1 * MiB;
constexpr size_t CTL_MOD_OFF = 512 * 1024;
constexpr size_t WS_W = 1 * MiB;
constexpr size_t W_FFIN = 0, W_FFIN_SZ = (size_t)2 * FF * DM * 2;
constexpr size_t W_FFOUT = 2 * W_FFIN_SZ, W_FFOUT_SZ = (size_t)DM * FF * 2;
constexpr size_t W_MIXIN = W_FFOUT + 2 * W_FFOUT_SZ, W_MIXIN_SZ = (size_t)PW * DM * 2;
constexpr size_t W_GATE = W_MIXIN + W_MIXIN_SZ, W_GATE_SZ = (size_t)2048 * DM * 2;
constexpr size_t W_BR = W_GATE + W_GATE_SZ, W_BR_SZ = (size_t)DM * 512 * 2;
constexpr size_t W_WOUT = W_BR + 2 * W_BR_SZ, W_WOUT_SZ = (size_t)DM * DM * 2;
constexpr size_t W_SMALL = W_WOUT + W_WOUT_SZ;
constexpr size_t W_SMALL_WUP = 0, W_SMALL_AUP = 8 * 64 * 32 * 2, W_SMALL_GUP = 2 * 8 * 64 * 32 * 2, W_SMALL_SZ = 512 * 1024;
constexpr size_t W_LAYER = W_SMALL + W_SMALL_SZ;
static_assert(W_LAYER == 49 * MiB, "weight block");
constexpr size_t WS_XN = WS_W + 2 * W_LAYER;
constexpr size_t WS_R = WS_XN + (size_t)MTOK * DM * 2;
constexpr size_t WS_F = WS_R + (size_t)MTOK * PW * 2;
constexpr size_t F_GV = 0;
constexpr size_t F_EV = F_GV + (size_t)NIT1 * 16384;
constexpr size_t F_MC = F_EV + (size_t)NIT1 * 16384;
constexpr size_t F_KS = F_MC + (size_t)NIT2 * 65536;
constexpr size_t F_MSC = F_KS + (size_t)NIT2 * 512;
constexpr size_t F_RHO = F_MSC + (size_t)NIT2 * 16;
constexpr size_t WS_END = WS_F + F_RHO + (size_t)MTOK * 32;
static_assert(F_EV + (size_t)MTOK * 2048 * 2 <= F_KS, "SG overlay");
static_assert((size_t)MTOK * DM * 2 <= F_EV, "T1/U overlay");
constexpr int CW_BAR = 4096;

constexpr int LDS_BYTES = 147456;
constexpr int MISC_OFF = LDS_BYTES - 256;
constexpr int NWAVES = 8;

#ifdef EMU
static inline float fexp(float x) { return expf(x); }
#else
__device__ __forceinline__ float fexp(float x) { return __expf(x); }
#endif
__device__ __forceinline__ float bf2f(bf16 b) { unsigned u = ((unsigned)b) << 16; return __builtin_bit_cast(float, u); }
__device__ __forceinline__ unsigned f2bf(float f) { unsigned u = __builtin_bit_cast(unsigned, f); return (u + 0x7fffu + ((u >> 16) & 1u)) >> 16; }
__device__ __forceinline__ unsigned pk2(float lo, float hi) { return f2bf(lo) | (f2bf(hi) << 16); }
__device__ __forceinline__ float sigmoidf_(float x) { return 1.0f / (1.0f + fexp(-x)); }
__device__ __forceinline__ float siluf_(float x) { return x / (1.0f + fexp(-x)); }
__device__ __forceinline__ float softplusf_(float x) { return fmaxf(x, 0.f) + log1pf(fexp(-fabsf(x))); }

#ifdef EMU
#define WAVE_LDS_FENCE() emu::wave_sync()
#define EMU_FENCE() do {} while (0)
#define LAUNDER(x) do {} while (0)
#define LAUNDER_S(x) do {} while (0)
static inline f32x4 mfma16(bf16x8 a, bf16x8 b, f32x4 c) {
    int w = emu::cur >> 6, l = emu::cur & 63;
    for (int j = 0; j < 8; ++j) { emu::xa[w][l][j] = (unsigned short)a[j]; emu::xb[w][l][j] = (unsigned short)b[j]; }
    emu::wave_sync();
    for (int r = 0; r < 4; ++r) { int row = 4 * (l >> 4) + r, col = l & 15; float s = 0.f;
        for (int k = 0; k < 32; ++k) s += bf2f(emu::xa[w][row + 16 * (k >> 3)][k & 7]) * bf2f(emu::xb[w][col + 16 * (k >> 3)][k & 7]);
        c[r] += s; }
    emu::wave_sync(); return c;
}
static inline float rdlane(float v, int l) { return __shfl(v, l); }
static inline int wave_id() { return threadIdx.x >> 6; }
#else
#define WAVE_LDS_FENCE() asm volatile("s_waitcnt lgkmcnt(0)" ::: "memory")
#define EMU_FENCE() asm volatile("" ::: "memory")
#define LAUNDER_S(x) asm volatile("" : "+s"(x))
#define LAUNDER(x) asm volatile("" : "+v"(x))
__device__ __forceinline__ f32x4 mfma16(bf16x8 a, bf16x8 b, f32x4 c) { return __builtin_amdgcn_mfma_f32_16x16x32_bf16(a, b, c, 0, 0, 0); }
__device__ __forceinline__ float rdlane(float v, int l) { return __builtin_bit_cast(float, __builtin_amdgcn_readlane(__builtin_bit_cast(int, v), l)); }
__device__ __forceinline__ int wave_id() { return __builtin_amdgcn_readfirstlane(threadIdx.x >> 6); }
#endif
__device__ __forceinline__ float wave_sum(float v) {
#pragma unroll
    for (int o = 1; o < 64; o <<= 1) v += __shfl_xor(v, o);
    return v;
}

namespace pg8 {
#define PG8_LAS LAS
typedef unsigned short bf16_t;
constexpr int BM = 256, BK = 64, HALF = 128, HTB = HALF * BK * 2  , STAGE_BYTES = 8 * HTB, NXCD = 8, WGM = 8;
__host__ __device__ __forceinline__ int lds_byte(int r, int c) { const int st = (r >> 4) * 2 + (c >> 5), rr = r & 15, cc = c & 31, ob = rr * 64 + cc * 2; return st * 1024 + (ob ^ (((ob >> 9) & 1) << 5)); }
__host__ __device__ __forceinline__ void stage_rc(int b, int& R, int& C) { const int st = b / 1024, sb = b % 1024, swz = sb ^ (((sb >> 9) & 1) << 5); R = (st >> 1) * 16 + swz / 64; C = (st & 1) * 32 + (swz % 64) / 2; }
__host__ __device__ __forceinline__ int perm32(int rho) { const int n = rho >> 4, i = rho & 15; return 8 * (i >> 2) + 4 * n + (i & 3); }
struct Unit { int pm, pn; };
struct Gemm { const bf16_t* A; const bf16_t* Bt; int M, N, K, lda; };
struct StaticOrder {
    int nM, nN, nwg, G, c;
    __host__ __device__ void init(int M, int N, int G_, int c_) { nM = M / BM; nN = N / BM; nwg = nM * nN; G = G_; c = c_; }
    __host__ __device__ bool next(int i, Unit& u) const {
        const long L = (long)i * G + c; if (L >= nwg) return false;
        int wgid = (int)L; { const int q = nwg / NXCD, r = nwg % NXCD, xcd = wgid % NXCD, off = wgid / NXCD; wgid = (xcd < r ? xcd * (q + 1) : r * (q + 1) + (xcd - r) * q) + off; }
        const int nig = WGM * nN, gid = wgid / nig, fm = gid * WGM, gsz = (nM - fm) < WGM ? (nM - fm) : WGM;
        u.pm = fm + ((wgid % nig) % gsz); u.pn = (wgid % nig) / gsz; return true;
    }
    __device__ __forceinline__ void a_ready(const Unit&) const {}
    __device__ __forceinline__ void done(const Unit&) const {}
};
struct GateOrder {
    StaticOrder base;
    __host__ __device__ void init(int M, int G_, int c_) { base.init(M, 1024, G_, c_); }
    __host__ __device__ bool next(int i, Unit& u) const { if (!base.next(i >> 1, u)) return false; u.pn += 4 * (i & 1); return true; }
    __device__ __forceinline__ void a_ready(const Unit&) const {}
    __device__ __forceinline__ void done(const Unit&) const {}
};
#ifndef EMU
__device__ __forceinline__ unsigned cvt_pk_bf16(float lo, float hi) { unsigned r; asm volatile("v_cvt_pk_bf16_f32 %0, %1, %2" : "=v"(r) : "v"(lo), "v"(hi)); return r; }
template <class Epi, class Sched, bool ALIGN_EPI = false, bool SP2 = false>
__device__ __forceinline__ void gemm_phase(PG8_LAS unsigned char* lds, const Gemm g, const Sched& S, const Epi& E) {
    int tid_ = threadIdx.x; asm volatile("" : "+v"(tid_));
    const int tid = tid_, wid = __builtin_amdgcn_readfirstlane(tid >> 6), lane = tid & 63, wr = wid >> 2, wc = wid & 3, fr = lane & 15, fq = lane >> 4;
    const int K = g.K, nt = K / BK;
    unsigned voffA[2], voffB[2];
#pragma unroll
    for (int i = 0; i < 2; ++i) { int R, C; stage_rc(tid * 16 + i * 8192, R, C); const int Rb = Epi::PERM ? ((R & ~31) + perm32(R & 31)) : R;
        voffA[i] = (unsigned)(R * g.lda + C) * 2u; voffB[i] = (unsigned)(Rb * K + C) * 2u; }
    const size_t kstep = (size_t)(BK * 2);
    const size_t hstep = (size_t)HALF * K * 2;
    const size_t tstep = 2 * hstep; const size_t hstepA = (size_t)HALF * g.lda * 2, tstepA = 2 * hstepA;
    const unsigned ldsw = (unsigned)wid * 1024u;
    const int aoff = lds_byte(wr * 64 + fr, fq * 8), boff = lds_byte(wc * 32 + fr, fq * 8);
#define PG8_SA(b, h) (((b) * 2 + (h)) * HTB)
#define PG8_SB(b, h) ((4 + (b) * 2 + (h)) * HTB)
#define PG8_STAGE(bufoff, gbase, voff) do { _Pragma("unroll") for (int _i = 0; _i < 2; ++_i) \
        __builtin_amdgcn_global_load_lds((const unsigned*)((const char*)(gbase) + (voff)[_i]), (PG8_LAS unsigned*)(lds + (bufoff) + ldsw + _i * 8192), 16, 0, 0); } while (0)
#define PG8_LDA(dst, b, h) do { _Pragma("unroll") for (int m = 0; m < 4; ++m) _Pragma("unroll") for (int k = 0; k < 2; ++k) dst[m][k] = *(const PG8_LAS bf16x8*)(lds + PG8_SA(b, h) + aoff + m * 2048 + k * 1024); } while (0)
#define PG8_LDB(dst, b, h) do { _Pragma("unroll") for (int n = 0; n < 2; ++n) _Pragma("unroll") for (int k = 0; k < 2; ++k) dst[n][k] = *(const PG8_LAS bf16x8*)(lds + PG8_SB(b, h) + boff + n * 2048 + k * 1024); } while (0)
#define PG8_MMA(ai, bj, At, Bt) do { __builtin_amdgcn_s_setprio(1); _Pragma("unroll") for (int m = 0; m < 4; ++m) _Pragma("unroll") for (int n = 0; n < 2; ++n) _Pragma("unroll") for (int k = 0; k < 2; ++k) \
        acc[ai][bj][m][n] = __builtin_amdgcn_mfma_f32_16x16x32_bf16(Bt[n][k], At[m][k], acc[ai][bj][m][n], 0, 0, 0); __builtin_amdgcn_s_setprio(0); } while (0)
#define PG8_WAIT_V(n) asm volatile("s_waitcnt vmcnt(" #n ")" ::: "memory")
#define PG8_WAIT_L(n) asm volatile("s_waitcnt lgkmcnt(" #n ")" ::: "memory")
#define PG8_BAR __builtin_amdgcn_s_barrier()
#define PG8_SCHED __builtin_amdgcn_sched_barrier(0)
    Unit cur, nxt; int ui = 0;
    if (!S.next(0, cur)) return;
    f32x4 acc[2][2][4][2];
#pragma unroll
    for (int a = 0; a < 2; ++a)
#pragma unroll
        for (int b = 0; b < 2; ++b)
#pragma unroll
            for (int m = 0; m < 4; ++m)
#pragma unroll
                for (int n = 0; n < 2; ++n) acc[a][b][m][n] = (f32x4){0.f, 0.f, 0.f, 0.f};
    bf16x8 At[4][2], B0[2][2], B1[2][2];
    const char* cA = (const char*)g.A + (size_t)cur.pm * tstepA; const char* cB = (const char*)g.Bt + (size_t)cur.pn * tstep;
    S.a_ready(cur);
    if constexpr (SP2) {
        PG8_STAGE(PG8_SB(0, 0), cB, voffB); PG8_STAGE(PG8_SB(0, 1), cB + hstep, voffB); PG8_STAGE(PG8_SA(0, 0), cA, voffA); PG8_STAGE(PG8_SA(0, 1), cA + hstepA, voffA);
        if (wr == 1) PG8_BAR;
        PG8_WAIT_V(2); PG8_BAR;
        PG8_STAGE(PG8_SB(1, 0), cB + kstep, voffB); PG8_STAGE(PG8_SA(1, 0), cA + kstep, voffA); PG8_STAGE(PG8_SB(1, 1), cB + hstep + kstep, voffB);
        PG8_WAIT_V(6); PG8_BAR;
    } else {
        PG8_STAGE(PG8_SB(0, 0), cB, voffB); PG8_STAGE(PG8_SA(0, 0), cA, voffA); PG8_STAGE(PG8_SB(0, 1), cB + hstep, voffB); PG8_STAGE(PG8_SA(0, 1), cA + hstepA, voffA);
        if (wr == 1) PG8_BAR;
        PG8_WAIT_V(4); PG8_BAR;
        PG8_STAGE(PG8_SB(1, 0), cB + kstep, voffB); PG8_STAGE(PG8_SA(1, 0), cA + kstep, voffA); PG8_STAGE(PG8_SB(1, 1), cB + hstep + kstep, voffB);
        PG8_WAIT_V(6); PG8_BAR;
    }
    for (;;) {
        const bool has_next = S.next(ui + 1, nxt);
        const char* nA = has_next ? (const char*)g.A + (size_t)nxt.pm * tstepA : cA; const char* nB = has_next ? (const char*)g.Bt + (size_t)nxt.pn * tstep : cB;
        for (int t = 0; t < nt; t += 2) {
            const bool last = (t == nt - 2);
            const char* a1 = cA + (size_t)(t + 1) * kstep;
            const char* a2 = last ? nA : cA + (size_t)(t + 2) * kstep; const char* b2 = last ? nB : cB + (size_t)(t + 2) * kstep;
            const char* a3 = a2 + kstep; const char* b3 = b2 + kstep;
            if (last && has_next) S.a_ready(nxt);
            if constexpr (SP2) {
            PG8_LDB(B0, 0, 0); PG8_LDB(B1, 0, 1); PG8_SCHED; PG8_LDA(At, 0, 0); PG8_STAGE(PG8_SA(1, 1), a1 + hstepA, voffA);
            PG8_WAIT_V(8); PG8_WAIT_L(0); PG8_BAR; PG8_MMA(0, 0, At, B0); PG8_MMA(0, 1, At, B1); PG8_BAR; PG8_SCHED;
            PG8_LDA(At, 0, 1); PG8_STAGE(PG8_SB(0, 0), b2, voffB); PG8_STAGE(PG8_SB(0, 1), b2 + hstep, voffB); PG8_STAGE(PG8_SA(0, 0), a2, voffA);
            PG8_WAIT_V(8); PG8_WAIT_L(0); PG8_BAR; PG8_MMA(1, 0, At, B0); PG8_MMA(1, 1, At, B1); PG8_BAR; PG8_SCHED;
            PG8_LDB(B0, 1, 0); PG8_LDB(B1, 1, 1); PG8_SCHED; PG8_LDA(At, 1, 0); PG8_STAGE(PG8_SA(0, 1), a2 + hstepA, voffA);
            PG8_WAIT_V(8); PG8_WAIT_L(0); PG8_BAR; PG8_MMA(0, 0, At, B0); PG8_MMA(0, 1, At, B1); PG8_BAR; PG8_SCHED;
            PG8_LDA(At, 1, 1); PG8_STAGE(PG8_SB(1, 0), b3, voffB); PG8_STAGE(PG8_SB(1, 1), b3 + hstep, voffB); PG8_STAGE(PG8_SA(1, 0), a3, voffA);
            PG8_WAIT_V(8); PG8_WAIT_L(0); PG8_BAR; PG8_MMA(1, 0, At, B0); PG8_MMA(1, 1, At, B1); PG8_BAR; PG8_SCHED;
            } else {
            PG8_LDB(B0, 0, 0); PG8_SCHED; PG8_LDA(At, 0, 0); PG8_STAGE(PG8_SA(1, 1), a1 + hstepA, voffA);
            PG8_WAIT_L(8); PG8_BAR; PG8_WAIT_L(0); PG8_MMA(0, 0, At, B0); PG8_BAR; PG8_SCHED;
            PG8_LDB(B1, 0, 1); PG8_STAGE(PG8_SB(0, 0), b2, voffB);
            PG8_BAR; PG8_WAIT_L(0); PG8_MMA(0, 1, At, B1); PG8_BAR;
            PG8_LDA(At, 0, 1); PG8_STAGE(PG8_SA(0, 0), a2, voffA);
            PG8_BAR; PG8_WAIT_L(0); PG8_MMA(1, 0, At, B0); PG8_BAR; PG8_SCHED;
            PG8_STAGE(PG8_SB(0, 1), b2 + hstep, voffB);
            PG8_WAIT_V(6); PG8_BAR; PG8_MMA(1, 1, At, B1); PG8_BAR;
            PG8_LDB(B0, 1, 0); PG8_SCHED; PG8_LDA(At, 1, 0); PG8_STAGE(PG8_SA(0, 1), a2 + hstepA, voffA);
            PG8_WAIT_L(8); PG8_BAR; PG8_WAIT_L(0); PG8_MMA(0, 0, At, B0); PG8_BAR; PG8_SCHED;
            PG8_LDB(B1, 1, 1); PG8_STAGE(PG8_SB(1, 0), b3, voffB);
            PG8_BAR; PG8_WAIT_L(0); PG8_MMA(0, 1, At, B1); PG8_BAR;
            PG8_LDA(At, 1, 1); PG8_STAGE(PG8_SA(1, 0), a3, voffA);
            PG8_BAR; PG8_WAIT_L(0); PG8_MMA(1, 0, At, B0); PG8_BAR; PG8_SCHED;
            PG8_STAGE(PG8_SB(1, 1), b3 + hstep, voffB);
            PG8_WAIT_V(6); PG8_BAR; PG8_MMA(1, 1, At, B1); PG8_BAR;
            }
        }
        if constexpr (ALIGN_EPI) { if (wr == 0) PG8_BAR; }
        if constexpr (!Epi::AFTER_DRAIN) { E(acc, cur, wr, wc, fr, fq); S.done(cur); }
        if (!has_next) break;
#pragma unroll
        for (int a = 0; a < 2; ++a)
#pragma unroll
            for (int b = 0; b < 2; ++b)
#pragma unroll
                for (int m = 0; m < 4; ++m)
#pragma unroll
                    for (int n = 0; n < 2; ++n) acc[a][b][m][n] = (f32x4){0.f, 0.f, 0.f, 0.f};
        cur = nxt; cA = nA; cB = nB; ++ui;
        if constexpr (ALIGN_EPI) { if (wr == 1) PG8_BAR; }
    }
    PG8_WAIT_V(0);
    if constexpr (!ALIGN_EPI) { if (wr == 0) PG8_BAR; }
    PG8_BAR;
    if constexpr (Epi::AFTER_DRAIN) { E.fused(acc, cur, wr, wc, fr, fq, lds, wid, lane); S.done(cur); }
#undef PG8_SA
#undef PG8_SB
#undef PG8_STAGE
#undef PG8_LDA
#undef PG8_LDB
#undef PG8_MMA
#undef PG8_WAIT_V
#undef PG8_WAIT_L
#undef PG8_BAR
#undef PG8_SCHED
}

#else
static inline unsigned cvt_pk_bf16(float lo, float hi) { return pk2(lo, hi); }
template <class Epi, class Sched, bool ALIGN_EPI = false, bool SP2 = false>
static void gemm_phase(unsigned char* lds, const Gemm g, const Sched& S, const Epi& E) {
    if (threadIdx.x != 0) return;
    static std::vector<float> C; C.resize(256 * 256);
    Unit u;
    for (int i = 0; S.next(i, u); ++i) {
        for (int r = 0; r < 256; ++r) for (int c = 0; c < 256; ++c) { const bf16_t* a = g.A + (size_t)(u.pm * 256 + r) * g.lda; const bf16_t* b = g.Bt + (size_t)(u.pn * 256 + c) * g.K; float s = 0.f; for (int k = 0; k < g.K; ++k) s += bf2f(a[k]) * bf2f(b[k]); C[r * 256 + c] = s; }
        for (int tid = 0; tid < 512; ++tid) { const int wid = tid >> 6, lane = tid & 63, wr = wid >> 2, wc = wid & 3, fr = lane & 15, fq = lane >> 4;
            f32x4 acc[2][2][4][2];
            for (int ai = 0; ai < 2; ++ai) for (int bj = 0; bj < 2; ++bj) for (int m = 0; m < 4; ++m) for (int n = 0; n < 2; ++n) for (int e = 0; e < 4; ++e) {
                const int r = 128 * ai + 64 * wr + 16 * m + fr, c = Epi::PERM ? (128 * bj + 32 * wc + 8 * fq + 4 * n + e) : (128 * bj + 32 * wc + 16 * n + 4 * fq + e);
                acc[ai][bj][m][n][e] = C[r * 256 + c]; }
            E(acc, u, wr, wc, fr, fq); }
    }
}
#endif
}

struct Frame {
    LAS unsigned char* lds;
    int tid, lane, wave, G, bid;
};
constexpr int TBL_OFF = MISC_OFF - 256;
#ifdef EMU
__device__ __forceinline__ const float* inp(const Frame& F, int i) { return *(const float* const*)(F.lds + TBL_OFF + 8 * i); }
__device__ __forceinline__ float* xout(const Frame& F) { return *(float* const*)(F.lds + TBL_OFF + 8 * 27); }
__device__ __forceinline__ unsigned char* wsb(const Frame& F) { return *(unsigned char* const*)(F.lds + TBL_OFF + 8 * 28); }
#else
__device__ __forceinline__ const float* inp(const Frame& F, int i) { return (const float*)(*(GAS const float* const LAS*)(F.lds + TBL_OFF + 8 * i)); }
__device__ __forceinline__ float* xout(const Frame& F) { return (float*)(*(GAS float* const LAS*)(F.lds + TBL_OFF + 8 * 27)); }
__device__ __forceinline__ unsigned char* wsb(const Frame& F) { return (unsigned char*)(*(GAS unsigned char* const LAS*)(F.lds + TBL_OFF + 8 * 28)); }
#endif
__device__ __forceinline__ Frame relaunder(const Frame& F) { Frame G = F; LAUNDER(G.lane); LAUNDER_S(G.wave); LAUNDER(G.lds); G.tid = G.wave * 64 + G.lane; return G; }
template <class T> __device__ __forceinline__ T* wsp(const Frame& F, size_t off) { return (T*)(wsb(F) + off); }
__device__ __forceinline__ unsigned char* wlayer(const Frame& F, int l) { return wsb(F) + WS_W + (size_t)l * W_LAYER; }
__device__ __forceinline__ const float* modp(const Frame& F, int l, int chunk) { return (const float*)(wsb(F) + CTL_MOD_OFF) + (size_t)l * NB * 9216 + chunk * 1024; }
template <class T> __device__ __forceinline__ LAS T* ldsp(LAS unsigned char* base, int off) { return (LAS T*)(base + off); }

__device__ __forceinline__ void p0_item(const float* W, int ldw, int K, int src_col0, int ncols, bf16* WT, int dest_row0, LAS float* scr, int kb, int lane) {
    const int k0 = 64 * kb;
#pragma unroll 8
    for (int i = 0; i < 32; ++i) { const int kk = 2 * i + (lane >> 5), cc = lane & 31;
        scr[kk * 33 + cc] = cc < ncols ? W[(size_t)(k0 + kk) * ldw + src_col0 + cc] : 0.f; }
    WAVE_LDS_FENCE();
    const int c = lane & 7;
#pragma unroll
    for (int j = 0; j < 4; ++j) { const int n = (lane >> 3) + 8 * j; const LAS float* s = scr + (8 * c) * 33 + n;
        u32x4 o; o.x = pk2(s[0], s[33]); o.y = pk2(s[66], s[99]); o.z = pk2(s[132], s[165]); o.w = pk2(s[198], s[231]);
        *(u32x4*)(WT + (size_t)(dest_row0 + n) * K + k0 + 8 * c) = o; }
    WAVE_LDS_FENCE();
}
constexpr int P0_ITEMS_L = 5632 + 2816 + 1920 + 1024 + 512 + 512;
__device__ __forceinline__ void ph_p0(Frame& F0) {
    Frame F = relaunder(F0);
    LAS float* scr = ldsp<float>(F.lds, F.wave * 16384);
    const int gw = F.bid * NWAVES + F.wave, NGW = F.G * NWAVES, lane = F.lane;
    for (int it = gw; it < 2 * P0_ITEMS_L; it += NGW) {
        const int l = it / P0_ITEMS_L; int r = it % P0_ITEMS_L; unsigned char* wl = wlayer(F, l);
        if (r < 5632) { const int i = r / 2816, q = r % 2816, kb = q / 176, rb = q % 176, pn = rb >> 3, qq = rb & 7;
            const int sc0 = qq < 4 ? 128 * pn + 32 * qq : FF + 128 * pn + 32 * (qq - 4);
            p0_item(inp(F, 5) + (size_t)(l * 2 + i) * DM * (2 * FF), 2 * FF, DM, sc0, 32, (bf16*)(wl + W_FFIN + i * W_FFIN_SZ), 32 * rb, scr, kb, lane); continue; }
        r -= 5632;
        if (r < 2816) { const int i = r / 1408, q = r % 1408, kb = q / 32, rb = q % 32;
            p0_item(inp(F, 6) + (size_t)(l * 2 + i) * FF * DM, DM, FF, 32 * rb, 32, (bf16*)(wl + W_FFOUT + i * W_FFOUT_SZ), 32 * rb, scr, kb, lane); continue; }
        r -= 2816;
        if (r < 1920) { const int kb = r / 120, rb = r % 120; int nc = (RCOLS + MCOLS) - 32 * rb; nc = nc < 0 ? 0 : (nc > 32 ? 32 : nc);
            p0_item(inp(F, 7) + (size_t)l * DM * NIN, NIN, DM, 32 * rb, nc, (bf16*)(wl + W_MIXIN), 32 * rb, scr, kb, lane); continue; }
        r -= 1920;
        if (r < 1024) { const int kb = r / 64, rb = r % 64;
            p0_item(inp(F, 7) + (size_t)l * DM * NIN, NIN, DM, (RCOLS + MCOLS) + 32 * rb, 32, (bf16*)(wl + W_GATE), 32 * rb, scr, kb, lane); continue; }
        r -= 1024;
        if (r < 512) { const int j = r / 256, q = r % 256, kb = q / 32, rb = q % 32;
            p0_item(inp(F, 23 + j) + (size_t)l * 512 * DM, DM, 512, 32 * rb, 32, (bf16*)(wl + W_BR + j * W_BR_SZ), 32 * rb, scr, kb, lane); continue; }
        r -= 512;
        { const int kb = r / 32, rb = r % 32;
            p0_item(inp(F, 25) + (size_t)l * DM * DM, DM, DM, 32 * rb, 32, (bf16*)(wl + W_WOUT), 32 * rb, scr, kb, lane); }
    }
    for (int idx = F.bid * 512 + F.tid; idx < 2 * 81920; idx += F.G * 512) {
        const int l = idx / 81920; int r = idx % 81920; bf16* sm = (bf16*)(wlayer(F, l) + W_SMALL);
        if (r < 32768) { const int which = r >> 14, e = r & 16383, ch = e >> 5, j = e & 31;
            sm[(which ? W_SMALL_AUP : W_SMALL_WUP) / 2 + e] = (bf16)f2bf(inp(F, which ? 12 : 10)[(size_t)(l * 32 + j) * RW + ch]); }
        else { const int e = r - 32768, ch = e / 96, j = e % 96;
            sm[W_SMALL_GUP / 2 + e] = (bf16)f2bf(inp(F, 13)[(size_t)(l * 96 + j) * RW + ch]); }
    }
    float* mod = (float*)(wsb(F) + CTL_MOD_OFF);
    for (int it = F.bid; it < DEPTH * 36; it += F.G) {
        const int l = it / 36, cg = it % 36, c0 = 256 * cg + 4 * lane, k0 = 128 * F.wave;
        f32x4 acc[NB];
#pragma unroll
        for (int b = 0; b < NB; ++b) acc[b] = (f32x4){0.f, 0.f, 0.f, 0.f};
        for (int half = 0; half < 2; ++half) {
            float cb[NB];
#pragma unroll
            for (int b = 0; b < NB; ++b) cb[b] = siluf_(inp(F, 1)[b * DM + k0 + 64 * half + lane]);
            const float* wp = inp(F, 2) + ((size_t)l * DM + k0 + 64 * half) * 9216 + c0;
#pragma unroll 8
            for (int kk = 0; kk < 64; ++kk) { const f32x4 w4 = *(const f32x4*)(wp + (size_t)kk * 9216);
#pragma unroll
                for (int b = 0; b < NB; ++b) acc[b] += w4 * rdlane(cb[b], kk); }
        }
        LAS float* part = ldsp<float>(F.lds, F.wave * 16384 + 8448);
#pragma unroll
        for (int b = 0; b < NB; ++b) *(LAS f32x4*)(part + b * 256 + 4 * lane) = acc[b];
        __syncthreads();
        for (int o = F.tid; o < NB * 256; o += 512) { const int b = o >> 8, cc = o & 255; float s = inp(F, 3)[(size_t)l * 9216 + 256 * cg + cc];
#pragma unroll
            for (int ww = 0; ww < NWAVES; ++ww) s += *ldsp<float>(F.lds, ww * 16384 + 8448 + (b * 256 + cc) * 4);
            mod[((size_t)l * NB + b) * 9216 + 256 * cg + cc] = s; }
        __syncthreads();
    }
}

__device__ __forceinline__ void ph_norm(Frame& F0, const float* xin, const float* g, const float* sh, const float* sc, bool final) {
    Frame F = relaunder(F0);
    const int gw = F.bid * NWAVES + F.wave, NGW = F.G * NWAVES, lane = F.lane;
    bf16* XN = wsp<bf16>(F, WS_XN);
    for (int m = gw; m < MTOK; m += NGW) {
        const int b = m / SEQ; const f32x4* xr = (const f32x4*)(xin + (size_t)m * DM) + lane;
        f32x4 v[4]; float s = 0.f;
#pragma unroll
        for (int j = 0; j < 4; ++j) { v[j] = xr[64 * j]; s += (v[j][0] * v[j][0] + v[j][1] * v[j][1]) + (v[j][2] * v[j][2] + v[j][3] * v[j][3]); }
        const float rstd = 1.0f / sqrtf(wave_sum(s) * (1.0f / DM) + 1e-6f);
        if (final) {
#pragma unroll
            for (int j = 0; j < 4; ++j) { const f32x4 gg = *((const f32x4*)g + lane + 64 * j); *((f32x4*)(xout(F) + (size_t)m * DM) + lane + 64 * j) = v[j] * rstd * gg; }
        } else {
#pragma unroll
            for (int j = 0; j < 4; ++j) { const int c = 4 * lane + 256 * j; const f32x4 gg = *(const f32x4*)(g + c), s1 = *(const f32x4*)(sc + (size_t)b * 9216 + c), s0 = *(const f32x4*)(sh + (size_t)b * 9216 + c);
                const f32x4 y = v[j] * rstd * gg * (s1 + 1.0f) + s0;
                u32x2 o; o.x = pk2(y[0], y[1]); o.y = pk2(y[2], y[3]); *(u32x2*)(XN + (size_t)m * DM + c) = o; }
        }
    }
}

struct EpiSwiglu {
    static constexpr bool PERM = true, AFTER_DRAIN = false; bf16* H;
    __device__ __forceinline__ void operator()(const f32x4 (&acc)[2][2][4][2], const pg8::Unit& u, int wr, int wc, int fr, int fq) const {
        const int row0 = u.pm * 256 + wr * 64 + fr, col0 = u.pn * 128 + wc * 32 + 8 * fq;
#pragma unroll
        for (int ai = 0; ai < 2; ++ai)
#pragma unroll
            for (int m = 0; m < 4; ++m) { float hh[8];
#pragma unroll
                for (int n = 0; n < 2; ++n)
#pragma unroll
                    for (int e = 0; e < 4; ++e) hh[4 * n + e] = siluf_(acc[ai][0][m][n][e]) * acc[ai][1][m][n][e];
                u32x4 o; o.x = pk2(hh[0], hh[1]); o.y = pk2(hh[2], hh[3]); o.z = pk2(hh[4], hh[5]); o.w = pk2(hh[6], hh[7]);
                *(u32x4*)(H + (size_t)(row0 + ai * 128 + m * 16) * FF + col0) = o; }
    }
};
struct EpiRes {
    static constexpr bool PERM = false, AFTER_DRAIN = false; const float* Xin; float* Xout; const float* gate; float scale;
    __device__ __forceinline__ void operator()(const f32x4 (&acc)[2][2][4][2], const pg8::Unit& u, int wr, int wc, int fr, int fq) const {
        const int row0 = u.pm * 256 + wr * 64 + fr, col0 = u.pn * 256 + wc * 32 + 4 * fq, b = (u.pm * 256) / SEQ;
        f32x4 gv[2][2];
#pragma unroll
        for (int bj = 0; bj < 2; ++bj)
#pragma unroll
            for (int n = 0; n < 2; ++n) gv[bj][n] = (*(const f32x4*)(gate + (size_t)b * 9216 + col0 + bj * 128 + n * 16) + 1.0f) * scale;
#pragma unroll
        for (int ai = 0; ai < 2; ++ai)
#pragma unroll
            for (int m = 0; m < 4; ++m) { const size_t off = (size_t)(row0 + ai * 128 + m * 16) * DM + col0;
#pragma unroll
                for (int bj = 0; bj < 2; ++bj)
#pragma unroll
                    for (int n = 0; n < 2; ++n) { const f32x4 x = *(const f32x4*)(Xin + off + bj * 128 + n * 16); *(f32x4*)(Xout + off + bj * 128 + n * 16) = x + gv[bj][n] * acc[ai][bj][m][n]; }
                EMU_FENCE(); }
    }
};
template <int MODE  > struct EpiBf {
    static constexpr bool PERM = true, AFTER_DRAIN = false; bf16* O; int ldo; const bf16* S1; int lds1;
    __device__ __forceinline__ void operator()(const f32x4 (&acc)[2][2][4][2], const pg8::Unit& u, int wr, int wc, int fr, int fq) const {
        const int row0 = u.pm * 256 + wr * 64 + fr, col0 = u.pn * 256 + wc * 32 + 8 * fq;
#pragma unroll
        for (int ai = 0; ai < 2; ++ai)
#pragma unroll
            for (int m = 0; m < 4; ++m) { const size_t r = (size_t)(row0 + ai * 128 + m * 16);
#pragma unroll
                for (int bj = 0; bj < 2; ++bj) { float v[8];
#pragma unroll
                    for (int n = 0; n < 2; ++n)
#pragma unroll
                        for (int e = 0; e < 4; ++e) v[4 * n + e] = acc[ai][bj][m][n][e];
                    bf16* op = O + r * ldo + col0 + bj * 128;
                    if (MODE == 1) {
#pragma unroll
                        for (int e = 0; e < 8; ++e) v[e] = sigmoidf_(v[e]); }
                    if (MODE >= 2) { const u32x4 s = *(const u32x4*)(S1 + r * lds1 + col0 + bj * 128);
#pragma unroll
                        for (int e = 0; e < 4; ++e) { v[2 * e] *= bf2f((bf16)(s[e] & 0xffffu)); v[2 * e + 1] *= bf2f((bf16)(s[e] >> 16)); } }
                    if (MODE == 3) { const u32x4 o = *(const u32x4*)op;
#pragma unroll
                        for (int e = 0; e < 4; ++e) { v[2 * e] += bf2f((bf16)(o[e] & 0xffffu)); v[2 * e + 1] += bf2f((bf16)(o[e] >> 16)); } }
                    u32x4 w; w.x = pk2(v[0], v[1]); w.y = pk2(v[2], v[3]); w.z = pk2(v[4], v[5]); w.w = pk2(v[6], v[7]);
                    *(u32x4*)op = w; }
                if (MODE >= 2) EMU_FENCE(); }
    }
};

constexpr int RP = 72, RBUF = 64 * RP * 2;
constexpr int L4_AT = 0, L4_RT = RBUF, L4_BT = 2 * RBUF, L4_KT = 3 * RBUF, L4_KH = 4 * RBUF, L4_AC = 5 * RBUF, L4_BC = 6 * RBUF, L4_VC = 7 * RBUF;
constexpr int L4_NM = 8 * RBUF, L4_PT = 9 * RBUF, L4_MF = 10 * RBUF  , L4_TOT = L4_MF + 64 * 68 * 4  , L4_GCX = L4_TOT + 2048  , L4_MFT = L4_GCX + 256  ;
constexpr int L4_WR = 8 * RBUF  , L4_AP = L4_WR + 64 * 65 * 4, L4_LORA = L4_AT;
constexpr int L4_TT = L4_AT, L4_WM = L4_BT, L4_NTM = L4_KT, L4_HT = L4_NM, L4_FT = L4_AC;
constexpr int L4_TL = L4_BT;
static_assert(L4_AP + 64 * 65 * 4 <= L4_TOT && L4_MFT + 64 * 68 * 4 <= MISC_OFF - 256 && 64 * 68 * 4 <= 2 * RBUF, "RWKV LDS map");

__device__ __forceinline__ bf16x8 ldfrag(const LAS unsigned char* base, int off, int row, int col) { return *(const LAS bf16x8*)(base + off + (row * RP + col) * 2); }
__device__ __forceinline__ void st4bf(LAS unsigned char* base, int off, int row, int col, f32x4 v) { u32x2 o; o.x = pk2(v[0], v[1]); o.y = pk2(v[2], v[3]); *(LAS u32x2*)(base + off + (row * RP + col) * 2) = o; }
__device__ __forceinline__ void st4bf_g(bf16* p, f32x4 v) { u32x2 o; o.x = pk2(v[0], v[1]); o.y = pk2(v[2], v[3]); *(u32x2*)p = o; }
__device__ __forceinline__ f32x4 ld4bf_g(const bf16* p) { const u32x2 o = *(const u32x2*)p; return (f32x4){bf2f((bf16)(o.x & 0xffffu)), bf2f((bf16)(o.x >> 16)), bf2f((bf16)(o.y & 0xffffu)), bf2f((bf16)(o.y >> 16))}; }

__device__ __forceinline__ void rwkv_prep_item(Frame& F0, int l, int item) {
    Frame F = relaunder(F0);
    const int c = item % NC1, bh = item / NC1, h = bh % RH, b = bh / RH;
    const int lane = F.lane, w = F.wave, l15 = lane & 15, q = lane >> 4, rb = w >> 1, cb0 = 2 * (w & 1), t0 = 8 * w;
    const size_t m0 = (size_t)b * SEQ + (size_t)c * 64;
    const bf16* P = wsp<bf16>(F, WS_R);
    LAS unsigned char* L = F.lds;
    const f32x4 z4 = (f32x4){0.f, 0.f, 0.f, 0.f};
    const int ch = h * 64 + lane;
    LAUNDER(L);
    float rs[8], ks[8], vs[8];
    {
        const float* mu = inp(F, 8) + (size_t)l * RCOLS;
        const float mu_r = mu[PC_R + ch], mu_k = mu[PC_K + ch], mu_v = mu[PC_V + ch], mu_l = mu[PC_LORA + lane];
        float pr = 0.f, pk = 0.f, pv = 0.f, pl = 0.f;
        if (c * 64 + t0 > 0) { const bf16* row = P + (m0 + t0 - 1) * PW; pr = bf2f(row[PC_R + ch]); pk = bf2f(row[PC_K + ch]); pv = bf2f(row[PC_V + ch]); pl = bf2f(row[PC_LORA + lane]); }
#pragma unroll
        for (int i = 0; i < 8; ++i) { const bf16* row = P + (m0 + t0 + i) * PW;
            const float xr = bf2f(row[PC_R + ch]), xk = bf2f(row[PC_K + ch]), xv = bf2f(row[PC_V + ch]), xl = bf2f(row[PC_LORA + lane]);
            rs[i] = xr + (pr - xr) * mu_r; ks[i] = xk + (pk - xk) * mu_k; vs[i] = xv + (pv - xv) * mu_v; const float ls = xl + (pl - xl) * mu_l;
            pr = xr; pk = xk; pv = xv; pl = xl;
            *ldsp<bf16>(L, L4_LORA + ((t0 + i) * RP + lane) * 2) = (bf16)f2bf(lane < 32 ? tanhf(ls) : ls); }
    }
    __syncthreads();
    LAUNDER(L);
    {
        const bf16* sm = (const bf16*)(wlayer(F, l) + W_SMALL);
        const bf16x8 aw = ldfrag(L, L4_LORA, 16 * rb + l15, 8 * q), aa = ldfrag(L, L4_LORA, 16 * rb + l15, 32 + 8 * q);
#pragma unroll
        for (int cbi = 0; cbi < 2; ++cbi) { const int kc = 16 * (cb0 + cbi) + l15;
            const bf16x8 bw = *(const bf16x8*)(sm + W_SMALL_WUP / 2 + (size_t)(h * 64 + kc) * 32 + 8 * q), ba = *(const bf16x8*)(sm + W_SMALL_AUP / 2 + (size_t)(h * 64 + kc) * 32 + 8 * q);
            const f32x4 cw = mfma16(aw, bw, z4), ca = mfma16(aa, ba, z4);
#pragma unroll
            for (int r = 0; r < 4; ++r) { *ldsp<float>(L, L4_WR + ((16 * rb + 4 * q + r) * 65 + kc) * 4) = cw[r]; *ldsp<float>(L, L4_AP + ((16 * rb + 4 * q + r) * 65 + kc) * 4) = ca[r]; } }
    }
    __syncthreads();
    LAUNDER(L);
    float ar[8], br[8], k2[8], ld[8], gin[8];
    {
        const float w0 = inp(F, 9)[(size_t)l * RW + ch], a0 = inp(F, 11)[(size_t)l * RW + ch], kkw = inp(F, 14)[(size_t)l * RW + ch], kaw = inp(F, 15)[(size_t)l * RW + ch], rkw = inp(F, 16)[(size_t)l * RW + ch];
        float cs = 0.f;
#pragma unroll
        for (int i = 0; i < 8; ++i) { const int t = t0 + i;
            const float wraw = w0 + *ldsp<float>(L, L4_WR + (t * 65 + lane) * 4);
            const float wl = -softplusf_(-wraw) - 0.5f; ld[i] = -fexp(wl);
            const float a = sigmoidf_(a0 + *ldsp<float>(L, L4_AP + (t * 65 + lane) * 4));
            float kk = ks[i] * kkw; const float nrm = sqrtf(wave_sum(kk * kk)); kk = kk / fmaxf(nrm, 1e-12f);
            k2[i] = ks[i] * (1.0f + (a - 1.0f) * kaw);
            const float rho = wave_sum(rs[i] * k2[i] * rkw);
            if (lane == 0) wsp<float>(F, WS_F + F_RHO)[(m0 + t) * 8 + h] = rho;
            ar[i] = -kk; br[i] = kk * a; cs += ld[i]; gin[i] = cs; }
        *ldsp<float>(L, L4_TOT + (w * 64 + lane) * 4) = cs;
    }
    __syncthreads();
    LAUNDER(L);
    {
        float pre = 0.f, gC = 0.f;
#pragma unroll
        for (int ww = 0; ww < 8; ++ww) { const float tv = *ldsp<float>(L, L4_TOT + (ww * 64 + lane) * 4); gC += tv; if (ww < w) pre += tv; }
        if (w == 0) *ldsp<float>(L, L4_GCX + lane * 4) = fexp(gC);
        float acv[8], bcv[8];
#pragma unroll
        for (int i = 0; i < 8; ++i) { const int t = t0 + i; const float gi = pre + gin[i], ge = gi - ld[i];
            const float e_gi = fexp(gi), e_ngi = fexp(-gi), e_ge = fexp(ge), e_c = fexp(gC - gi);
            const float at = ar[i] * e_ge; acv[i] = at; bcv[i] = br[i] * e_c;
            *ldsp<bf16>(L, L4_AT + (t * RP + lane) * 2) = (bf16)f2bf(at);
            *ldsp<bf16>(L, L4_RT + (t * RP + lane) * 2) = (bf16)f2bf(rs[i] * e_gi);
            *ldsp<bf16>(L, L4_BT + (t * RP + lane) * 2) = (bf16)f2bf(br[i] * e_ngi);
            *ldsp<bf16>(L, L4_KT + (t * RP + lane) * 2) = (bf16)f2bf(k2[i] * e_ngi);
            *ldsp<bf16>(L, L4_KH + (t * RP + lane) * 2) = (bf16)f2bf(k2[i] * e_c); }
        u32x4 o;
        o.x = pk2(acv[0], acv[1]); o.y = pk2(acv[2], acv[3]); o.z = pk2(acv[4], acv[5]); o.w = pk2(acv[6], acv[7]); *ldsp<u32x4>(L, L4_AC + (lane * RP + t0) * 2) = o;
        o.x = pk2(bcv[0], bcv[1]); o.y = pk2(bcv[2], bcv[3]); o.z = pk2(bcv[4], bcv[5]); o.w = pk2(bcv[6], bcv[7]); *ldsp<u32x4>(L, L4_BC + (lane * RP + t0) * 2) = o;
        o.x = pk2(vs[0], vs[1]); o.y = pk2(vs[2], vs[3]); o.z = pk2(vs[4], vs[5]); o.w = pk2(vs[6], vs[7]); *ldsp<u32x4>(L, L4_VC + (lane * RP + t0) * 2) = o;
    }
    __syncthreads();
    LAUNDER(L);
    f32x4 qreg[2];
    {
        bf16x8 aA[2], aB[2], aK[2];
#pragma unroll
        for (int s = 0; s < 2; ++s) { aA[s] = ldfrag(L, L4_AT, 16 * rb + l15, 32 * s + 8 * q); aB[s] = ldfrag(L, L4_BT, 16 * rb + l15, 32 * s + 8 * q); aK[s] = ldfrag(L, L4_KT, 16 * rb + l15, 32 * s + 8 * q); }
#pragma unroll
        for (int cbi = 0; cbi < 2; ++cbi) { const int cb = cb0 + cbi, cc = 16 * cb + l15, r0 = 16 * rb + 4 * q;
            f32x4 cm = z4, cn = z4, cp = z4, cq = z4;
#pragma unroll
            for (int s = 0; s < 2; ++s) { const bf16x8 bB = ldfrag(L, L4_BT, cc, 32 * s + 8 * q), bK = ldfrag(L, L4_KT, cc, 32 * s + 8 * q), bR = ldfrag(L, L4_RT, cc, 32 * s + 8 * q);
                cm = mfma16(aA[s], bB, cm); cn = mfma16(aA[s], bK, cn); cp = mfma16(aB[s], bR, cp); cq = mfma16(aK[s], bR, cq); }
#pragma unroll
            for (int r = 0; r < 4; ++r) { const int rr = r0 + r;
                if (!(cc < rr)) { cm[r] = 0.f; cn[r] = 0.f; }
                if (!(rr <= cc)) { cp[r] = 0.f; cq[r] = 0.f; } }
            *ldsp<f32x4>(L, L4_MF + (cc * 68 + r0) * 4) = cm;
#pragma unroll
            for (int r = 0; r < 4; ++r) *ldsp<float>(L, L4_MFT + ((r0 + r) * 68 + cc) * 4) = cm[r];
            st4bf(L, L4_NM, cc, r0, cn);
            st4bf(L, L4_PT, cc, r0, cp);
            qreg[cbi] = cq; }
    }
    __syncthreads();
    LAUNDER(L);
    if (w == 0) {
        int lnq = lane; LAUNDER(lnq);
        for (int ib = 3; ib >= 0; --ib) { const int i0 = 16 * ib;
            float acc[16];
#pragma unroll
            for (int r = 0; r < 16; ++r) acc[r] = (i0 + r == lnq) ? 1.0f : 0.0f;
            for (int j = i0 + 16; j < 64; ++j) { const float tj = *ldsp<float>(L, L4_TL + (j * 68 + lane) * 4);
#pragma unroll
                for (int g = 0; g < 4; ++g) { const f32x4 m4 = *ldsp<f32x4>(L, L4_MFT + (j * 68 + i0 + 4 * g) * 4);
#pragma unroll
                    for (int e = 0; e < 4; ++e) acc[4 * g + e] += m4[e] * tj; } }
#pragma unroll
            for (int r = 14; r >= 0; --r) {
#pragma unroll
                for (int g = (r + 1) >> 2; g < 4; ++g) { const f32x4 m4 = *ldsp<f32x4>(L, L4_MF + ((i0 + r) * 68 + i0 + 4 * g) * 4);
#pragma unroll
                    for (int e = 0; e < 4; ++e) if (4 * g + e > r) acc[r] += m4[e] * acc[4 * g + e]; } }
#pragma unroll
            for (int r = 0; r < 16; ++r) *ldsp<float>(L, L4_TL + ((i0 + r) * 68 + lane) * 4) = acc[r];
        }
#pragma unroll
        for (int g = 0; g < 8; ++g) { float tv[8];
#pragma unroll
            for (int e = 0; e < 8; ++e) tv[e] = *ldsp<float>(L, L4_TL + ((8 * g + e) * 68 + lane) * 4);
            u32x4 o; o.x = pk2(tv[0], tv[1]); o.y = pk2(tv[2], tv[3]); o.z = pk2(tv[4], tv[5]); o.w = pk2(tv[6], tv[7]);
            *ldsp<u32x4>(L, L4_TT + (lane * RP + 8 * g) * 2) = o; }
    }
    __syncthreads();
    LAUNDER(L);
    {
        bf16x8 aT[2];
#pragma unroll
        for (int s = 0; s < 2; ++s) aT[s] = ldfrag(L, L4_TT, 16 * rb + l15, 32 * s + 8 * q);
#pragma unroll
        for (int cbi = 0; cbi < 2; ++cbi) { const int cc = 16 * (cb0 + cbi) + l15, r0 = 16 * rb + 4 * q; f32x4 cw = z4, cn = z4;
#pragma unroll
            for (int s = 0; s < 2; ++s) { cw = mfma16(aT[s], ldfrag(L, L4_AC, cc, 32 * s + 8 * q), cw); cn = mfma16(aT[s], ldfrag(L, L4_NM, cc, 32 * s + 8 * q), cn); }
            st4bf(L, L4_WM, cc, r0, cw); st4bf(L, L4_NTM, cc, r0, cn); }
    }
    __syncthreads();
    LAUNDER(L);
    bf16* GT = wsp<bf16>(F, WS_F + F_GV + (size_t)item * 16384); bf16* VH = GT + 4096;
    bf16* ET = wsp<bf16>(F, WS_F + F_EV + (size_t)item * 16384); bf16* VFT = ET + 4096;
    {
        bf16x8 aW[2], aN[2];
#pragma unroll
        for (int s = 0; s < 2; ++s) { aW[s] = ldfrag(L, L4_WM, 16 * rb + l15, 32 * s + 8 * q); aN[s] = ldfrag(L, L4_NTM, 16 * rb + l15, 32 * s + 8 * q); }
#pragma unroll
        for (int cbi = 0; cbi < 2; ++cbi) { const int cc = 16 * (cb0 + cbi) + l15, r0 = 16 * rb + 4 * q; f32x4 cg = z4, ce = z4, chh = z4, cf = qreg[cbi];
#pragma unroll
            for (int s = 0; s < 2; ++s) { const bf16x8 bB = ldfrag(L, L4_BC, cc, 32 * s + 8 * q), bP = ldfrag(L, L4_PT, cc, 32 * s + 8 * q);
                cg = mfma16(aW[s], bB, cg); ce = mfma16(aW[s], bP, ce); chh = mfma16(aN[s], bB, chh); cf = mfma16(aN[s], bP, cf); }
#pragma unroll
            for (int r = 0; r < 4; ++r) { if (r0 + r == cc) cg[r] += *ldsp<float>(L, L4_GCX + cc * 4);
                chh[r] += bf2f(*ldsp<bf16>(L, L4_KH + ((r0 + r) * RP + cc) * 2)); }
            const u32x2 rt = *ldsp<u32x2>(L, L4_RT + (cc * RP + r0) * 2);
            ce[0] += bf2f((bf16)(rt.x & 0xffffu)); ce[1] += bf2f((bf16)(rt.x >> 16)); ce[2] += bf2f((bf16)(rt.y & 0xffffu)); ce[3] += bf2f((bf16)(rt.y >> 16));
            st4bf_g(GT + cc * 64 + r0, cg);
            st4bf_g(ET + cc * 64 + r0, ce);
            st4bf(L, L4_HT, cc, r0, chh);
            st4bf(L, L4_FT, cc, r0, cf); }
    }
    __syncthreads();
    LAUNDER(L);
    {
#pragma unroll
        for (int cbi = 0; cbi < 2; ++cbi) { const int cc = 16 * (cb0 + cbi) + l15, r0 = 16 * rb + 4 * q; f32x4 c1 = z4, c2 = z4;
#pragma unroll
            for (int s = 0; s < 2; ++s) { c1 = mfma16(ldfrag(L, L4_HT, 16 * rb + l15, 32 * s + 8 * q), ldfrag(L, L4_VC, cc, 32 * s + 8 * q), c1);
                c2 = mfma16(ldfrag(L, L4_VC, 16 * rb + l15, 32 * s + 8 * q), ldfrag(L, L4_FT, cc, 32 * s + 8 * q), c2); }
            st4bf_g(VH + cc * 64 + r0, c1); st4bf_g(VFT + cc * 64 + r0, c2); }
    }
    __syncthreads();
}

constexpr int L5_SB = 0;
__device__ __forceinline__ void rwkv_scan_bh(Frame& F0, int bh) {
    Frame F = relaunder(F0);
    const int lane = F.lane, w = F.wave, l15 = lane & 15, q = lane >> 4, rb = w >> 1, cb0 = 2 * (w & 1);
    LAS unsigned char* L = F.lds;
    const f32x4 z4 = (f32x4){0.f, 0.f, 0.f, 0.f};
    for (int i = F.tid; i < 2 * RBUF / 4; i += 512) *ldsp<unsigned>(L, L5_SB + 4 * i) = 0u;
    __syncthreads();
    f32x4 st[2] = {z4, z4};
    int cur = 0;
    bf16* base = wsp<bf16>(F, WS_F + F_GV + (size_t)bh * NC1 * 16384);
    bf16x8 ga[2]; f32x4 vh[2];
#pragma unroll
    for (int s = 0; s < 2; ++s) ga[s] = *(const bf16x8*)(base + (16 * rb + l15) * 64 + 32 * s + 8 * q);
#pragma unroll
    for (int cbi = 0; cbi < 2; ++cbi) vh[cbi] = ld4bf_g(base + 4096 + (16 * (cb0 + cbi) + l15) * 64 + 16 * rb + 4 * q);
    for (int c = 0; c < NC1; ++c) {
        bf16* it = base + (size_t)c * 8192;
        bf16x8 gan[2]; f32x4 vhn[2];
        const bf16* nx = it + (c + 1 < NC1 ? 8192 : 0);
#pragma unroll
        for (int s = 0; s < 2; ++s) gan[s] = *(const bf16x8*)(nx + (16 * rb + l15) * 64 + 32 * s + 8 * q);
        if (c + 1 < NC1) {
#pragma unroll
            for (int cbi = 0; cbi < 2; ++cbi) vhn[cbi] = ld4bf_g(nx + 4096 + (16 * (cb0 + cbi) + l15) * 64 + 16 * rb + 4 * q); }
        else { vhn[0] = z4; vhn[1] = z4; }
#pragma unroll
        for (int cbi = 0; cbi < 2; ++cbi) { const int v = 16 * (cb0 + cbi) + l15;
            st4bf_g(it + 4096 + v * 64 + 16 * rb + 4 * q, st[cbi]);
            f32x4 acc = vh[cbi];
#pragma unroll
            for (int s = 0; s < 2; ++s) acc = mfma16(ga[s], ldfrag(L, L5_SB + cur * RBUF, v, 32 * s + 8 * q), acc);
            st[cbi] = acc;
            st4bf(L, L5_SB + (cur ^ 1) * RBUF, v, 16 * rb + 4 * q, acc); }
        __syncthreads();
        cur ^= 1;
#pragma unroll
        for (int s = 0; s < 2; ++s) ga[s] = gan[s];
        vh[0] = vhn[0]; vh[1] = vhn[1];
    }
}

constexpr int L6_SG = 0  , L6_YL = 64 * 104 * 2  , L6_GL = L6_YL + 64 * 68 * 4;
__device__ __forceinline__ void rwkv_out_item(Frame& F0, int l, int item) {
    Frame F = relaunder(F0);
    const int c = item % NC1, bh = item / NC1, h = bh % RH, b = bh / RH;
    const int lane = F.lane, w = F.wave, l15 = lane & 15, q = lane >> 4, rb = w >> 1, cb0 = 2 * (w & 1), t0 = 8 * w;
    const size_t m0 = (size_t)b * SEQ + (size_t)c * 64;
    bf16* P = wsp<bf16>(F, WS_R);
    LAS unsigned char* L = F.lds;
    const int ch = h * 64 + lane;
    LAUNDER(L);
    float vs[8];
    {
        const float* mu = inp(F, 8) + (size_t)l * RCOLS;
        const float mu_v = mu[PC_V + ch], mu_g0 = mu[PC_GLO + lane], mu_g1 = lane < 32 ? mu[PC_GLO + 64 + lane] : 0.f;
        float pv = 0.f, p0 = 0.f, p1 = 0.f;
        if (c * 64 + t0 > 0) { const bf16* row = P + (m0 + t0 - 1) * PW; pv = bf2f(row[PC_V + ch]); p0 = bf2f(row[PC_GLO + lane]); if (lane < 32) p1 = bf2f(row[PC_GLO + 64 + lane]); }
#pragma unroll
        for (int i = 0; i < 8; ++i) { const bf16* row = P + (m0 + t0 + i) * PW;
            const float xv = bf2f(row[PC_V + ch]), x0 = bf2f(row[PC_GLO + lane]); vs[i] = xv + (pv - xv) * mu_v; pv = xv;
            *ldsp<bf16>(L, L6_SG + ((t0 + i) * 104 + lane) * 2) = (bf16)f2bf(sigmoidf_(x0 + (p0 - x0) * mu_g0)); p0 = x0;
            if (lane < 32) { const float x1 = bf2f(row[PC_GLO + 64 + lane]); *ldsp<bf16>(L, L6_SG + ((t0 + i) * 104 + 64 + lane) * 2) = (bf16)f2bf(sigmoidf_(x1 + (p1 - x1) * mu_g1)); p1 = x1; } }
    }
    __syncthreads();
    {
        const bf16* Sc = wsp<bf16>(F, WS_F + F_GV + (size_t)item * 16384) + 4096;
        const bf16* ET = wsp<bf16>(F, WS_F + F_EV + (size_t)item * 16384); const bf16* VFT = ET + 4096;
        const bf16* gup = (const bf16*)(wlayer(F, l) + W_SMALL + W_SMALL_GUP) + (size_t)(h * 64) * 96;
        bf16x8 aS[2], aG[3];
#pragma unroll
        for (int s = 0; s < 2; ++s) aS[s] = *(const bf16x8*)(Sc + (16 * rb + l15) * 64 + 32 * s + 8 * q);
#pragma unroll
        for (int s = 0; s < 3; ++s) aG[s] = *(const bf16x8*)(gup + (16 * rb + l15) * 96 + 32 * s + 8 * q);
#pragma unroll
        for (int cbi = 0; cbi < 2; ++cbi) { const int tt = 16 * (cb0 + cbi) + l15, v0 = 16 * rb + 4 * q;
            f32x4 cy = ld4bf_g(VFT + tt * 64 + v0), cg = (f32x4){0.f, 0.f, 0.f, 0.f};
#pragma unroll
            for (int s = 0; s < 2; ++s) cy = mfma16(aS[s], *(const bf16x8*)(ET + tt * 64 + 32 * s + 8 * q), cy);
#pragma unroll
            for (int s = 0; s < 3; ++s) cg = mfma16(aG[s], *(const LAS bf16x8*)(L + L6_SG + (tt * 104 + 32 * s + 8 * q) * 2), cg);
            *ldsp<f32x4>(L, L6_YL + (tt * 68 + v0) * 4) = cy; *ldsp<f32x4>(L, L6_GL + (tt * 68 + v0) * 4) = cg; }
    }
    __syncthreads();
    {
        const float lng = inp(F, 17)[(size_t)l * RW + ch], lnb = inp(F, 18)[(size_t)l * RW + ch];
#pragma unroll
        for (int i = 0; i < 8; ++i) { const int t = t0 + i; const float y = *ldsp<float>(L, L6_YL + (t * 68 + lane) * 4);
            const float mean = wave_sum(y) * (1.0f / 64.0f), d = y - mean, var = wave_sum(d * d) * (1.0f / 64.0f);
            const float yn = d * (1.0f / sqrtf(var + 64e-5f)) * lng + lnb;
            const float rho = wsp<float>(F, WS_F + F_RHO)[(m0 + t) * 8 + h];
            const float o = (yn + rho * vs[i]) * *ldsp<float>(L, L6_GL + (t * 68 + lane) * 4);
            P[(m0 + t) * PW + ch] = (bf16)f2bf(o); }
    }
    __syncthreads();
}

constexpr int MP = 136, MBUF = 128 * MP * 2;
constexpr int LM_A = 0, LM_B = MBUF, LM_C = 2 * MBUF, LM_D = 3 * MBUF, LM_S = 4 * MBUF;
static_assert(LM_S + 8 * 512 <= MISC_OFF - 256, "mLSTM LDS map");
__device__ __forceinline__ bf16x8 ldfragm(const LAS unsigned char* base, int off, int row, int col) { return *(const LAS bf16x8*)(base + off + (row * MP + col) * 2); }
__device__ __forceinline__ float logsigmoidf_(float x) { return -softplusf_(-x); }

__device__ __forceinline__ void mlstm_gates(Frame& F, int l, int b, int h, int c) {
    LAS unsigned char* L = F.lds; const bf16* P = wsp<bf16>(F, WS_R);
    if (F.tid < 128) { const bf16* row = P + ((size_t)b * SEQ + (size_t)c * 128 + F.tid) * PW;
        *ldsp<float>(L, LM_S + 0 * 512 + F.tid * 4) = bf2f(row[PC_MI + h]) + inp(F, 21)[l * 8 + h];
        *ldsp<float>(L, LM_S + 1 * 512 + F.tid * 4) = logsigmoidf_(bf2f(row[PC_MF + h]) + inp(F, 21)[l * 8 + 4 + h]); }
    __syncthreads();
    if (F.tid < 128) { float s = 0.f; for (int j = 0; j <= F.tid; ++j) s += *ldsp<float>(L, LM_S + 1 * 512 + j * 4); *ldsp<float>(L, LM_S + 2 * 512 + F.tid * 4) = s; }
    __syncthreads();
}
__device__ __forceinline__ void mlstm_conv32(const Frame& F, int l, size_t mrow0, int tseq0, int chq, float (&out)[32]) {
    const bf16* P = wsp<bf16>(F, WS_R);
    const float w0 = inp(F, 19)[(size_t)(l * 4 + 0) * 1024 + chq], w1 = inp(F, 19)[(size_t)(l * 4 + 1) * 1024 + chq], w2 = inp(F, 19)[(size_t)(l * 4 + 2) * 1024 + chq], w3 = inp(F, 19)[(size_t)(l * 4 + 3) * 1024 + chq], cb = inp(F, 20)[(size_t)l * 1024 + chq];
    float x0 = 0.f, x1 = 0.f, x2 = 0.f;
    if (tseq0 >= 3) { x0 = bf2f(P[(mrow0 - 3) * PW + PC_MQ + chq]); x1 = bf2f(P[(mrow0 - 2) * PW + PC_MQ + chq]); x2 = bf2f(P[(mrow0 - 1) * PW + PC_MQ + chq]); }
#pragma unroll
    for (int i = 0; i < 32; ++i) { const float x3 = bf2f(P[(mrow0 + i) * PW + PC_MQ + chq]);
        out[i] = siluf_(w0 * x0 + w1 * x1 + w2 * x2 + w3 * x3 + cb); x0 = x1; x1 = x2; x2 = x3; }
}
__device__ __forceinline__ void mlstm_m1_item(Frame& F0, int l, int item) {
    Frame F = relaunder(F0);
    const int c = item % NC2, bh = item / NC2, h = bh % MH, b = bh / MH;
    const int lane = F.lane, w = F.wave, l15 = lane & 15, q = lane >> 4;
    LAS unsigned char* L = F.lds; const bf16* P = wsp<bf16>(F, WS_R);
    const size_t m0 = (size_t)b * SEQ + (size_t)c * 128;
    LAUNDER(L);
    mlstm_gates(F, l, b, h, c);
    const float bend = *ldsp<float>(L, LM_S + 2 * 512 + 127 * 4);
    if (F.tid < 128) *ldsp<float>(L, LM_S + 3 * 512 + F.tid * 4) = bend - *ldsp<float>(L, LM_S + 2 * 512 + F.tid * 4) + *ldsp<float>(L, LM_S + 0 * 512 + F.tid * 4);
    __syncthreads();
    float mloc = -3.0e38f;
    for (int j = 0; j < 128; ++j) mloc = fmaxf(mloc, *ldsp<float>(L, LM_S + 3 * 512 + j * 4));
    const int d = lane + 64 * (w & 1), tg = w >> 1, tb = 32 * tg;
    {
        float kc[32]; mlstm_conv32(F, l, m0 + tb, c * 128 + tb, 512 + h * 128 + d, kc);
        float ksum = 0.f;
#pragma unroll
        for (int i = 0; i < 32; ++i) { const float wg = fexp(*ldsp<float>(L, LM_S + 3 * 512 + (tb + i) * 4) - mloc); kc[i] *= wg; ksum += kc[i]; }
#pragma unroll
        for (int g = 0; g < 4; ++g) { u32x4 o; o.x = pk2(kc[8 * g], kc[8 * g + 1]); o.y = pk2(kc[8 * g + 2], kc[8 * g + 3]); o.z = pk2(kc[8 * g + 4], kc[8 * g + 5]); o.w = pk2(kc[8 * g + 6], kc[8 * g + 7]);
            *ldsp<u32x4>(L, LM_A + (d * MP + tb + 8 * g) * 2) = o; }
        *ldsp<float>(L, LM_S + 4 * 512 + tg * 512 + d * 4) = ksum;
#pragma unroll
        for (int g = 0; g < 4; ++g) { float vv[8];
#pragma unroll
            for (int i = 0; i < 8; ++i) vv[i] = bf2f(P[(m0 + tb + 8 * g + i) * PW + PC_MV + h * 128 + d]);
            u32x4 o; o.x = pk2(vv[0], vv[1]); o.y = pk2(vv[2], vv[3]); o.z = pk2(vv[4], vv[5]); o.w = pk2(vv[6], vv[7]);
            *ldsp<u32x4>(L, LM_B + (d * MP + tb + 8 * g) * 2) = o; }
    }
    __syncthreads();
    float* KVT = wsp<float>(F, WS_F + F_MC + (size_t)item * 65536);
    {
        f32x4 acc[8];
#pragma unroll
        for (int et = 0; et < 8; ++et) acc[et] = (f32x4){0.f, 0.f, 0.f, 0.f};
#pragma unroll
        for (int s = 0; s < 4; ++s) { const bf16x8 a = ldfragm(L, LM_A, 16 * w + l15, 32 * s + 8 * q);
#pragma unroll
            for (int et = 0; et < 8; ++et) acc[et] = mfma16(a, ldfragm(L, LM_B, 16 * et + l15, 32 * s + 8 * q), acc[et]); }
#pragma unroll
        for (int et = 0; et < 8; ++et) *(f32x4*)(KVT + (size_t)(16 * et + l15) * 128 + 16 * w + 4 * q) = acc[et];
    }
    if (F.tid < 128) { float s = 0.f;
#pragma unroll
        for (int g = 0; g < 4; ++g) s += *ldsp<float>(L, LM_S + 4 * 512 + g * 512 + F.tid * 4);
        wsp<float>(F, WS_F + F_KS)[(size_t)item * 128 + F.tid] = s; }
    if (F.tid == 0) { float* msc = wsp<float>(F, WS_F + F_MSC) + (size_t)item * 4; msc[0] = mloc; msc[1] = bend; }
    __syncthreads();
}
__device__ __forceinline__ void mlstm_m2(Frame& F0, int first_wg) {
    Frame F = relaunder(F0);
    const int nW = F.G - first_wg; if (F.bid < first_wg || nW <= 0) return;
    const int per = 4096 + 32;
    for (int idx = (F.bid - first_wg) * 512 + F.tid; idx < NB * MH * per; idx += nW * 512) {
        const int bh = idx / per, e4 = idx % per;
        float m = -INFINITY; f32x4 st = (f32x4){0.f, 0.f, 0.f, 0.f};
        for (int c = 0; c < NC2; ++c) { const size_t item = (size_t)bh * NC2 + c;
            float* msc = wsp<float>(F, WS_F + F_MSC) + item * 4; const float mloc = msc[0], bend = msc[1];
            f32x4* p = e4 < 4096 ? (f32x4*)(wsp<float>(F, WS_F + F_MC) + item * 16384) + e4 : (f32x4*)(wsp<float>(F, WS_F + F_KS) + item * 128) + (e4 - 4096);
            const f32x4 kv = *p; *p = st;
            if (e4 == 0) msc[2] = m;
            const float mn = fmaxf(bend + m, mloc), keep = fexp(bend + m - mn), w2 = fexp(mloc - mn);
            st = st * keep + kv * w2; m = mn; }
    }
}
__device__ __forceinline__ void mlstm_m3_item(Frame& F0, int l, int item) {
    Frame F = relaunder(F0);
    const int c = item % NC2, bh = item / NC2, h = bh % MH, b = bh / MH;
    const int lane = F.lane, w = F.wave, l15 = lane & 15, q = lane >> 4;
    LAS unsigned char* L = F.lds; bf16* P = wsp<bf16>(F, WS_R);
    const size_t m0 = (size_t)b * SEQ + (size_t)c * 128;
    LAUNDER(L);
    mlstm_gates(F, l, b, h, c);
    const float mprev = wsp<float>(F, WS_F + F_MSC)[(size_t)item * 4 + 2];
    if (F.tid < 128) *ldsp<float>(L, LM_S + 3 * 512 + F.tid * 4) = *ldsp<float>(L, LM_S + 0 * 512 + F.tid * 4) - *ldsp<float>(L, LM_S + 2 * 512 + F.tid * 4);
    __syncthreads();
    if (F.tid < 128) { float cm = -3.0e38f; for (int j = 0; j <= F.tid; ++j) cm = fmaxf(cm, *ldsp<float>(L, LM_S + 3 * 512 + j * 4));
        const float mx = fmaxf(mprev, cm), bl = *ldsp<float>(L, LM_S + 2 * 512 + F.tid * 4);
        *ldsp<float>(L, LM_S + 4 * 512 + F.tid * 4) = -mx;
        *ldsp<float>(L, LM_S + 5 * 512 + F.tid * 4) = fexp(mprev - mx);
        *ldsp<float>(L, LM_S + 6 * 512 + F.tid * 4) = fexp(-(bl + mx)); }
    const int d = lane + 64 * (w & 1), tg = w >> 1, tb = 32 * tg;
    {
        float cv[32];
        mlstm_conv32(F, l, m0 + tb, c * 128 + tb, h * 128 + d, cv);
#pragma unroll
        for (int i = 0; i < 32; ++i) *ldsp<bf16>(L, LM_A + ((tb + i) * MP + d) * 2) = (bf16)f2bf(cv[i] * 0.08838834764831845f);
        mlstm_conv32(F, l, m0 + tb, c * 128 + tb, 512 + h * 128 + d, cv);
#pragma unroll
        for (int i = 0; i < 32; ++i) *ldsp<bf16>(L, LM_B + ((tb + i) * MP + d) * 2) = (bf16)f2bf(cv[i]);
#pragma unroll
        for (int g = 0; g < 4; ++g) { float vv[8];
#pragma unroll
            for (int i = 0; i < 8; ++i) vv[i] = bf2f(P[(m0 + tb + 8 * g + i) * PW + PC_MV + h * 128 + d]);
            u32x4 o; o.x = pk2(vv[0], vv[1]); o.y = pk2(vv[2], vv[3]); o.z = pk2(vv[4], vv[5]); o.w = pk2(vv[6], vv[7]);
            *ldsp<u32x4>(L, LM_C + (d * MP + tb + 8 * g) * 2) = o; }
    }
    __syncthreads();
    LAUNDER(L);
    const int lq = 16 * w + l15;
    {
        bf16x8 bq[4];
#pragma unroll
        for (int s = 0; s < 4; ++s) bq[s] = ldfragm(L, LM_A, lq, 32 * s + 8 * q);
        const float al = *ldsp<float>(L, LM_S + 4 * 512 + lq * 4);
        const int nsb = 2 * (w >> 1) + 2;
        for (int sb = 0; sb < nsb; ++sb) { f32x4 acc = (f32x4){0.f, 0.f, 0.f, 0.f};
            if (sb <= w) {
#pragma unroll
                for (int s = 0; s < 4; ++s) acc = mfma16(ldfragm(L, LM_B, 16 * sb + l15, 32 * s + 8 * q), bq[s], acc);
#pragma unroll
                for (int r = 0; r < 4; ++r) { const int ss = 16 * sb + 4 * q + r; acc[r] = ss <= lq ? acc[r] * fexp(al + *ldsp<float>(L, LM_S + 3 * 512 + ss * 4)) : 0.f; } }
            u32x2 o; o.x = pk2(acc[0], acc[1]); o.y = pk2(acc[2], acc[3]); *ldsp<u32x2>(L, LM_D + (lq * MP + 16 * sb + 4 * q) * 2) = o; }
    }
    WAVE_LDS_FENCE();
    LAUNDER(L);
    f32x4 a1[9], a2[9];
#pragma unroll
    for (int et = 0; et < 9; ++et) { a1[et] = (f32x4){0.f, 0.f, 0.f, 0.f}; a2[et] = (f32x4){0.f, 0.f, 0.f, 0.f}; }
    {
        const float* CP = wsp<float>(F, WS_F + F_MC + (size_t)item * 65536); const float* NP = wsp<float>(F, WS_F + F_KS) + (size_t)item * 128;
        const int ns = (w >> 1) + 1;
        for (int s = 0; s < ns; ++s) { const bf16x8 bs = ldfragm(L, LM_D, lq, 32 * s + 8 * q);
#pragma unroll
            for (int et = 0; et < 8; ++et) a1[et] = mfma16(ldfragm(L, LM_C, 16 * et + l15, 32 * s + 8 * q), bs, a1[et]);
            const short one = l15 == 0 ? (short)0x3F80 : (short)0; const bf16x8 ones = (bf16x8){one, one, one, one, one, one, one, one};
            a1[8] = mfma16(ones, bs, a1[8]); }
#pragma unroll
        for (int s = 0; s < 4; ++s) { const bf16x8 bq = ldfragm(L, LM_A, lq, 32 * s + 8 * q);
#pragma unroll
            for (int et = 0; et < 8; ++et) { const float* cp = CP + (size_t)(16 * et + l15) * 128 + 32 * s + 8 * q; const f32x4 c0 = *(const f32x4*)cp, c1 = *(const f32x4*)(cp + 4);
                u32x4 o; o.x = pk2(c0[0], c0[1]); o.y = pk2(c0[2], c0[3]); o.z = pk2(c1[0], c1[1]); o.w = pk2(c1[2], c1[3]);
                a2[et] = mfma16(__builtin_bit_cast(bf16x8, o), bq, a2[et]); }
            const float* np = NP + 32 * s + 8 * q; const f32x4 n0 = *(const f32x4*)np, n1 = *(const f32x4*)(np + 4);
            u32x4 o; o.x = pk2(n0[0], n0[1]); o.y = pk2(n0[2], n0[3]); o.z = pk2(n1[0], n1[1]); o.w = pk2(n1[2], n1[3]);
            if (l15 != 0) o = (u32x4){0u, 0u, 0u, 0u};
            a2[8] = mfma16(__builtin_bit_cast(bf16x8, o), bq, a2[8]); }
    }
    {
        const float inter = *ldsp<float>(L, LM_S + 5 * 512 + lq * 4), emt = *ldsp<float>(L, LM_S + 6 * 512 + lq * 4);
        const float den = __shfl(a1[8][0] + inter * a2[8][0], l15);
        const float rden = 1.0f / fmaxf(fabsf(den), emt);
        float s1 = 0.f;
#pragma unroll
        for (int et = 0; et < 8; ++et) { a1[et] = (a1[et] + a2[et] * inter) * rden; s1 += (a1[et][0] + a1[et][1]) + (a1[et][2] + a1[et][3]); }
        s1 += __shfl_xor(s1, 16); s1 += __shfl_xor(s1, 32);
        const float mean = s1 * (1.0f / 128.0f); float s2 = 0.f;
#pragma unroll
        for (int et = 0; et < 8; ++et) { a1[et] = a1[et] - mean; s2 += (a1[et][0] * a1[et][0] + a1[et][1] * a1[et][1]) + (a1[et][2] * a1[et][2] + a1[et][3] * a1[et][3]); }
        s2 += __shfl_xor(s2, 16); s2 += __shfl_xor(s2, 32);
        const float rstd = 1.0f / sqrtf(s2 * (1.0f / 128.0f) + 1e-5f);
        bf16* prow = P + (m0 + lq) * PW;
#pragma unroll
        for (int et = 0; et < 8; ++et) { const int e = 16 * et + 4 * q; const f32x4 lg = *(const f32x4*)(inp(F, 22) + (size_t)l * MW + h * 128 + e);
            const f32x4 og = ld4bf_g(prow + PC_MO + h * 128 + e); f32x4 o;
#pragma unroll
            for (int r = 0; r < 4; ++r) o[r] = sigmoidf_(og[r]) * (a1[et][r] * rstd * lg[r]);
            st4bf_g(prow + 512 + h * 128 + e, o); }
    }
    __syncthreads();
}

constexpr int NSTAGES = 2 + 13 * DEPTH;
#ifndef PG8_SP2
#define PG8_SP2 true
#endif
#ifndef PG8_ALIGN
#define PG8_ALIGN true
#endif
__device__ __forceinline__ void run_stage(Frame& F, int s) {
    int r = -1, l = 0;
    if (s >= 2) { r = (s - 2) % 13; l = (s - 2) / 13; }
    unsigned char* wl = wlayer(F, l);
    bf16* XN = wsp<bf16>(F, WS_XN); bf16* R = wsp<bf16>(F, WS_R);
    if (s == 0) { ph_p0(F); return; }
    if (s == 1 || r == 2 || r == 9 || r == 12) {
        const float* xin = (s == 1) ? inp(F, 0) : xout(F); int ln = l, which = 0; bool fin = false;
        if (r == 2) which = 1; else if (r == 9) which = 2; else if (r == 12) { ln = l + 1; fin = (ln >= DEPTH); }
        if (fin) ph_norm(F, xin, inp(F, 26), nullptr, nullptr, true);
        else ph_norm(F, xin, inp(F, 4) + (size_t)(ln * 3 + which) * DM, modp(F, ln, 3 * which), modp(F, ln, 3 * which + 1), false);
        return;
    }
    if (r == 0 || r == 10) {
        const int i = r == 0 ? 0 : 1;
        pg8::Gemm g{XN, (const bf16*)(wl + W_FFIN + i * W_FFIN_SZ), MTOK, 2 * FF, DM, DM}; pg8::StaticOrder S; S.init(MTOK, 2 * FF, F.G, F.bid);
        EpiSwiglu E{R};
        pg8::gemm_phase<EpiSwiglu, pg8::StaticOrder, PG8_ALIGN, PG8_SP2>(F.lds, g, S, E); return;
    }
    if (r == 1 || r == 11) {
        const int i = r == 1 ? 0 : 1;
        pg8::Gemm g{R, (const bf16*)(wl + W_FFOUT + i * W_FFOUT_SZ), MTOK, DM, FF, FF}; pg8::StaticOrder S; S.init(MTOK, DM, F.G, F.bid);
        EpiRes E{(l == 0 && i == 0) ? inp(F, 0) : xout(F), xout(F), modp(F, l, i == 0 ? 2 : 8), 0.5f};
        pg8::gemm_phase<EpiRes, pg8::StaticOrder, false, PG8_SP2>(F.lds, g, S, E); return;
    }
    if (r == 3) {
        pg8::Gemm g{XN, (const bf16*)(wl + W_MIXIN), MTOK, PW, DM, DM}; pg8::StaticOrder S; S.init(MTOK, PW, F.G, F.bid);
        EpiBf<0> E{R, PW, nullptr, 0};
        pg8::gemm_phase<EpiBf<0>, pg8::StaticOrder, PG8_ALIGN, PG8_SP2>(F.lds, g, S, E); return;
    }
    if (r == 4) {
        for (int it = F.bid; it < NIT1; it += F.G) rwkv_prep_item(F, l, it);
        for (int it = F.bid; it < NIT2; it += F.G) mlstm_m1_item(F, l, it);
        return;
    }
    if (r == 5) {
        for (int bh = F.bid; bh < NB * RH; bh += F.G) rwkv_scan_bh(F, bh);
        mlstm_m2(F, F.G > NB * RH ? NB * RH : 0);
        return;
    }
    if (r == 6) {
        for (int it = F.bid; it < NIT1; it += F.G) rwkv_out_item(F, l, it);
        for (int it = F.bid; it < NIT2; it += F.G) mlstm_m3_item(F, l, it);
        return;
    }
    if (r == 7) {
        bf16* SG = wsp<bf16>(F, WS_F + F_EV); bf16* TU = wsp<bf16>(F, WS_F + F_GV);
        { pg8::Gemm g{XN, (const bf16*)(wl + W_GATE), MTOK, 2048, DM, DM}; pg8::GateOrder S; S.init(MTOK, F.G, F.bid);
          EpiBf<1> E{SG, 2048, nullptr, 0};
          pg8::gemm_phase<EpiBf<1>, pg8::GateOrder, PG8_ALIGN, PG8_SP2>(F.lds, g, S, E); }
        { pg8::Gemm g{R, (const bf16*)(wl + W_BR), MTOK, DM, 512, PW}; pg8::StaticOrder S; S.init(MTOK, DM, F.G, F.bid);
          EpiBf<2> E{TU, DM, SG, 2048};
          pg8::gemm_phase<EpiBf<2>, pg8::StaticOrder, false, PG8_SP2>(F.lds, g, S, E); }
        { pg8::Gemm g{R + 512, (const bf16*)(wl + W_BR + W_BR_SZ), MTOK, DM, 512, PW}; pg8::StaticOrder S; S.init(MTOK, DM, F.G, F.bid);
          EpiBf<3> E{TU, DM, SG + 1024, 2048};
          pg8::gemm_phase<EpiBf<3>, pg8::StaticOrder, false, PG8_SP2>(F.lds, g, S, E); }
        return;
    }
    if (r == 8) {
        pg8::Gemm g{wsp<bf16>(F, WS_F + F_GV), (const bf16*)(wl + W_WOUT), MTOK, DM, DM, DM}; pg8::StaticOrder S; S.init(MTOK, DM, F.G, F.bid);
        EpiRes E{xout(F), xout(F), modp(F, l, 5), 1.0f};
        pg8::gemm_phase<EpiRes, pg8::StaticOrder, false, PG8_SP2>(F.lds, g, S, E); return;
    }
}

struct Args { const float* in[27]; float* out; unsigned char* ws; int s_lo, s_hi; };

#ifndef EMU
#define XB_TMO      128
#define XB_XCNT(j)  (256  + 64 * (j))
#define XB_XSUB(j)  (1280 + 64 * (j))
#define XB_XGEN(j)  (2304 + 64 * (j))
#define XB_TOP      3328
#define XB_TOPGEN   3392
#define XCD_BAR_WORDS 3456
#define XB_SPIN_CAP (1u << 18)

__device__ __forceinline__ unsigned xb_ld(unsigned* p)              { return __hip_atomic_load(p, __ATOMIC_RELAXED, __HIP_MEMORY_SCOPE_AGENT); }
__device__ __forceinline__ unsigned xb_add(unsigned* p, unsigned v) { return __hip_atomic_fetch_add(p, v, __ATOMIC_RELAXED, __HIP_MEMORY_SCOPE_AGENT); }
__device__ __forceinline__ unsigned xb_xcc_id() { return (unsigned)__builtin_amdgcn_s_getreg((3 << 11) | 20) & 0xFu; }
#define XB_SPIN(cond, bar) do { unsigned _sp = 0; while (cond) { __builtin_amdgcn_s_sleep(1); \
    if ((++_sp & 255u) == 0u) { if (xb_ld(&(bar)[XB_TMO])) break; if (_sp > XB_SPIN_CAP) { atomicAdd(&(bar)[XB_TMO], 1u); break; } } } } while (0)

struct XcdBarrier {
    unsigned* bar; unsigned x;
    volatile LAS unsigned* st;
};

__device__ __forceinline__ XcdBarrier xcd_barrier_post(unsigned* bar, volatile LAS unsigned* st) {
    XcdBarrier b; b.bar = bar; b.x = xb_xcc_id(); b.st = st;
    if (threadIdx.x == 0) (void)xb_add(&bar[XB_XCNT(b.x)], 1u);
    return b;
}
__device__ __forceinline__ void xcd_barrier_complete(unsigned* bar, unsigned x, unsigned& nloc, unsigned& nx) {
    const unsigned G = gridDim.x * gridDim.y * gridDim.z;
    unsigned sum, cnt, mine, sp = 0u;
    for (;;) {
        sum = 0u; cnt = 0u; mine = 0u;
#pragma unroll
        for (unsigned j = 0; j < 16; ++j) { const unsigned c = xb_ld(&bar[XB_XCNT(j)]); sum += c; cnt += (c > 0u) ? 1u : 0u; mine = (j == x) ? c : mine; }
        if (sum == G) break;
        __builtin_amdgcn_s_sleep(1);
        if ((++sp & 255u) == 0u) { if (xb_ld(&bar[XB_TMO])) break; if (sp > XB_SPIN_CAP) { atomicAdd(&bar[XB_TMO], 1u); break; } }
    }
    nloc = mine > 0u ? mine : 1u; nx = cnt > 0u ? cnt : 1u;
}

__device__ __forceinline__ void xcd_barrier(const XcdBarrier& b) {
    asm volatile("s_waitcnt vmcnt(0)" ::: "memory");
    __syncthreads();
    if (threadIdx.x == 0) {
        unsigned* bar = b.bar;
        __builtin_amdgcn_s_waitcnt(0);
        unsigned nloc = b.st[0], nx = b.st[1];
        if (nloc == 0u) { xcd_barrier_complete(bar, b.x, nloc, nx); b.st[0] = nloc; b.st[1] = nx; }
        const unsigned old = xb_add(&bar[XB_XSUB(b.x)], 1u);
        const unsigned gen = old / nloc;
        if (old + 1u == (gen + 1u) * nloc) {
            __builtin_amdgcn_fence(__ATOMIC_RELEASE, "agent");
            asm volatile("s_waitcnt vmcnt(0)" ::: "memory");
            const unsigned og = xb_add(&bar[XB_TOP], 1u);
            const unsigned tg = og / nx;
            if (og + 1u == (tg + 1u) * nx) xb_add(&bar[XB_TOPGEN], 1u);
            else XB_SPIN(xb_ld(&bar[XB_TOPGEN]) == tg, bar);
            __builtin_amdgcn_fence(__ATOMIC_ACQUIRE, "agent");
            xb_add(&bar[XB_XGEN(b.x)], 1u);
            asm volatile("s_waitcnt vmcnt(0)" ::: "memory");
        } else {
            XB_SPIN(xb_ld(&bar[XB_XGEN(b.x)]) == gen, bar);
            __builtin_amdgcn_fence(__ATOMIC_ACQUIRE, "agent");
            asm volatile("s_waitcnt vmcnt(0)" ::: "memory");
        }
    }
    __syncthreads();
}

#ifndef MK_N_LAUNCHES
#define MK_N_LAUNCHES 1
#endif
__global__ void __launch_bounds__(NWAVES * 64, 2) mk_fwd(Args a) {
    extern __shared__ __attribute__((aligned(16))) unsigned char lds_raw[];
    Frame F;
    F.lds = (LAS unsigned char*)lds_raw;
    F.tid = threadIdx.x; F.lane = F.tid & 63; F.wave = __builtin_amdgcn_readfirstlane(F.tid >> 6); F.G = gridDim.x; F.bid = blockIdx.x;
    if (F.tid < 27) *(const float* LAS*)(F.lds + TBL_OFF + 8 * F.tid) = a.in[F.tid];
    if (F.tid == 27) *(float* LAS*)(F.lds + TBL_OFF + 8 * 27) = a.out;
    if (F.tid == 28) *(unsigned char* LAS*)(F.lds + TBL_OFF + 8 * 28) = a.ws;
    volatile LAS unsigned* MISC = (volatile LAS unsigned*)(F.lds + MISC_OFF);
    for (int u = F.tid; u < 64; u += NWAVES * 64) MISC[u] = 0u;
    __syncthreads();
    XcdBarrier bar; bar.bar = (unsigned*)(a.ws + WS_CTL) + CW_BAR; bar.x = 0; bar.st = nullptr;
    if (a.s_hi - a.s_lo > 1) bar = xcd_barrier_post((unsigned*)(a.ws + WS_CTL) + CW_BAR, MISC + 8);
    for (int s = a.s_lo; s < a.s_hi; ++s) {
        run_stage(F, s);
        if (s + 1 < a.s_hi) { XcdBarrier b2 = bar; asm volatile("" : "+s"(b2.bar));
            xcd_barrier(b2); }
    }
}

extern "C" void kernel_launch(void* const* d_in, const int* in_sizes, int n_in, void* d_out, int out_size, void* d_ws, size_t ws_size, hipStream_t stream) {
    static int grid = 0;
    if (grid == 0) {
        if (n_in != 27 || in_sizes[0] != MTOK * DM || out_size != MTOK * DM || ws_size < WS_END) { fprintf(stderr, "kernel_launch: unexpected problem shape (n_in %d, in0 %d, out %d, ws %zu < %zu); nothing launched\n", n_in, n_in > 0 ? in_sizes[0] : -1, out_size, ws_size, (size_t)WS_END); grid = -1; return; }
        int dev = 0, cus = 0, per_cu = 0;
        if (hipGetDevice(&dev) != hipSuccess || hipDeviceGetAttribute(&cus, hipDeviceAttributeMultiprocessorCount, dev) != hipSuccess) { grid = -1; return; }
        if (hipFuncSetAttribute((const void*)mk_fwd, hipFuncAttributeMaxDynamicSharedMemorySize, LDS_BYTES) != hipSuccess) { fprintf(stderr, "kernel_launch: hipFuncSetAttribute failed\n"); grid = -1; return; }
        if (hipOccupancyMaxActiveBlocksPerMultiprocessor(&per_cu, (const void*)mk_fwd, NWAVES * 64, LDS_BYTES) != hipSuccess || per_cu < 1) { fprintf(stderr, "kernel_launch: occupancy query reports %d workgroups per CU\n", per_cu); }
        (void)hipGetLastError();
        grid = cus;
    }
    if (grid < 0) return;
    if (hipMemsetAsync((char*)d_ws + WS_CTL, 0, CTL_ZERO_BYTES, stream) != hipSuccess) return;
    Args a{};
    for (int i = 0; i < 27; ++i) a.in[i] = (const float*)d_in[i];
    a.out = (float*)d_out; a.ws = (unsigned char*)d_ws;
    if (MK_N_LAUNCHES == 1) { a.s_lo = 0; a.s_hi = NSTAGES; hipLaunchKernelGGL(mk_fwd, dim3(grid), dim3(NWAVES * 64), LDS_BYTES, stream, a); }
    else for (int s = 0; s < NSTAGES; ++s) { a.s_lo = s; a.s_hi = s + 1; hipLaunchKernelGGL(mk_fwd, dim3(grid), dim3(NWAVES * 64), LDS_BYTES, stream, a); }
}
#endif
```

```cpp
#ifndef EMU
#include <hip/hip_runtime.h>
#include <cstdio>
#include <cstdint>
#define LAS __attribute__((address_space(3)))
#define GAS __attribute__((address_space(1)))
#endif

#ifndef CFG_B
#define CFG_B 4
#endif
#ifndef CFG_T
#define CFG_T 4096
#endif

typedef unsigned short bf16;
typedef short bf16x8 __attribute__((ext_vector_type(8)));
typedef float f32x4 __attribute__((ext_vector_type(4)));
typedef float f32x2 __attribute__((ext_vector_type(2)));
typedef unsigned u32x4 __attribute__((ext_vector_type(4)));
typedef unsigned u32x2 __attribute__((ext_vector_type(2)));

constexpr int NB = CFG_B, SEQ = CFG_T, MTOK = NB * SEQ, DM = 1024, FF = 2816, DEPTH = 2;
constexpr int RH = 8, RD = 64, RW = 512, MH = 4, MD = 128, MW = 512;
constexpr int RCOLS = 1696, MCOLS = 2056, NIN = 5800, PW = 3840;
constexpr int NC1 = SEQ / 64, NC2 = SEQ / 128;
constexpr int NIT1 = NB * RH * NC1, NIT2 = NB * MH * NC2;
static_assert(MTOK % 256 == 0 && SEQ % 256 == 0, "token tiles");
constexpr int PC_R = 0, PC_K = 512, PC_V = 1024, PC_LORA = 1536, PC_GLO = 1600;
constexpr int PC_MQ = 1696, PC_MK = 2208, PC_MV = 2720, PC_MO = 3232, PC_MI = 3744, PC_MF = 3748;

constexpr size_t MiB = 1u << 20;
constexpr size_t WS_CTL = 0, CTL_ZERO_BYTES = 1 * MiB;
constexpr size_t CTL_MOD_OFF = 512 * 1024;
constexpr size_t WS_W = 1 * MiB;
constexpr size_t W_FFIN = 0, W_FFIN_SZ = (size_t)2 * FF * DM * 2;
constexpr size_t W_FFOUT = 2 * W_FFIN_SZ, W_FFOUT_SZ = (size_t)DM * FF * 2;
constexpr size_t W_MIXIN = W_FFOUT + 2 * W_FFOUT_SZ, W_MIXIN_SZ = (size_t)PW * DM * 2;
constexpr size_t W_GATE = W_MIXIN + W_MIXIN_SZ, W_GATE_SZ = (size_t)2048 * DM * 2;
constexpr size_t W_BR = W_GATE + W_GATE_SZ, W_BR_SZ = (size_t)DM * 512 * 2;
constexpr size_t W_WOUT = W_BR + 2 * W_BR_SZ, W_WOUT_SZ = (size_t)DM * DM * 2;
constexpr size_t W_SMALL = W_WOUT + W_WOUT_SZ;
constexpr size_t W_SMALL_WUP = 0, W_SMALL_AUP = 8 * 64 * 32 * 2, W_SMALL_GUP = 2 * 8 * 64 * 32 * 2, W_SMALL_SZ = 512 * 1024;
constexpr size_t W_LAYER = W_SMALL + W_SMALL_SZ;
static_assert(W_LAYER == 49 * MiB, "weight block");
constexpr size_t WS_XN = WS_W + 2 * W_LAYER;
constexpr size_t WS_R = WS_XN + (size_t)MTOK * DM * 2;
constexpr size_t WS_F = WS_R + (size_t)MTOK * PW * 2;
constexpr size_t F_GV = 0;
constexpr size_t F_EV = F_GV + (size_t)NIT1 * 16384;
constexpr size_t F_MC = F_EV + (size_t)NIT1 * 16384;
constexpr size_t F_KS = F_MC + (size_t)NIT2 * 65536;
constexpr size_t F_MSC = F_KS + (size_t)NIT2 * 512;
constexpr size_t F_RHO = F_MSC + (size_t)NIT2 * 16;
constexpr size_t F_RSQ = F_RHO + (size_t)MTOK * 32;
constexpr size_t F_BIAS = F_RSQ + (size_t)MTOK * 64;
constexpr size_t BIAS_FF = (size_t)NB * 2 * FF, BIAS_MIX = (size_t)NB * PW, BIAS_GATE = (size_t)NB * 2048, BIAS_LAYER = 2 * BIAS_FF + BIAS_MIX + BIAS_GATE;
constexpr size_t F_CS = F_BIAS + 2 * BIAS_LAYER * 4;
constexpr size_t WS_END = WS_F + F_CS + (size_t)DEPTH * 3 * NB * DM * 4;
static_assert(F_EV + (size_t)MTOK * 2048 * 2 <= F_KS, "SG overlay");
static_assert((size_t)MTOK * DM * 2 <= F_EV, "T1/U overlay");
constexpr int CW_BAR = 4096;

constexpr int LDS_BYTES = 147456;
constexpr int MISC_OFF = LDS_BYTES - 256;
constexpr int NWAVES = 8;

#ifndef PROBE_SEC
#define PROBE_SEC 0
#endif
#if PROBE_SEC && !defined(EMU)
#define PSEC_B(id) unsigned long long _tp##id = 0ull; if (PROBE_SEC == id) _tp##id = __builtin_amdgcn_s_memrealtime();
#define PSEC_E(F, id) if (PROBE_SEC == id && threadIdx.x == 0) *(LAS unsigned long long*)((F).lds + MISC_OFF + 64) += __builtin_amdgcn_s_memrealtime() - _tp##id;
#else
#define PSEC_B(id)
#define PSEC_E(F, id)
#endif
#ifdef EMU
static inline float fexp(float x) { return expf(x); }
#else
__device__ __forceinline__ float fexp(float x) { return __expf(x); }
#endif
__device__ __forceinline__ float bf2f(bf16 b) { unsigned u = ((unsigned)b) << 16; return __builtin_bit_cast(float, u); }
#ifdef EMU
__device__ __forceinline__ unsigned f2bf(float f) { unsigned u = __builtin_bit_cast(unsigned, f); return (u + 0x7fffu + ((u >> 16) & 1u)) >> 16; }
__device__ __forceinline__ unsigned pk2(float lo, float hi) { return f2bf(lo) | (f2bf(hi) << 16); }
#else
typedef __bf16 hwbf16x2 __attribute__((ext_vector_type(2)));
__device__ __forceinline__ unsigned pk2(float lo, float hi) { const f32x2 v = {lo, hi}; return __builtin_bit_cast(unsigned, __builtin_convertvector(v, hwbf16x2)); }
__device__ __forceinline__ unsigned f2bf(float f) { return pk2(f, 0.f) & 0xffffu; }
#endif
#ifdef EMU
static inline float frcp(float x) { return 1.0f / x; }
static inline float frsq(float x) { return 1.0f / sqrtf(x); }
static inline float fsqrt(float x) { return sqrtf(x); }
static inline float flog(float x) { return logf(x); }
#else
__device__ __forceinline__ float frcp(float x) { return __builtin_amdgcn_rcpf(x); }
__device__ __forceinline__ float frsq(float x) { return __builtin_amdgcn_rsqf(x); }
__device__ __forceinline__ float fsqrt(float x) { return __builtin_amdgcn_sqrtf(x); }
__device__ __forceinline__ float flog(float x) { return __logf(x); }
#endif
__device__ __forceinline__ float sigmoidf_(float x) { return frcp(1.0f + fexp(-x)); }
__device__ __forceinline__ float siluf_(float x) { return x * frcp(1.0f + fexp(-x)); }
__device__ __forceinline__ float softplusf_(float x) { return fmaxf(x, 0.f) + flog(1.0f + fexp(-fabsf(x))); }
__device__ __forceinline__ float tanhf_(float x) { return 1.0f - 2.0f * frcp(fexp(2.0f * x) + 1.0f); }

#ifdef EMU
#define WAVE_LDS_FENCE() emu::wave_sync()
#define EMU_FENCE() do {} while (0)
#define lds_barrier() __syncthreads()
#define vm_lds_barrier() __syncthreads()
static inline void glds16(const void* gsrc_lane, unsigned char* lds_wave_base) { memcpy(lds_wave_base + 16 * (emu::cur & 63), gsrc_lane, 16); }
static inline f32x4 mfma4f(float a, float b, f32x4 c) {
    int w = emu::cur >> 6, l = emu::cur & 63; emu::xf[w][l] = a; emu::xu[w][l] = __builtin_bit_cast(unsigned, b);
    emu::wave_sync();
    for (int r = 0; r < 4; ++r) { int row = 4 * (l >> 4) + r, col = l & 15; float s = 0.f;
        for (int k = 0; k < 4; ++k) s += emu::xf[w][row + 16 * k] * __builtin_bit_cast(float, emu::xu[w][col + 16 * k]);
        c[r] += s; }
    emu::wave_sync(); return c;
}
#define LAUNDER(x) do {} while (0)
#define LAUNDER_S(x) do {} while (0)
static inline f32x4 mfma16(bf16x8 a, bf16x8 b, f32x4 c) {
    int w = emu::cur >> 6, l = emu::cur & 63;
    for (int j = 0; j < 8; ++j) { emu::xa[w][l][j] = (unsigned short)a[j]; emu::xb[w][l][j] = (unsigned short)b[j]; }
    emu::wave_sync();
    for (int r = 0; r < 4; ++r) { int row = 4 * (l >> 4) + r, col = l & 15; float s = 0.f;
        for (int k = 0; k < 32; ++k) s += bf2f(emu::xa[w][row + 16 * (k >> 3)][k & 7]) * bf2f(emu::xb[w][col + 16 * (k >> 3)][k & 7]);
        c[r] += s; }
    emu::wave_sync(); return c;
}
static inline float rdlane(float v, int l) { return __shfl(v, l); }
static inline int wave_id() { return threadIdx.x >> 6; }
#else
#define WAVE_LDS_FENCE() asm volatile("s_waitcnt lgkmcnt(0)" ::: "memory")
#define EMU_FENCE() asm volatile("" ::: "memory")
#define lds_barrier() asm volatile("s_waitcnt lgkmcnt(0)\n\ts_barrier" ::: "memory")
#define vm_lds_barrier() asm volatile("s_waitcnt vmcnt(0) lgkmcnt(0)\n\ts_barrier" ::: "memory")
__device__ __forceinline__ void glds16(const void* gsrc_lane, LAS unsigned char* lds_wave_base) { __builtin_amdgcn_global_load_lds((const unsigned*)gsrc_lane, (LAS unsigned*)lds_wave_base, 16, 0, 0); }
__device__ __forceinline__ f32x4 mfma4f(float a, float b, f32x4 c) { return __builtin_amdgcn_mfma_f32_16x16x4f32(a, b, c, 0, 0, 0); }
#define LAUNDER_S(x) asm volatile("" : "+s"(x))
#define LAUNDER(x) asm volatile("" : "+v"(x))
__device__ __forceinline__ f32x4 mfma16(bf16x8 a, bf16x8 b, f32x4 c) { return __builtin_amdgcn_mfma_f32_16x16x32_bf16(a, b, c, 0, 0, 0); }
__device__ __forceinline__ float rdlane(float v, int l) { return __builtin_bit_cast(float, __builtin_amdgcn_readlane(__builtin_bit_cast(int, v), l)); }
__device__ __forceinline__ int wave_id() { return __builtin_amdgcn_readfirstlane(threadIdx.x >> 6); }
#endif
#ifdef EMU
__device__ __forceinline__ float wave_sum(float v) {
    for (int o = 1; o < 64; o <<= 1) v += __shfl_xor(v, o);
    return v;
}
#else
template <int CTRL, int ROWMASK> __device__ __forceinline__ float dpp_add(float v) {
    return v + __builtin_bit_cast(float, __builtin_amdgcn_update_dpp(0, __builtin_bit_cast(int, v), CTRL, ROWMASK, 0xf, false)); }
__device__ __forceinline__ float wave_sum(float v) {
    v = dpp_add<0xB1, 0xf>(v);
    v = dpp_add<0x4E, 0xf>(v);
    v = dpp_add<0x141, 0xf>(v);
    v = dpp_add<0x140, 0xf>(v);
    v = dpp_add<0x142, 0xa>(v);
    v = dpp_add<0x143, 0xc>(v);
    return rdlane(v, 63);
}
#endif

namespace pg8 {
#define PG8_LAS LAS
typedef unsigned short bf16_t;
constexpr int BM = 256, BK = 64, HALF = 128, HTB = HALF * BK * 2  , STAGE_BYTES = 8 * HTB, NXCD = 8, WGM = 8;
__host__ __device__ __forceinline__ int lds_byte(int r, int c) { const int st = (r >> 4) * 2 + (c >> 5), rr = r & 15, cc = c & 31, ob = rr * 64 + cc * 2; return st * 1024 + (ob ^ (((ob >> 9) & 1) << 5)); }
__host__ __device__ __forceinline__ void stage_rc(int b, int& R, int& C) { const int st = b / 1024, sb = b % 1024, swz = sb ^ (((sb >> 9) & 1) << 5); R = (st >> 1) * 16 + swz / 64; C = (st & 1) * 32 + (swz % 64) / 2; }
__host__ __device__ __forceinline__ int perm32(int rho) { const int n = rho >> 4, i = rho & 15; return 8 * (i >> 2) + 4 * n + (i & 3); }
struct Unit { int pm, pn; };
struct Gemm { const bf16_t* A; const bf16_t* Bt; int M, N, K, lda; };
struct StaticOrder {
    int nM, nN, nwg, G, c;
    __host__ __device__ void init(int M, int N, int G_, int c_) { nM = M / BM; nN = N / BM; nwg = nM * nN; G = G_; c = c_; }
    __host__ __device__ bool next(int i, Unit& u) const {
        const long L = (long)i * G + c; if (L >= nwg) return false;
        int wgid = (int)L; { const int q = nwg / NXCD, r = nwg % NXCD, xcd = wgid % NXCD, off = wgid / NXCD; wgid = (xcd < r ? xcd * (q + 1) : r * (q + 1) + (xcd - r) * q) + off; }
        const int nig = WGM * nN, gid = wgid / nig, fm = gid * WGM, gsz = (nM - fm) < WGM ? (nM - fm) : WGM;
        u.pm = fm + ((wgid % nig) % gsz); u.pn = (wgid % nig) / gsz; return true;
    }
    __device__ __forceinline__ void a_ready(const Unit&) const {}
    __device__ __forceinline__ void done(const Unit&) const {}
};
struct GateOrder {
    StaticOrder base;
    __host__ __device__ void init(int M, int G_, int c_) { base.init(M, 1024, G_, c_); }
    __host__ __device__ bool next(int i, Unit& u) const { if (!base.next(i >> 1, u)) return false; u.pn += 4 * (i & 1); return true; }
    __device__ __forceinline__ void a_ready(const Unit&) const {}
    __device__ __forceinline__ void done(const Unit&) const {}
};
#ifndef EMU
__device__ __forceinline__ unsigned cvt_pk_bf16(float lo, float hi) { unsigned r; asm volatile("v_cvt_pk_bf16_f32 %0, %1, %2" : "=v"(r) : "v"(lo), "v"(hi)); return r; }
template <class Epi, class Sched, bool ALIGN_EPI = false, bool SP2 = false>
__device__ __forceinline__ void gemm_phase(PG8_LAS unsigned char* lds, const Gemm g, const Sched& S, const Epi& E) {
    int tid_ = threadIdx.x; asm volatile("" : "+v"(tid_));
    const int tid = tid_, wid = __builtin_amdgcn_readfirstlane(tid >> 6), lane = tid & 63, wr = wid >> 2, wc = wid & 3, fr = lane & 15, fq = lane >> 4;
    const int K = g.K, nt = K / BK;
    unsigned voffA[2], voffB[2];
#pragma unroll
    for (int i = 0; i < 2; ++i) { int R, C; stage_rc(tid * 16 + i * 8192, R, C); const int Rb = Epi::PERM ? ((R & ~31) + perm32(R & 31)) : R;
        voffA[i] = (unsigned)(R * g.lda + C) * 2u; voffB[i] = (unsigned)(Rb * K + C) * 2u; }
    const size_t kstep = (size_t)(BK * 2);
    const size_t hstep = (size_t)HALF * K * 2;
    const size_t tstep = 2 * hstep; const size_t hstepA = (size_t)HALF * g.lda * 2, tstepA = 2 * hstepA;
    const unsigned ldsw = (unsigned)wid * 1024u;
    const int aoff = lds_byte(wr * 64 + fr, fq * 8), boff = lds_byte(wc * 32 + fr, fq * 8);
#define PG8_SA(b, h) (((b) * 2 + (h)) * HTB)
#define PG8_SB(b, h) ((4 + (b) * 2 + (h)) * HTB)
#define PG8_STAGE(bufoff, gbase, voff) do { _Pragma("unroll") for (int _i = 0; _i < 2; ++_i) \
        __builtin_amdgcn_global_load_lds((const unsigned*)((const char*)(gbase) + (voff)[_i]), (PG8_LAS unsigned*)(lds + (bufoff) + ldsw + _i * 8192), 16, 0, 0); } while (0)
#define PG8_LDA(dst, b, h) do { _Pragma("unroll") for (int m = 0; m < 4; ++m) _Pragma("unroll") for (int k = 0; k < 2; ++k) dst[m][k] = *(const PG8_LAS bf16x8*)(lds + PG8_SA(b, h) + aoff + m * 2048 + k * 1024); } while (0)
#define PG8_LDB(dst, b, h) do { _Pragma("unroll") for (int n = 0; n < 2; ++n) _Pragma("unroll") for (int k = 0; k < 2; ++k) dst[n][k] = *(const PG8_LAS bf16x8*)(lds + PG8_SB(b, h) + boff + n * 2048 + k * 1024); } while (0)
#define PG8_MMA(ai, bj, At, Bt) do { __builtin_amdgcn_s_setprio(1); _Pragma("unroll") for (int m = 0; m < 4; ++m) _Pragma("unroll") for (int n = 0; n < 2; ++n) _Pragma("unroll") for (int k = 0; k < 2; ++k) \
        acc[ai][bj][m][n] = __builtin_amdgcn_mfma_f32_16x16x32_bf16(Bt[n][k], At[m][k], acc[ai][bj][m][n], 0, 0, 0); __builtin_amdgcn_s_setprio(0); } while (0)
#define PG8_WAIT_V(n) asm volatile("s_waitcnt vmcnt(" #n ")" ::: "memory")
#define PG8_WAIT_L(n) asm volatile("s_waitcnt lgkmcnt(" #n ")" ::: "memory")
#define PG8_BAR __builtin_amdgcn_s_barrier()
#define PG8_SCHED __builtin_amdgcn_sched_barrier(0)
    Unit cur, nxt; int ui = 0;
    if (!S.next(0, cur)) return;
    f32x4 acc[2][2][4][2];
#pragma unroll
    for (int a = 0; a < 2; ++a)
#pragma unroll
        for (int b = 0; b < 2; ++b)
#pragma unroll
            for (int m = 0; m < 4; ++m)
#pragma unroll
                for (int n = 0; n < 2; ++n) acc[a][b][m][n] = (f32x4){0.f, 0.f, 0.f, 0.f};
    bf16x8 At[4][2], B0[2][2], B1[2][2];
    const char* cA = (const char*)g.A + (size_t)cur.pm * tstepA; const char* cB = (const char*)g.Bt + (size_t)cur.pn * tstep;
    S.a_ready(cur);
    if constexpr (SP2) {
        PG8_STAGE(PG8_SB(0, 0), cB, voffB); PG8_STAGE(PG8_SB(0, 1), cB + hstep, voffB); PG8_STAGE(PG8_SA(0, 0), cA, voffA); PG8_STAGE(PG8_SA(0, 1), cA + hstepA, voffA);
        if (wr == 1) PG8_BAR;
        PG8_WAIT_V(2); PG8_BAR;
        PG8_STAGE(PG8_SB(1, 0), cB + kstep, voffB); PG8_STAGE(PG8_SA(1, 0), cA + kstep, voffA); PG8_STAGE(PG8_SB(1, 1), cB + hstep + kstep, voffB);
        PG8_WAIT_V(6); PG8_BAR;
    } else {
        PG8_STAGE(PG8_SB(0, 0), cB, voffB); PG8_STAGE(PG8_SA(0, 0), cA, voffA); PG8_STAGE(PG8_SB(0, 1), cB + hstep, voffB); PG8_STAGE(PG8_SA(0, 1), cA + hstepA, voffA);
        if (wr == 1) PG8_BAR;
        PG8_WAIT_V(4); PG8_BAR;
        PG8_STAGE(PG8_SB(1, 0), cB + kstep, voffB); PG8_STAGE(PG8_SA(1, 0), cA + kstep, voffA); PG8_STAGE(PG8_SB(1, 1), cB + hstep + kstep, voffB);
        PG8_WAIT_V(6); PG8_BAR;
    }
    for (;;) {
        const bool has_next = S.next(ui + 1, nxt);
        const char* nA = has_next ? (const char*)g.A + (size_t)nxt.pm * tstepA : cA; const char* nB = has_next ? (const char*)g.Bt + (size_t)nxt.pn * tstep : cB;
        for (int t = 0; t < nt; t += 2) {
            const bool last = (t == nt - 2);
            const char* a1 = cA + (size_t)(t + 1) * kstep;
            const char* a2 = last ? nA : cA + (size_t)(t + 2) * kstep; const char* b2 = last ? nB : cB + (size_t)(t + 2) * kstep;
            const char* a3 = a2 + kstep; const char* b3 = b2 + kstep;
            if (last && has_next) S.a_ready(nxt);
            if constexpr (SP2) {
            PG8_LDB(B0, 0, 0); PG8_LDB(B1, 0, 1); PG8_SCHED; PG8_LDA(At, 0, 0); PG8_STAGE(PG8_SA(1, 1), a1 + hstepA, voffA);
            PG8_WAIT_V(8); PG8_WAIT_L(0); PG8_BAR; PG8_MMA(0, 0, At, B0); PG8_MMA(0, 1, At, B1); PG8_BAR; PG8_SCHED;
            PG8_LDA(At, 0, 1); PG8_STAGE(PG8_SB(0, 0), b2, voffB); PG8_STAGE(PG8_SB(0, 1), b2 + hstep, voffB); PG8_STAGE(PG8_SA(0, 0), a2, voffA);
            PG8_WAIT_V(8); PG8_WAIT_L(0); PG8_BAR; PG8_MMA(1, 0, At, B0); PG8_MMA(1, 1, At, B1); PG8_BAR; PG8_SCHED;
            PG8_LDB(B0, 1, 0); PG8_LDB(B1, 1, 1); PG8_SCHED; PG8_LDA(At, 1, 0); PG8_STAGE(PG8_SA(0, 1), a2 + hstepA, voffA);
            PG8_WAIT_V(8); PG8_WAIT_L(0); PG8_BAR; PG8_MMA(0, 0, At, B0); PG8_MMA(0, 1, At, B1); PG8_BAR; PG8_SCHED;
            PG8_LDA(At, 1, 1); PG8_STAGE(PG8_SB(1, 0), b3, voffB); PG8_STAGE(PG8_SB(1, 1), b3 + hstep, voffB); PG8_STAGE(PG8_SA(1, 0), a3, voffA);
            PG8_WAIT_V(8); PG8_WAIT_L(0); PG8_BAR; PG8_MMA(1, 0, At, B0); PG8_MMA(1, 1, At, B1); PG8_BAR; PG8_SCHED;
            } else {
            PG8_LDB(B0, 0, 0); PG8_SCHED; PG8_LDA(At, 0, 0); PG8_STAGE(PG8_SA(1, 1), a1 + hstepA, voffA);
            PG8_WAIT_L(8); PG8_BAR; PG8_WAIT_L(0); PG8_MMA(0, 0, At, B0); PG8_BAR; PG8_SCHED;
            PG8_LDB(B1, 0, 1); PG8_STAGE(PG8_SB(0, 0), b2, voffB);
            PG8_BAR; PG8_WAIT_L(0); PG8_MMA(0, 1, At, B1); PG8_BAR;
            PG8_LDA(At, 0, 1); PG8_STAGE(PG8_SA(0, 0), a2, voffA);
            PG8_BAR; PG8_WAIT_L(0); PG8_MMA(1, 0, At, B0); PG8_BAR; PG8_SCHED;
            PG8_STAGE(PG8_SB(0, 1), b2 + hstep, voffB);
            PG8_WAIT_V(6); PG8_BAR; PG8_MMA(1, 1, At, B1); PG8_BAR;
            PG8_LDB(B0, 1, 0); PG8_SCHED; PG8_LDA(At, 1, 0); PG8_STAGE(PG8_SA(0, 1), a2 + hstepA, voffA);
            PG8_WAIT_L(8); PG8_BAR; PG8_WAIT_L(0); PG8_MMA(0, 0, At, B0); PG8_BAR; PG8_SCHED;
            PG8_LDB(B1, 1, 1); PG8_STAGE(PG8_SB(1, 0), b3, voffB);
            PG8_BAR; PG8_WAIT_L(0); PG8_MMA(0, 1, At, B1); PG8_BAR;
            PG8_LDA(At, 1, 1); PG8_STAGE(PG8_SA(1, 0), a3, voffA);
            PG8_BAR; PG8_WAIT_L(0); PG8_MMA(1, 0, At, B0); PG8_BAR; PG8_SCHED;
            PG8_STAGE(PG8_SB(1, 1), b3 + hstep, voffB);
            PG8_WAIT_V(6); PG8_BAR; PG8_MMA(1, 1, At, B1); PG8_BAR;
            }
        }
        if constexpr (ALIGN_EPI) { if (wr == 0) PG8_BAR; }
        if constexpr (!Epi::AFTER_DRAIN) { E(acc, cur, wr, wc, fr, fq); S.done(cur); }
        if (!has_next) break;
#pragma unroll
        for (int a = 0; a < 2; ++a)
#pragma unroll
            for (int b = 0; b < 2; ++b)
#pragma unroll
                for (int m = 0; m < 4; ++m)
#pragma unroll
                    for (int n = 0; n < 2; ++n) acc[a][b][m][n] = (f32x4){0.f, 0.f, 0.f, 0.f};
        cur = nxt; cA = nA; cB = nB; ++ui;
        if constexpr (ALIGN_EPI) { if (wr == 1) PG8_BAR; }
    }
    PG8_WAIT_V(0);
    if constexpr (!ALIGN_EPI) { if (wr == 0) PG8_BAR; }
    PG8_BAR;
    if constexpr (Epi::AFTER_DRAIN) { E.fused(acc, cur, wr, wc, fr, fq, lds, wid, lane); S.done(cur); }
#undef PG8_SA
#undef PG8_SB
#undef PG8_STAGE
#undef PG8_LDA
#undef PG8_LDB
#undef PG8_MMA
#undef PG8_WAIT_V
#undef PG8_WAIT_L
#undef PG8_BAR
#undef PG8_SCHED
}

#else
static inline unsigned cvt_pk_bf16(float lo, float hi) { return pk2(lo, hi); }
template <class Epi, class Sched, bool ALIGN_EPI = false, bool SP2 = false>
static void gemm_phase(unsigned char* lds, const Gemm g, const Sched& S, const Epi& E) {
    if (threadIdx.x != 0) return;
    static std::vector<float> C; C.resize(256 * 256);
    Unit u;
    for (int i = 0; S.next(i, u); ++i) {
        for (int r = 0; r < 256; ++r) for (int c = 0; c < 256; ++c) { const bf16_t* a = g.A + (size_t)(u.pm * 256 + r) * g.lda; const bf16_t* b = g.Bt + (size_t)(u.pn * 256 + c) * g.K; float s = 0.f; for (int k = 0; k < g.K; ++k) s += bf2f(a[k]) * bf2f(b[k]); C[r * 256 + c] = s; }
        for (int tid = 0; tid < 512; ++tid) { const int wid = tid >> 6, lane = tid & 63, wr = wid >> 2, wc = wid & 3, fr = lane & 15, fq = lane >> 4;
            f32x4 acc[2][2][4][2];
            for (int ai = 0; ai < 2; ++ai) for (int bj = 0; bj < 2; ++bj) for (int m = 0; m < 4; ++m) for (int n = 0; n < 2; ++n) for (int e = 0; e < 4; ++e) {
                const int r = 128 * ai + 64 * wr + 16 * m + fr, c = Epi::PERM ? (128 * bj + 32 * wc + 8 * fq + 4 * n + e) : (128 * bj + 32 * wc + 16 * n + 4 * fq + e);
                acc[ai][bj][m][n][e] = C[r * 256 + c]; }
            E(acc, u, wr, wc, fr, fq); }
    }
}
#endif
}

struct Frame {
    LAS unsigned char* lds;
    int tid, lane, wave, G, bid;
};
constexpr int TBL_OFF = MISC_OFF - 256;
#ifdef EMU
__device__ __forceinline__ const float* inp(const Frame& F, int i) { return *(const float* const*)(F.lds + TBL_OFF + 8 * i); }
__device__ __forceinline__ float* xout(const Frame& F) { return *(float* const*)(F.lds + TBL_OFF + 8 * 27); }
__device__ __forceinline__ unsigned char* wsb(const Frame& F) { return *(unsigned char* const*)(F.lds + TBL_OFF + 8 * 28); }
#else
__device__ __forceinline__ const float* inp(const Frame& F, int i) { return (const float*)(*(GAS const float* const LAS*)(F.lds + TBL_OFF + 8 * i)); }
__device__ __forceinline__ float* xout(const Frame& F) { return (float*)(*(GAS float* const LAS*)(F.lds + TBL_OFF + 8 * 27)); }
__device__ __forceinline__ unsigned char* wsb(const Frame& F) { return (unsigned char*)(*(GAS unsigned char* const LAS*)(F.lds + TBL_OFF + 8 * 28)); }
#endif
__device__ __forceinline__ Frame relaunder(const Frame& F) { Frame G = F; LAUNDER(G.lane); LAUNDER_S(G.wave); LAUNDER_S(G.lds); G.tid = G.wave * 64 + G.lane; return G; }
template <class T> __device__ __forceinline__ T* wsp(const Frame& F, size_t off) { return (T*)(wsb(F) + off); }
__device__ __forceinline__ unsigned char* wlayer(const Frame& F, int l) { return wsb(F) + WS_W + (size_t)l * W_LAYER; }
__device__ __forceinline__ const float* modp(const Frame& F, int l, int chunk) { return (const float*)(wsb(F) + CTL_MOD_OFF) + (size_t)l * NB * 9216 + chunk * 1024; }
template <class T> __device__ __forceinline__ LAS T* ldsp(LAS unsigned char* base, int off) { return (LAS T*)(base + off); }

__device__ __forceinline__ void p0_item(const float* W, int ldw, int K, int src_col0, int ncols, bf16* WT, int dest_row0, LAS float* scr, int kb, int lane) {
    const int k0 = 64 * kb;
#pragma unroll 8
    for (int i = 0; i < 32; ++i) { const int kk = 2 * i + (lane >> 5), cc = lane & 31;
        scr[kk * 33 + cc] = cc < ncols ? W[(size_t)(k0 + kk) * ldw + src_col0 + cc] : 0.f; }
    WAVE_LDS_FENCE();
    const int c = lane & 7;
#pragma unroll
    for (int j = 0; j < 4; ++j) { const int n = (lane >> 3) + 8 * j; const LAS float* s = scr + (8 * c) * 33 + n;
        u32x4 o; o.x = pk2(s[0], s[33]); o.y = pk2(s[66], s[99]); o.z = pk2(s[132], s[165]); o.w = pk2(s[198], s[231]);
        *(u32x4*)(WT + (size_t)(dest_row0 + n) * K + k0 + 8 * c) = o; }
    WAVE_LDS_FENCE();
}
constexpr int P0_ITEMS_L = 5632 + 2816 + 1920 + 1024 + 512 + 512;
__device__ __forceinline__ void ph_p0(Frame& F0) {
    Frame F = relaunder(F0);
    LAS float* scr = ldsp<float>(F.lds, F.wave * 16384);
    const int gw = F.bid * NWAVES + F.wave, NGW = F.G * NWAVES, lane = F.lane;
    for (int it = gw; it < 2 * P0_ITEMS_L; it += NGW) {
        const int l = it / P0_ITEMS_L; int r = it % P0_ITEMS_L; unsigned char* wl = wlayer(F, l);
        if (r < 5632) { const int i = r / 2816, q = r % 2816, kb = q / 176, rb = q % 176, pn = rb >> 3, qq = rb & 7;
            const int sc0 = qq < 4 ? 128 * pn + 32 * qq : FF + 128 * pn + 32 * (qq - 4);
            p0_item(inp(F, 5) + (size_t)(l * 2 + i) * DM * (2 * FF), 2 * FF, DM, sc0, 32, (bf16*)(wl + W_FFIN + i * W_FFIN_SZ), 32 * rb, scr, kb, lane); continue; }
        r -= 5632;
        if (r < 2816) { const int i = r / 1408, q = r % 1408, kb = q / 32, rb = q % 32;
            p0_item(inp(F, 6) + (size_t)(l * 2 + i) * FF * DM, DM, FF, 32 * rb, 32, (bf16*)(wl + W_FFOUT + i * W_FFOUT_SZ), 32 * rb, scr, kb, lane); continue; }
        r -= 2816;
        if (r < 1920) { const int kb = r / 120, rb = r % 120; int nc = (RCOLS + MCOLS) - 32 * rb; nc = nc < 0 ? 0 : (nc > 32 ? 32 : nc);
            p0_item(inp(F, 7) + (size_t)l * DM * NIN, NIN, DM, 32 * rb, nc, (bf16*)(wl + W_MIXIN), 32 * rb, scr, kb, lane); continue; }
        r -= 1920;
        if (r < 1024) { const int kb = r / 64, rb = r % 64;
            p0_item(inp(F, 7) + (size_t)l * DM * NIN, NIN, DM, (RCOLS + MCOLS) + 32 * rb, 32, (bf16*)(wl + W_GATE), 32 * rb, scr, kb, lane); continue; }
        r -= 1024;
        if (r < 512) { const int j = r / 256, q = r % 256, kb = q / 32, rb = q % 32;
            p0_item(inp(F, 23 + j) + (size_t)l * 512 * DM, DM, 512, 32 * rb, 32, (bf16*)(wl + W_BR + j * W_BR_SZ), 32 * rb, scr, kb, lane); continue; }
        r -= 512;
        { const int kb = r / 32, rb = r % 32;
            p0_item(inp(F, 25) + (size_t)l * DM * DM, DM, DM, 32 * rb, 32, (bf16*)(wl + W_WOUT), 32 * rb, scr, kb, lane); }
    }
    for (int idx = F.bid * 512 + F.tid; idx < 2 * 81920; idx += F.G * 512) {
        const int l = idx / 81920; int r = idx % 81920; bf16* sm = (bf16*)(wlayer(F, l) + W_SMALL);
        if (r < 32768) { const int which = r >> 14, e = r & 16383, ch = e >> 5, j = e & 31;
            sm[(which ? W_SMALL_AUP : W_SMALL_WUP) / 2 + e] = (bf16)f2bf(inp(F, which ? 12 : 10)[(size_t)(l * 32 + j) * RW + ch]); }
        else { const int e = r - 32768, ch = e / 96, j = e % 96;
            sm[W_SMALL_GUP / 2 + e] = (bf16)f2bf(inp(F, 13)[(size_t)(l * 96 + j) * RW + ch]); }
    }
    float* mod = (float*)(wsb(F) + CTL_MOD_OFF);
    for (int it = F.bid; it < DEPTH * 36; it += F.G) {
        const int l = it / 36, cg = it % 36, c0 = 256 * cg + 4 * lane, k0 = 128 * F.wave;
        f32x4 acc[NB];
#pragma unroll
        for (int b = 0; b < NB; ++b) acc[b] = (f32x4){0.f, 0.f, 0.f, 0.f};
        for (int half = 0; half < 2; ++half) {
            float cb[NB];
#pragma unroll
            for (int b = 0; b < NB; ++b) cb[b] = siluf_(inp(F, 1)[b * DM + k0 + 64 * half + lane]);
            const float* wp = inp(F, 2) + ((size_t)l * DM + k0 + 64 * half) * 9216 + c0;
#pragma unroll 8
            for (int kk = 0; kk < 64; ++kk) { const f32x4 w4 = *(const f32x4*)(wp + (size_t)kk * 9216);
#pragma unroll
                for (int b = 0; b < NB; ++b) acc[b] += w4 * rdlane(cb[b], kk); }
        }
        LAS float* part = ldsp<float>(F.lds, F.wave * 16384 + 8448);
#pragma unroll
        for (int b = 0; b < NB; ++b) *(LAS f32x4*)(part + b * 256 + 4 * lane) = acc[b];
        lds_barrier();
        for (int o = F.tid; o < NB * 256; o += 512) { const int b = o >> 8, cc = o & 255; float s = inp(F, 3)[(size_t)l * 9216 + 256 * cg + cc];
#pragma unroll
            for (int ww = 0; ww < NWAVES; ++ww) s += *ldsp<float>(F.lds, ww * 16384 + 8448 + (b * 256 + cc) * 4);
            mod[((size_t)l * NB + b) * 9216 + 256 * cg + cc] = s; }
        lds_barrier();
    }
}

__device__ __forceinline__ float* rowsq16(const Frame& F) { return wsp<float>(F, WS_F + F_RSQ); }
__device__ __forceinline__ float row_rstd(const float* rsq, size_t m) {
    const f32x4* p = (const f32x4*)(rsq + m * 16); const f32x4 a = p[0], b = p[1], c = p[2], d = p[3];
    const float s = ((a[0] + a[1]) + (a[2] + a[3])) + ((b[0] + b[1]) + (b[2] + b[3])) + (((c[0] + c[1]) + (c[2] + c[3])) + ((d[0] + d[1]) + (d[2] + d[3])));
    return frsq(s * (1.0f / DM) + 1e-6f);
}
__device__ __forceinline__ void ph_prenorm(Frame& F0, const float* xin, const float* g, const float* sc) {
    Frame F = relaunder(F0);
    const int gw = F.bid * NWAVES + F.wave, NGW = F.G * NWAVES, lane = F.lane;
    bf16* XN = wsp<bf16>(F, WS_XN); float* rsq = rowsq16(F);
    for (int m = gw; m < MTOK; m += NGW) {
        const int b = m / SEQ; const f32x4* xr = (const f32x4*)(xin + (size_t)m * DM) + lane;
        f32x4 v[4]; float s = 0.f;
#pragma unroll
        for (int j = 0; j < 4; ++j) { v[j] = xr[64 * j]; s += (v[j][0] * v[j][0] + v[j][1] * v[j][1]) + (v[j][2] * v[j][2] + v[j][3] * v[j][3]); }
        s = wave_sum(s);
        if (lane < 16) rsq[(size_t)m * 16 + lane] = lane == 0 ? s : 0.f;
#pragma unroll
        for (int j = 0; j < 4; ++j) { const int c = 4 * lane + 256 * j; const f32x4 gg = *(const f32x4*)(g + c), s1 = *(const f32x4*)(sc + (size_t)b * 9216 + c);
            const f32x4 y = v[j] * gg * (s1 + 1.0f);
            u32x2 o; o.x = pk2(y[0], y[1]); o.y = pk2(y[2], y[3]); *(u32x2*)(XN + (size_t)m * DM + c) = o; }
    }
}
__device__ __forceinline__ void ph_finalnorm(Frame& F0, const float* g) {
    Frame F = relaunder(F0);
    const int gw = F.bid * NWAVES + F.wave, NGW = F.G * NWAVES, lane = F.lane;
    float* X = xout(F); const float* rsq = rowsq16(F);
    for (int m = gw; m < MTOK; m += NGW) {
        const float rstd = row_rstd(rsq, (size_t)m);
#pragma unroll
        for (int j = 0; j < 4; ++j) { f32x4* p = (f32x4*)(X + (size_t)m * DM) + lane + 64 * j; const f32x4 gg = *((const f32x4*)g + lane + 64 * j); *p = *p * rstd * gg; }
    }
}
__device__ __forceinline__ void ph_bias(Frame& F0) {
    Frame F = relaunder(F0);
    const int gw = F.bid * NWAVES + F.wave, NGW = F.G * NWAVES, lane = F.lane;
    for (int i = F.bid * 512 + F.tid; i < DEPTH * 3 * NB * DM; i += F.G * 512) { const int c = i % DM, b = (i / DM) % NB, wch = (i / (DM * NB)) % 3, l = i / (DM * NB * 3);
        wsp<float>(F, WS_F + F_CS)[i] = inp(F, 4)[(size_t)(l * 3 + wch) * DM + c] * (1.0f + modp(F, l, 3 * wch + 1)[(size_t)b * 9216 + c]); }
    constexpr int ROWS_L = 2 * (2 * FF) + PW + 2048;
    for (int it = gw; it < DEPTH * ROWS_L; it += NGW) {
        const int l = it / ROWS_L; int r = it % ROWS_L; unsigned char* wl = wlayer(F, l);
        const bf16* wrow; const float* sh; float* out; int ldo;
        float* bl = wsp<float>(F, WS_F + F_BIAS) + (size_t)l * BIAS_LAYER;
        if (r < 2 * FF) { wrow = (const bf16*)(wl + W_FFIN) + (size_t)r * DM; sh = modp(F, l, 0); out = bl + r; ldo = 2 * FF; }
        else if (r < 4 * FF) { r -= 2 * FF; wrow = (const bf16*)(wl + W_FFIN + W_FFIN_SZ) + (size_t)r * DM; sh = modp(F, l, 6); out = bl + BIAS_FF + r; ldo = 2 * FF; }
        else if (r < 4 * FF + PW) { r -= 4 * FF; wrow = (const bf16*)(wl + W_MIXIN) + (size_t)r * DM; sh = modp(F, l, 3); out = bl + 2 * BIAS_FF + r; ldo = PW; }
        else { r -= 4 * FF + PW; wrow = (const bf16*)(wl + W_GATE) + (size_t)r * DM; sh = modp(F, l, 3); out = bl + 2 * BIAS_FF + BIAS_MIX + r; ldo = 2048; }
        const u32x4 w0 = *(const u32x4*)(wrow + 8 * lane), w1 = *(const u32x4*)(wrow + 512 + 8 * lane);
        float wf[16];
#pragma unroll
        for (int e = 0; e < 4; ++e) { wf[2 * e] = bf2f((bf16)(w0[e] & 0xffffu)); wf[2 * e + 1] = bf2f((bf16)(w0[e] >> 16)); wf[8 + 2 * e] = bf2f((bf16)(w1[e] & 0xffffu)); wf[8 + 2 * e + 1] = bf2f((bf16)(w1[e] >> 16)); }
#pragma unroll
        for (int b = 0; b < NB; ++b) { const float* sb = sh + (size_t)b * 9216; const f32x4 s0 = *(const f32x4*)(sb + 8 * lane), s1 = *(const f32x4*)(sb + 8 * lane + 4), s2 = *(const f32x4*)(sb + 512 + 8 * lane), s3 = *(const f32x4*)(sb + 512 + 8 * lane + 4);
            float acc = 0.f;
#pragma unroll
            for (int e = 0; e < 4; ++e) acc += wf[e] * s0[e] + wf[4 + e] * s1[e] + wf[8 + e] * s2[e] + wf[12 + e] * s3[e];
            acc = wave_sum(acc);
            if (lane == 0) out[(size_t)b * ldo] = acc; }
    }
}

struct EpiSwiglu {
    static constexpr bool PERM = true, AFTER_DRAIN = false; bf16* H; const float* rsq; const float* bias;
    __device__ __forceinline__ void operator()(const f32x4 (&acc)[2][2][4][2], const pg8::Unit& u, int wr, int wc, int fr, int fq) const {
        const int row0 = u.pm * 256 + wr * 64 + fr, col0 = u.pn * 128 + wc * 32 + 8 * fq, b = (u.pm * 256) / SEQ;
        const float* bp = bias + (size_t)b * (2 * FF) + u.pn * 256 + wc * 32 + 8 * fq;
        f32x4 bg[2], bu[2];
#pragma unroll
        for (int n = 0; n < 2; ++n) { bg[n] = *(const f32x4*)(bp + 4 * n); bu[n] = *(const f32x4*)(bp + 128 + 4 * n); }
#pragma unroll
        for (int ai = 0; ai < 2; ++ai)
#pragma unroll
            for (int m = 0; m < 4; ++m) { const size_t r = (size_t)(row0 + ai * 128 + m * 16); const float rstd = row_rstd(rsq, r); float hh[8];
#pragma unroll
                for (int n = 0; n < 2; ++n)
#pragma unroll
                    for (int e = 0; e < 4; ++e) hh[4 * n + e] = siluf_(acc[ai][0][m][n][e] * rstd + bg[n][e]) * (acc[ai][1][m][n][e] * rstd + bu[n][e]);
                u32x4 o; o.x = pk2(hh[0], hh[1]); o.y = pk2(hh[2], hh[3]); o.z = pk2(hh[4], hh[5]); o.w = pk2(hh[6], hh[7]);
                *(u32x4*)(H + r * FF + col0) = o; }
    }
};
template <bool HALF> struct EpiRes {
    static constexpr bool PERM = false, AFTER_DRAIN = false; const float* Xin; float* Xout; const float* gate; bf16* XS; const float* csn; float* rsq;
    __device__ __forceinline__ void operator()(const f32x4 (&acc)[2][2][4][2], const pg8::Unit& u, int wr, int wc, int fr, int fq) const {
        const int row0 = u.pm * 256 + wr * 64 + fr, col0 = u.pn * 256 + wc * 32 + 4 * fq, b = (u.pm * 256) / SEQ;
        f32x4 gv[2][2]; const float* csb = csn ? csn + (size_t)b * DM + col0 : nullptr;
#pragma unroll
        for (int bj = 0; bj < 2; ++bj)
#pragma unroll
            for (int n = 0; n < 2; ++n) { const int c = col0 + bj * 128 + n * 16; gv[bj][n] = (*(const f32x4*)(gate + (size_t)b * 9216 + c) + 1.0f) * (HALF ? 0.5f : 1.0f); }
        f32x4 xa[2][2], xb[2][2]; float ss[8];
#define EPIRES_LOAD(dst, g) { const size_t off_ = (size_t)(row0 + ((g) >> 2) * 128 + ((g) & 3) * 16) * DM + col0; _Pragma("unroll") for (int bj = 0; bj < 2; ++bj) _Pragma("unroll") for (int n = 0; n < 2; ++n) dst[bj][n] = *(const f32x4*)(Xin + off_ + bj * 128 + n * 16); }
#define EPIRES_DO(src, g) { const size_t off_ = (size_t)(row0 + ((g) >> 2) * 128 + ((g) & 3) * 16) * DM + col0; float s_ = 0.f; \
            _Pragma("unroll") for (int bj = 0; bj < 2; ++bj) _Pragma("unroll") for (int n = 0; n < 2; ++n) { const f32x4 x = src[bj][n] + gv[bj][n] * acc[(g) >> 2][bj][(g) & 3][n]; *(f32x4*)(Xout + off_ + bj * 128 + n * 16) = x; \
                s_ += (x[0] * x[0] + x[1] * x[1]) + (x[2] * x[2] + x[3] * x[3]); \
                if (csn) { const f32x4 y = x * *(const f32x4*)(csb + bj * 128 + n * 16); u32x2 o; o.x = pk2(y[0], y[1]); o.y = pk2(y[2], y[3]); *(u32x2*)(XS + off_ + bj * 128 + n * 16) = o; } } \
            ss[g] = s_; }
        EPIRES_LOAD(xa, 0) EMU_FENCE();
        EPIRES_LOAD(xb, 1) EMU_FENCE(); EPIRES_DO(xa, 0)
        EPIRES_LOAD(xa, 2) EMU_FENCE(); EPIRES_DO(xb, 1)
        EPIRES_LOAD(xb, 3) EMU_FENCE(); EPIRES_DO(xa, 2)
        EPIRES_LOAD(xa, 4) EMU_FENCE(); EPIRES_DO(xb, 3)
        EPIRES_LOAD(xb, 5) EMU_FENCE(); EPIRES_DO(xa, 4)
        EPIRES_LOAD(xa, 6) EMU_FENCE(); EPIRES_DO(xb, 5)
        EPIRES_LOAD(xb, 7) EMU_FENCE(); EPIRES_DO(xa, 6)
        EPIRES_DO(xb, 7)
#undef EPIRES_LOAD
#undef EPIRES_DO
#pragma unroll
        for (int g = 0; g < 8; ++g) { float* rp = rsq + (size_t)(row0 + (g >> 2) * 128 + (g & 3) * 16) * 16 + u.pn * 4 + wc;
#ifdef EMU
            if (fq == 0) *rp = ss[g]; else *rp += ss[g];
#else
            float s = ss[g]; s += __shfl_xor(s, 16); s += __shfl_xor(s, 32);
            if (fq == 0) *rp = s;
#endif
        }
    }
};
template <int MODE  > struct EpiBf {
    static constexpr bool PERM = true, AFTER_DRAIN = false; bf16* O; int ldo; const bf16* S1; int lds1; const float* rsq; const float* bias; int ldb;
    __device__ __forceinline__ void operator()(const f32x4 (&acc)[2][2][4][2], const pg8::Unit& u, int wr, int wc, int fr, int fq) const {
        const int row0 = u.pm * 256 + wr * 64 + fr, col0 = u.pn * 256 + wc * 32 + 8 * fq, b = (u.pm * 256) / SEQ;
        f32x4 bv[2][2];
        if (MODE <= 1) {
#pragma unroll
            for (int bj = 0; bj < 2; ++bj)
#pragma unroll
                for (int n = 0; n < 2; ++n) bv[bj][n] = *(const f32x4*)(bias + (size_t)b * ldb + col0 + bj * 128 + 4 * n); }
#pragma unroll
        for (int ai = 0; ai < 2; ++ai)
#pragma unroll
            for (int m = 0; m < 4; ++m) { const size_t r = (size_t)(row0 + ai * 128 + m * 16); float rstd = 1.f; if (MODE <= 1) rstd = row_rstd(rsq, r);
#pragma unroll
                for (int bj = 0; bj < 2; ++bj) { float v[8];
#pragma unroll
                    for (int n = 0; n < 2; ++n)
#pragma unroll
                        for (int e = 0; e < 4; ++e) v[4 * n + e] = MODE <= 1 ? acc[ai][bj][m][n][e] * rstd + bv[bj][n][e] : acc[ai][bj][m][n][e];
                    bf16* op = O + r * ldo + col0 + bj * 128;
                    if (MODE == 1) {
#pragma unroll
                        for (int e = 0; e < 8; ++e) v[e] = sigmoidf_(v[e]); }
                    if (MODE >= 2) { const u32x4 s = *(const u32x4*)(S1 + r * lds1 + col0 + bj * 128);
#pragma unroll
                        for (int e = 0; e < 4; ++e) { v[2 * e] *= bf2f((bf16)(s[e] & 0xffffu)); v[2 * e + 1] *= bf2f((bf16)(s[e] >> 16)); } }
                    if (MODE == 3) { const u32x4 o = *(const u32x4*)op;
#pragma unroll
                        for (int e = 0; e < 4; ++e) { v[2 * e] += bf2f((bf16)(o[e] & 0xffffu)); v[2 * e + 1] += bf2f((bf16)(o[e] >> 16)); } }
                    u32x4 w; w.x = pk2(v[0], v[1]); w.y = pk2(v[2], v[3]); w.z = pk2(v[4], v[5]); w.w = pk2(v[6], v[7]);
                    *(u32x4*)op = w; }
                if (MODE >= 2) EMU_FENCE(); }
    }
};

constexpr int RP = 72, RBUF = 64 * RP * 2;
constexpr int L4_AT = 0, L4_RT = RBUF, L4_BT = 2 * RBUF, L4_KT = 3 * RBUF, L4_KH = 4 * RBUF, L4_AC = 5 * RBUF, L4_BC = 6 * RBUF, L4_VC = 7 * RBUF;
constexpr int L4_NM = 8 * RBUF, L4_PT = 9 * RBUF, L4_MF = 10 * RBUF  , L4_TOT = L4_MF + 64 * 68 * 4  , L4_GCX = L4_TOT + 2048  , L4_XS = L4_GCX + 256  ;
constexpr int L4_WR = 8 * RBUF  , L4_AP = L4_WR + 64 * 65 * 4, L4_LORA = L4_AT;
constexpr int L4_TT = L4_AT, L4_WM = L4_BT, L4_NTM = L4_KT, L4_HT = L4_NM, L4_FT = L4_AC;
constexpr int L4_TL = L4_BT;
static_assert(L4_AP + 64 * 65 * 4 <= L4_TOT && L4_XS + 3 * 16 * 17 * 4 <= MISC_OFF - 256 && 64 * 68 * 4 <= 2 * RBUF, "RWKV LDS map");

__device__ __forceinline__ bf16x8 ldfrag(const LAS unsigned char* base, int off, int row, int col) { return *(const LAS bf16x8*)(base + off + (row * RP + col) * 2); }
__device__ __forceinline__ void st4bf(LAS unsigned char* base, int off, int row, int col, f32x4 v) { u32x2 o; o.x = pk2(v[0], v[1]); o.y = pk2(v[2], v[3]); *(LAS u32x2*)(base + off + (row * RP + col) * 2) = o; }
__device__ __forceinline__ void st4bf_g(bf16* p, f32x4 v) { u32x2 o; o.x = pk2(v[0], v[1]); o.y = pk2(v[2], v[3]); *(u32x2*)p = o; }
__device__ __forceinline__ f32x4 ld4bf_g(const bf16* p) { const u32x2 o = *(const u32x2*)p; return (f32x4){bf2f((bf16)(o.x & 0xffffu)), bf2f((bf16)(o.x >> 16)), bf2f((bf16)(o.y & 0xffffu)), bf2f((bf16)(o.y >> 16))}; }

struct PrepRaw { bf16 x[4][9]; float mu[4]; float prm[5]; bf16x8 bw[2], ba[2]; };
__device__ __forceinline__ void rwkv_prep_fetch(const Frame& F, int l, int item, PrepRaw& R) {
    const int c = item % NC1, bh = item / NC1, h = bh % RH, b = bh / RH;
    const int lane = F.lane, w = F.wave, l15 = lane & 15, q = lane >> 4, cb0 = 2 * (w & 1), t0 = 8 * w, ch = h * 64 + lane;
    const size_t m0 = (size_t)b * SEQ + (size_t)c * 64;
    const bf16* P = wsp<bf16>(F, WS_R);
    if (c * 64 + t0 > 0) { const bf16* row = P + (m0 + t0 - 1) * PW; R.x[0][0] = row[PC_R + ch]; R.x[1][0] = row[PC_K + ch]; R.x[2][0] = row[PC_V + ch]; R.x[3][0] = row[PC_LORA + lane]; }
    else { R.x[0][0] = 0; R.x[1][0] = 0; R.x[2][0] = 0; R.x[3][0] = 0; }
#pragma unroll
    for (int i = 0; i < 8; ++i) { const bf16* row = P + (m0 + t0 + i) * PW; R.x[0][1 + i] = row[PC_R + ch]; R.x[1][1 + i] = row[PC_K + ch]; R.x[2][1 + i] = row[PC_V + ch]; R.x[3][1 + i] = row[PC_LORA + lane]; }
    const float* mu = inp(F, 8) + (size_t)l * RCOLS;
    R.mu[0] = mu[PC_R + ch]; R.mu[1] = mu[PC_K + ch]; R.mu[2] = mu[PC_V + ch]; R.mu[3] = mu[PC_LORA + lane];
    R.prm[0] = inp(F, 9)[(size_t)l * RW + ch]; R.prm[1] = inp(F, 11)[(size_t)l * RW + ch]; R.prm[2] = inp(F, 14)[(size_t)l * RW + ch]; R.prm[3] = inp(F, 15)[(size_t)l * RW + ch]; R.prm[4] = inp(F, 16)[(size_t)l * RW + ch];
    const bf16* sm = (const bf16*)(wlayer(F, l) + W_SMALL);
#pragma unroll
    for (int cbi = 0; cbi < 2; ++cbi) { const int kc = 16 * (cb0 + cbi) + l15;
        R.bw[cbi] = *(const bf16x8*)(sm + W_SMALL_WUP / 2 + (size_t)(h * 64 + kc) * 32 + 8 * q); R.ba[cbi] = *(const bf16x8*)(sm + W_SMALL_AUP / 2 + (size_t)(h * 64 + kc) * 32 + 8 * q); }
}
__device__ __forceinline__ void rwkv_prep_item(Frame& F0, int l, int item, PrepRaw& raw, int next_item) {
    Frame F = relaunder(F0);
    const int c = item % NC1, bh = item / NC1, h = bh % RH, b = bh / RH;
    const int lane = F.lane, w = F.wave, l15 = lane & 15, q = lane >> 4, rb = w >> 1, cb0 = 2 * (w & 1), t0 = 8 * w;
    const size_t m0 = (size_t)b * SEQ + (size_t)c * 64;
    LAS unsigned char* L = F.lds;
    const f32x4 z4 = (f32x4){0.f, 0.f, 0.f, 0.f};
    LAUNDER_S(L);
    PSEC_B(21)
    float rs[8], ks[8], vs[8];
#pragma unroll
    for (int i = 0; i < 8; ++i) {
        const float xr = bf2f(raw.x[0][1 + i]), xk = bf2f(raw.x[1][1 + i]), xv = bf2f(raw.x[2][1 + i]), xl = bf2f(raw.x[3][1 + i]);
        rs[i] = xr + (bf2f(raw.x[0][i]) - xr) * raw.mu[0]; ks[i] = xk + (bf2f(raw.x[1][i]) - xk) * raw.mu[1]; vs[i] = xv + (bf2f(raw.x[2][i]) - xv) * raw.mu[2];
        const float ls = xl + (bf2f(raw.x[3][i]) - xl) * raw.mu[3];
        *ldsp<bf16>(L, L4_LORA + ((t0 + i) * RP + lane) * 2) = (bf16)f2bf(lane < 32 ? tanhf_(ls) : ls); }
    const float w0 = raw.prm[0], a0 = raw.prm[1], kkw = raw.prm[2], kaw = raw.prm[3], rkw = raw.prm[4];
    const bf16x8 bw0 = raw.bw[0], bw1 = raw.bw[1], ba0 = raw.ba[0], ba1 = raw.ba[1];
    if (next_item >= 0) rwkv_prep_fetch(F, l, next_item, raw);
    lds_barrier();
    LAUNDER_S(L);
    PSEC_E(F, 21)
    PSEC_B(22)
    {
        const bf16x8 aw = ldfrag(L, L4_LORA, 16 * rb + l15, 8 * q), aa = ldfrag(L, L4_LORA, 16 * rb + l15, 32 + 8 * q);
#pragma unroll
        for (int cbi = 0; cbi < 2; ++cbi) { const int kc = 16 * (cb0 + cbi) + l15;
            const f32x4 cw = mfma16(aw, cbi ? bw1 : bw0, z4), ca = mfma16(aa, cbi ? ba1 : ba0, z4);
#pragma unroll
            for (int r = 0; r < 4; ++r) { *ldsp<float>(L, L4_WR + ((16 * rb + 4 * q + r) * 65 + kc) * 4) = cw[r]; *ldsp<float>(L, L4_AP + ((16 * rb + 4 * q + r) * 65 + kc) * 4) = ca[r]; } }
    }
    lds_barrier();
    LAUNDER_S(L);
    PSEC_E(F, 22)
    PSEC_B(23)
    float ar[8], br[8], k2[8], ld[8], gin[8];
    {
        float cs = 0.f;
#pragma unroll
        for (int i = 0; i < 8; ++i) { const int t = t0 + i;
            const float wraw = w0 + *ldsp<float>(L, L4_WR + (t * 65 + lane) * 4);
            const float wl = -softplusf_(-wraw) - 0.5f; ld[i] = -fexp(wl);
            const float a = sigmoidf_(a0 + *ldsp<float>(L, L4_AP + (t * 65 + lane) * 4));
            float kk = ks[i] * kkw; const float nrm = fsqrt(wave_sum(kk * kk)); kk = kk * frcp(fmaxf(nrm, 1e-12f));
            k2[i] = ks[i] * (1.0f + (a - 1.0f) * kaw);
            const float rho = wave_sum(rs[i] * k2[i] * rkw);
            if (lane == 0) wsp<float>(F, WS_F + F_RHO)[(m0 + t) * 8 + h] = rho;
            ar[i] = -kk; br[i] = kk * a; cs += ld[i]; gin[i] = cs; }
        *ldsp<float>(L, L4_TOT + (w * 64 + lane) * 4) = cs;
    }
    lds_barrier();
    LAUNDER_S(L);
    PSEC_E(F, 23)
    PSEC_B(24)
    {
        float pre = 0.f, gC = 0.f;
#pragma unroll
        for (int ww = 0; ww < 8; ++ww) { const float tv = *ldsp<float>(L, L4_TOT + (ww * 64 + lane) * 4); gC += tv; if (ww < w) pre += tv; }
        if (w == 0) *ldsp<float>(L, L4_GCX + lane * 4) = fexp(gC);
        float acv[8], bcv[8];
#pragma unroll
        for (int i = 0; i < 8; ++i) { const int t = t0 + i; const float gi = pre + gin[i], ge = gi - ld[i];
            const float e_gi = fexp(gi), e_ngi = fexp(-gi), e_ge = fexp(ge), e_c = fexp(gC - gi);
            const float at = ar[i] * e_ge; acv[i] = at; bcv[i] = br[i] * e_c;
            *ldsp<bf16>(L, L4_AT + (t * RP + lane) * 2) = (bf16)f2bf(at);
            *ldsp<bf16>(L, L4_RT + (t * RP + lane) * 2) = (bf16)f2bf(rs[i] * e_gi);
            *ldsp<bf16>(L, L4_BT + (t * RP + lane) * 2) = (bf16)f2bf(br[i] * e_ngi);
            *ldsp<bf16>(L, L4_KT + (t * RP + lane) * 2) = (bf16)f2bf(k2[i] * e_ngi);
            *ldsp<bf16>(L, L4_KH + (t * RP + lane) * 2) = (bf16)f2bf(k2[i] * e_c); }
        u32x4 o;
        o.x = pk2(acv[0], acv[1]); o.y = pk2(acv[2], acv[3]); o.z = pk2(acv[4], acv[5]); o.w = pk2(acv[6], acv[7]); *ldsp<u32x4>(L, L4_AC + (lane * RP + t0) * 2) = o;
        o.x = pk2(bcv[0], bcv[1]); o.y = pk2(bcv[2], bcv[3]); o.z = pk2(bcv[4], bcv[5]); o.w = pk2(bcv[6], bcv[7]); *ldsp<u32x4>(L, L4_BC + (lane * RP + t0) * 2) = o;
        o.x = pk2(vs[0], vs[1]); o.y = pk2(vs[2], vs[3]); o.z = pk2(vs[4], vs[5]); o.w = pk2(vs[6], vs[7]); *ldsp<u32x4>(L, L4_VC + (lane * RP + t0) * 2) = o;
    }
    lds_barrier();
    LAUNDER_S(L);
    PSEC_E(F, 24)
    PSEC_B(25)
    f32x4 qreg[2];
    {
        bf16x8 aA[2], aB[2], aK[2];
#pragma unroll
        for (int s = 0; s < 2; ++s) { aA[s] = ldfrag(L, L4_AT, 16 * rb + l15, 32 * s + 8 * q); aB[s] = ldfrag(L, L4_BT, 16 * rb + l15, 32 * s + 8 * q); aK[s] = ldfrag(L, L4_KT, 16 * rb + l15, 32 * s + 8 * q); }
#pragma unroll
        for (int cbi = 0; cbi < 2; ++cbi) { const int cb = cb0 + cbi, cc = 16 * cb + l15, r0 = 16 * rb + 4 * q;
            f32x4 cm = z4, cn = z4, cp = z4, cq = z4;
#pragma unroll
            for (int s = 0; s < 2; ++s) { const bf16x8 bB = ldfrag(L, L4_BT, cc, 32 * s + 8 * q), bK = ldfrag(L, L4_KT, cc, 32 * s + 8 * q), bR = ldfrag(L, L4_RT, cc, 32 * s + 8 * q);
                cm = mfma16(aA[s], bB, cm); cn = mfma16(aA[s], bK, cn); cp = mfma16(aB[s], bR, cp); cq = mfma16(aK[s], bR, cq); }
#pragma unroll
            for (int r = 0; r < 4; ++r) { const int rr = r0 + r;
                if (!(cc < rr)) { cm[r] = 0.f; cn[r] = 0.f; }
                if (!(rr <= cc)) { cp[r] = 0.f; cq[r] = 0.f; } }
            *ldsp<f32x4>(L, L4_MF + (cc * 68 + r0) * 4) = cm;
            st4bf(L, L4_NM, cc, r0, cn);
            st4bf(L, L4_PT, cc, r0, cp);
            qreg[cbi] = cq; }
    }
    lds_barrier();
    LAUNDER_S(L);
    PSEC_E(F, 25)
    PSEC_B(26)
    if (w == 0) {
        int lnq = lane; LAUNDER(lnq);
        const int I16 = 16 * (lnq >> 4), tt = lnq & 15;
        float acc[16];
#pragma unroll
        for (int r = 0; r < 16; ++r) acc[r] = (r == tt) ? 1.0f : 0.0f;
#pragma unroll
        for (int r = 14; r >= 0; --r) {
#pragma unroll
            for (int g = (r + 1) >> 2; g < 4; ++g) { const f32x4 m4 = *ldsp<f32x4>(L, L4_MF + ((I16 + r) * 68 + I16 + 4 * g) * 4);
#pragma unroll
                for (int e = 0; e < 4; ++e) if (4 * g + e > r) acc[r] += m4[e] * acc[4 * g + e]; } }
#pragma unroll
        for (int r = 0; r < 16; ++r) *ldsp<float>(L, L4_TL + ((I16 + r) * 68 + I16 + tt) * 4) = acc[r];
    }
    lds_barrier();
    LAUNDER_S(L);
#pragma unroll
    for (int dd = 1; dd < 4; ++dd) {
        if (w < 4 - dd) { const int I16 = 16 * w, J16 = 16 * (w + dd);
            f32x4 x = z4;
            for (int K16 = I16; K16 < J16; K16 += 16) {
#pragma unroll
                for (int s = 0; s < 4; ++s) x = mfma4f(*ldsp<float>(L, L4_TL + ((I16 + l15) * 68 + K16 + 4 * s + q) * 4), *ldsp<float>(L, L4_MF + ((K16 + 4 * s + q) * 68 + J16 + l15) * 4), x); }
#pragma unroll
            for (int r = 0; r < 4; ++r) *ldsp<float>(L, L4_XS + (w * 272 + (4 * q + r) * 17 + l15) * 4) = x[r];
            WAVE_LDS_FENCE();
            f32x4 y = z4;
#pragma unroll
            for (int s = 0; s < 4; ++s) y = mfma4f(*ldsp<float>(L, L4_XS + (w * 272 + l15 * 17 + 4 * s + q) * 4), *ldsp<float>(L, L4_TL + ((J16 + 4 * s + q) * 68 + J16 + l15) * 4), y);
#pragma unroll
            for (int r = 0; r < 4; ++r) *ldsp<float>(L, L4_TL + ((I16 + 4 * q + r) * 68 + J16 + l15) * 4) = y[r];
        }
        lds_barrier();
    }
    {
        const int t = F.tid >> 3, g = F.tid & 7; float tv[8];
#pragma unroll
        for (int e = 0; e < 8; ++e) { const int j = 8 * g + e; tv[e] = (j >> 4) <= (t >> 4) ? *ldsp<float>(L, L4_TL + (j * 68 + t) * 4) : 0.0f; }
        u32x4 o; o.x = pk2(tv[0], tv[1]); o.y = pk2(tv[2], tv[3]); o.z = pk2(tv[4], tv[5]); o.w = pk2(tv[6], tv[7]);
        *ldsp<u32x4>(L, L4_TT + (t * RP + 8 * g) * 2) = o;
    }
    lds_barrier();
    LAUNDER_S(L);
    PSEC_E(F, 26)
    PSEC_B(27)
    {
        bf16x8 aT[2];
#pragma unroll
        for (int s = 0; s < 2; ++s) aT[s] = ldfrag(L, L4_TT, 16 * rb + l15, 32 * s + 8 * q);
#pragma unroll
        for (int cbi = 0; cbi < 2; ++cbi) { const int cc = 16 * (cb0 + cbi) + l15, r0 = 16 * rb + 4 * q; f32x4 cw = z4, cn = z4;
#pragma unroll
            for (int s = 0; s < 2; ++s) { cw = mfma16(aT[s], ldfrag(L, L4_AC, cc, 32 * s + 8 * q), cw); cn = mfma16(aT[s], ldfrag(L, L4_NM, cc, 32 * s + 8 * q), cn); }
            st4bf(L, L4_WM, cc, r0, cw); st4bf(L, L4_NTM, cc, r0, cn); }
    }
    lds_barrier();
    LAUNDER_S(L);
    PSEC_E(F, 27)
    PSEC_B(28)
    const size_t slot = (size_t)c * (NB * RH) + bh;
    bf16* GT = wsp<bf16>(F, WS_F + F_GV + slot * 16384); bf16* VH = GT + 4096;
    bf16* ET = wsp<bf16>(F, WS_F + F_EV + slot * 16384); bf16* VFT = ET + 4096;
    {
        bf16x8 aW[2], aN[2];
#pragma unroll
        for (int s = 0; s < 2; ++s) { aW[s] = ldfrag(L, L4_WM, 16 * rb + l15, 32 * s + 8 * q); aN[s] = ldfrag(L, L4_NTM, 16 * rb + l15, 32 * s + 8 * q); }
#pragma unroll
        for (int cbi = 0; cbi < 2; ++cbi) { const int cc = 16 * (cb0 + cbi) + l15, r0 = 16 * rb + 4 * q; f32x4 cg = z4, ce = z4, chh = z4, cf = qreg[cbi];
#pragma unroll
            for (int s = 0; s < 2; ++s) { const bf16x8 bB = ldfrag(L, L4_BC, cc, 32 * s + 8 * q), bP = ldfrag(L, L4_PT, cc, 32 * s + 8 * q);
                cg = mfma16(aW[s], bB, cg); ce = mfma16(aW[s], bP, ce); chh = mfma16(aN[s], bB, chh); cf = mfma16(aN[s], bP, cf); }
#pragma unroll
            for (int r = 0; r < 4; ++r) { if (r0 + r == cc) cg[r] += *ldsp<float>(L, L4_GCX + cc * 4);
                chh[r] += bf2f(*ldsp<bf16>(L, L4_KH + ((r0 + r) * RP + cc) * 2)); }
            const u32x2 rt = *ldsp<u32x2>(L, L4_RT + (cc * RP + r0) * 2);
            ce[0] += bf2f((bf16)(rt.x & 0xffffu)); ce[1] += bf2f((bf16)(rt.x >> 16)); ce[2] += bf2f((bf16)(rt.y & 0xffffu)); ce[3] += bf2f((bf16)(rt.y >> 16));
            st4bf_g(GT + cc * 64 + 32 * (rb >> 1) + 8 * q + 4 * (rb & 1), cg);
            st4bf_g(ET + cc * 64 + r0, ce);
            st4bf(L, L4_HT, cc, r0, chh);
            st4bf(L, L4_FT, cc, r0, cf); }
    }
    lds_barrier();
    LAUNDER_S(L);
    PSEC_E(F, 28)
    PSEC_B(29)
    {
#pragma unroll
        for (int cbi = 0; cbi < 2; ++cbi) { const int cc = 16 * (cb0 + cbi) + l15, r0 = 16 * rb + 4 * q; f32x4 c1 = z4, c2 = z4;
#pragma unroll
            for (int s = 0; s < 2; ++s) { c1 = mfma16(ldfrag(L, L4_HT, 16 * rb + l15, 32 * s + 8 * q), ldfrag(L, L4_VC, cc, 32 * s + 8 * q), c1);
                c2 = mfma16(ldfrag(L, L4_VC, 16 * rb + l15, 32 * s + 8 * q), ldfrag(L, L4_FT, cc, 32 * s + 8 * q), c2); }
            st4bf_g(VH + cc * 64 + r0, c1); st4bf_g(VFT + cc * 64 + r0, c2); }
    }
    lds_barrier();
    PSEC_E(F, 29)
}

constexpr int L5_G = 0, L5_GBUF = 65536, SCG = 8;
static_assert(NC1 % SCG == 0, "scan groups of eight chunks");
__device__ __forceinline__ void scan_fetch_group(const Frame& F, const bf16* gbase  , size_t CS, int buf, u32x2 (&vhN)[SCG][4], int offV, bool consumer) {
    const int lane = F.lane, w = F.wave;
#pragma unroll
    for (int i = 0; i < SCG; ++i) {
        const int g = 64 * w + lane, r = g >> 3, c16 = (g & 7) ^ (r & 7);
        glds16((const char*)(gbase + (size_t)i * CS) + r * 128 + c16 * 16, F.lds + L5_G + buf * L5_GBUF + i * 8192 + w * 1024); }
    if (consumer) {
#pragma unroll
        for (int i = 0; i < SCG; ++i) { const char* gV = (const char*)(gbase + (size_t)i * CS) + 8192 + offV;
#pragma unroll
            for (int mt = 0; mt < 4; ++mt) vhN[i][mt] = *(const u32x2*)(gV + mt * 32); } }
}
__device__ __forceinline__ void scan_step(const Frame& F, int buf, int i, const u32x2 (&vh)[4], bf16* it, f32x4 (&st)[4], int offV, int l15, int q) {
    u32x4 b0, b1;
    b0.x = pk2(st[0][0], st[0][1]); b0.y = pk2(st[0][2], st[0][3]); b0.z = pk2(st[1][0], st[1][1]); b0.w = pk2(st[1][2], st[1][3]);
    b1.x = pk2(st[2][0], st[2][1]); b1.y = pk2(st[2][2], st[2][3]); b1.z = pk2(st[3][0], st[3][1]); b1.w = pk2(st[3][2], st[3][3]);
    char* sp = (char*)it + 8192 + offV;
    *(u32x2*)(sp) = (u32x2){b0.x, b0.y}; *(u32x2*)(sp + 32) = (u32x2){b0.z, b0.w}; *(u32x2*)(sp + 64) = (u32x2){b1.x, b1.y}; *(u32x2*)(sp + 96) = (u32x2){b1.z, b1.w};
    const bf16x8 f0 = __builtin_bit_cast(bf16x8, b0), f1 = __builtin_bit_cast(bf16x8, b1);
    const LAS unsigned char* G = F.lds + L5_G + buf * L5_GBUF + i * 8192;
#pragma unroll
    for (int mt = 0; mt < 4; ++mt) { const int r = 16 * mt + l15;
        f32x4 acc = (f32x4){bf2f((bf16)(vh[mt].x & 0xffffu)), bf2f((bf16)(vh[mt].x >> 16)), bf2f((bf16)(vh[mt].y & 0xffffu)), bf2f((bf16)(vh[mt].y >> 16))};
        acc = mfma16(*(const LAS bf16x8*)(G + (r * 8 + ((q) ^ (r & 7))) * 16), f0, acc);
        acc = mfma16(*(const LAS bf16x8*)(G + (r * 8 + ((4 + q) ^ (r & 7))) * 16), f1, acc);
        st[mt] = acc; }
}
__device__ __forceinline__ void rwkv_scan_bh(Frame& F0, int bh) {
    Frame F = relaunder(F0);
    const int lane = F.lane, vb = F.wave, l15 = lane & 15, q = lane >> 4;
    const bool consumer = vb < 4;
    const f32x4 z4 = (f32x4){0.f, 0.f, 0.f, 0.f};
    f32x4 st[4] = {z4, z4, z4, z4};
    bf16* base = wsp<bf16>(F, WS_F + F_GV + (size_t)bh * 16384); constexpr size_t CS = (size_t)NB * RH * 8192;
    int offV = ((16 * (vb & 3) + l15) * 64 + 4 * q) * 2;
    u32x2 vh[SCG][4], vhN[SCG][4];
#pragma unroll
    for (int i = 0; i < SCG; ++i)
#pragma unroll
        for (int mt = 0; mt < 4; ++mt) vhN[i][mt] = (u32x2){0u, 0u};
    scan_fetch_group(F, base, CS, 0, vhN, offV, consumer);
    vm_lds_barrier();
    for (int g = 0; g < NC1 / SCG; ++g) {
        LAUNDER(offV);
        bf16* gb = base + (size_t)g * SCG * CS;
#pragma unroll
        for (int i = 0; i < SCG; ++i)
#pragma unroll
            for (int mt = 0; mt < 4; ++mt) vh[i][mt] = vhN[i][mt];
        if (g + 1 < NC1 / SCG) scan_fetch_group(F, gb + (size_t)SCG * CS, CS, (g + 1) & 1, vhN, offV, consumer);
        if (consumer) {
#pragma unroll
            for (int i = 0; i < SCG; ++i) scan_step(F, g & 1, i, vh[i], gb + (size_t)i * CS, st, offV, l15, q); }
        vm_lds_barrier();
    }
}

constexpr int L6_SG = 0  , L6_YL = 64 * 104 * 2  , L6_GL = L6_YL + 64 * 68 * 4;
struct OutRaw { bf16 v[9], g0[9], g1[9]; float mu[3], ln[2], rho[8]; bf16x8 aS[2], aG[3], bE[2][2]; u32x2 vf[2]; };
__device__ __forceinline__ void rwkv_out_fetch(const Frame& F, int l, int item, OutRaw& R) {
    const int c = item % NC1, bh = item / NC1, h = bh % RH, b = bh / RH;
    const int lane = F.lane, w = F.wave, l15 = lane & 15, q = lane >> 4, rb = w >> 1, cb0 = 2 * (w & 1), t0 = 8 * w, ch = h * 64 + lane;
    const size_t m0 = (size_t)b * SEQ + (size_t)c * 64;
    const bf16* P = wsp<bf16>(F, WS_R);
    R.v[0] = 0; R.g0[0] = 0; R.g1[0] = 0;
    if (c * 64 + t0 > 0) { const bf16* row = P + (m0 + t0 - 1) * PW; R.v[0] = row[PC_V + ch]; R.g0[0] = row[PC_GLO + lane]; if (lane < 32) R.g1[0] = row[PC_GLO + 64 + lane]; }
#pragma unroll
    for (int i = 0; i < 8; ++i) { const bf16* row = P + (m0 + t0 + i) * PW; R.v[1 + i] = row[PC_V + ch]; R.g0[1 + i] = row[PC_GLO + lane]; R.g1[1 + i] = 0; if (lane < 32) R.g1[1 + i] = row[PC_GLO + 64 + lane]; }
    const float* mu = inp(F, 8) + (size_t)l * RCOLS;
    R.mu[0] = mu[PC_V + ch]; R.mu[1] = mu[PC_GLO + lane]; R.mu[2] = lane < 32 ? mu[PC_GLO + 64 + lane] : 0.f;
    R.ln[0] = inp(F, 17)[(size_t)l * RW + ch]; R.ln[1] = inp(F, 18)[(size_t)l * RW + ch];
#pragma unroll
    for (int i = 0; i < 8; ++i) R.rho[i] = wsp<float>(F, WS_F + F_RHO)[(m0 + t0 + i) * 8 + h];
    const size_t slot = (size_t)c * (NB * RH) + bh;
    const bf16* Sc = wsp<bf16>(F, WS_F + F_GV + slot * 16384) + 4096;
    const bf16* ET = wsp<bf16>(F, WS_F + F_EV + slot * 16384); const bf16* VFT = ET + 4096;
    const bf16* gup = (const bf16*)(wlayer(F, l) + W_SMALL + W_SMALL_GUP) + (size_t)(h * 64) * 96;
#pragma unroll
    for (int s = 0; s < 2; ++s) R.aS[s] = *(const bf16x8*)(Sc + (16 * rb + l15) * 64 + 32 * s + 8 * q);
#pragma unroll
    for (int s = 0; s < 3; ++s) R.aG[s] = *(const bf16x8*)(gup + (16 * rb + l15) * 96 + 32 * s + 8 * q);
#pragma unroll
    for (int cbi = 0; cbi < 2; ++cbi) { const int tt = 16 * (cb0 + cbi) + l15;
#pragma unroll
        for (int s = 0; s < 2; ++s) R.bE[cbi][s] = *(const bf16x8*)(ET + tt * 64 + 32 * s + 8 * q);
        R.vf[cbi] = *(const u32x2*)(VFT + tt * 64 + 16 * rb + 4 * q); }
}
__device__ __forceinline__ void rwkv_out_item(Frame& F0, int l, int item, OutRaw& raw, int next_item) {
    Frame F = relaunder(F0);
    const int c = item % NC1, bh = item / NC1, h = bh % RH, b = bh / RH;
    const int lane = F.lane, w = F.wave, l15 = lane & 15, q = lane >> 4, rb = w >> 1, cb0 = 2 * (w & 1), t0 = 8 * w;
    const size_t m0 = (size_t)b * SEQ + (size_t)c * 64;
    bf16* P = wsp<bf16>(F, WS_R);
    LAS unsigned char* L = F.lds;
    const int ch = h * 64 + lane;
    LAUNDER_S(L);
    float vs[8];
#pragma unroll
    for (int i = 0; i < 8; ++i) { const float xv = bf2f(raw.v[1 + i]), x0 = bf2f(raw.g0[1 + i]), x1 = bf2f(raw.g1[1 + i]);
        vs[i] = xv + (bf2f(raw.v[i]) - xv) * raw.mu[0];
        *ldsp<bf16>(L, L6_SG + ((t0 + i) * 104 + lane) * 2) = (bf16)f2bf(sigmoidf_(x0 + (bf2f(raw.g0[i]) - x0) * raw.mu[1]));
        if (lane < 32) *ldsp<bf16>(L, L6_SG + ((t0 + i) * 104 + 64 + lane) * 2) = (bf16)f2bf(sigmoidf_(x1 + (bf2f(raw.g1[i]) - x1) * raw.mu[2])); }
    const float lng = raw.ln[0], lnb = raw.ln[1];
    float rho[8];
#pragma unroll
    for (int i = 0; i < 8; ++i) rho[i] = raw.rho[i];
    const bf16x8 aS0 = raw.aS[0], aS1 = raw.aS[1], aG0 = raw.aG[0], aG1 = raw.aG[1], aG2 = raw.aG[2], bE00 = raw.bE[0][0], bE01 = raw.bE[0][1], bE10 = raw.bE[1][0], bE11 = raw.bE[1][1];
    const u32x2 vf0 = raw.vf[0], vf1 = raw.vf[1];
    if (next_item >= 0) rwkv_out_fetch(F, l, next_item, raw);
    lds_barrier();
    LAUNDER_S(L);
#pragma unroll
    for (int cbi = 0; cbi < 2; ++cbi) { const int tt = 16 * (cb0 + cbi) + l15, v0 = 16 * rb + 4 * q; const u32x2 vf = cbi ? vf1 : vf0;
        f32x4 cy = (f32x4){bf2f((bf16)(vf.x & 0xffffu)), bf2f((bf16)(vf.x >> 16)), bf2f((bf16)(vf.y & 0xffffu)), bf2f((bf16)(vf.y >> 16))}, cg = (f32x4){0.f, 0.f, 0.f, 0.f};
        cy = mfma16(aS0, cbi ? bE10 : bE00, cy); cy = mfma16(aS1, cbi ? bE11 : bE01, cy);
        cg = mfma16(aG0, *(const LAS bf16x8*)(L + L6_SG + (tt * 104 + 8 * q) * 2), cg);
        cg = mfma16(aG1, *(const LAS bf16x8*)(L + L6_SG + (tt * 104 + 32 + 8 * q) * 2), cg);
        cg = mfma16(aG2, *(const LAS bf16x8*)(L + L6_SG + (tt * 104 + 64 + 8 * q) * 2), cg);
        *ldsp<f32x4>(L, L6_YL + (tt * 68 + v0) * 4) = cy; *ldsp<f32x4>(L, L6_GL + (tt * 68 + v0) * 4) = cg; }
    lds_barrier();
    LAUNDER_S(L);
#pragma unroll
    for (int i = 0; i < 8; ++i) { const int t = t0 + i; const float y = *ldsp<float>(L, L6_YL + (t * 68 + lane) * 4);
        const float mean = wave_sum(y) * (1.0f / 64.0f), d = y - mean, var = wave_sum(d * d) * (1.0f / 64.0f);
        const float yn = d * frsq(var + 64e-5f) * lng + lnb;
        const float o = (yn + rho[i] * vs[i]) * *ldsp<float>(L, L6_GL + (t * 68 + lane) * 4);
        P[(m0 + t) * PW + ch] = (bf16)f2bf(o); }
    lds_barrier();
}

constexpr int MP = 136, MBUF = 128 * MP * 2;
constexpr int LM_A = 0, LM_B = MBUF, LM_C = 2 * MBUF, LM_D = 3 * MBUF, LM_S = 4 * MBUF;
static_assert(LM_S + 8 * 512 <= MISC_OFF - 256, "mLSTM LDS map");
__device__ __forceinline__ bf16x8 ldfragm(const LAS unsigned char* base, int off, int row, int col) { return *(const LAS bf16x8*)(base + off + (row * MP + col) * 2); }
__device__ __forceinline__ float logsigmoidf_(float x) { return -softplusf_(-x); }
__device__ __forceinline__ float wave_scan_add(float v, int lane) {
#pragma unroll
    for (int o = 1; o < 64; o <<= 1) { const float t = __shfl_up(v, o); if (lane >= o) v += t; }
    return v;
}
__device__ __forceinline__ float wave_scan_max(float v, int lane) {
#pragma unroll
    for (int o = 1; o < 64; o <<= 1) { const float t = __shfl_up(v, o); if (lane >= o) v = fmaxf(v, t); }
    return v;
}
__device__ __forceinline__ float wave_max(float v) {
#pragma unroll
    for (int o = 1; o < 64; o <<= 1) v = fmaxf(v, __shfl_xor(v, o));
    return v;
}

template <int MODE> __device__ __forceinline__ void mlstm_gates(const Frame& F, int l, int b, int h, int c, float mprev) {
    LAS unsigned char* L = F.lds; const bf16* P = wsp<bf16>(F, WS_R); const int lane = F.lane;
    const bf16* row = P + ((size_t)b * SEQ + (size_t)c * 128 + 2 * lane) * PW;
    const float bi = inp(F, 21)[l * 8 + h], bf = inp(F, 21)[l * 8 + 4 + h];
    const float i0 = bf2f(row[PC_MI + h]) + bi, i1 = bf2f(row[PW + PC_MI + h]) + bi;
    const float f0 = logsigmoidf_(bf2f(row[PC_MF + h]) + bf), f1 = logsigmoidf_(bf2f(row[PW + PC_MF + h]) + bf);
    const float p = f0 + f1, incl = wave_scan_add(p, lane), b0 = incl - p + f0, b1 = incl;
    if (MODE == 1) {
        const float bend = rdlane(incl, 63), g0 = bend - b0 + i0, g1 = bend - b1 + i1, mloc = wave_max(fmaxf(g0, g1));
        *ldsp<f32x2>(L, LM_S + 3 * 512 + lane * 8) = (f32x2){fexp(g0 - mloc), fexp(g1 - mloc)};
        if (lane == 0) *ldsp<f32x2>(L, LM_S + 7 * 512) = (f32x2){mloc, bend};
    } else {
        const float u0 = i0 - b0, u1 = i1 - b1, um = fmaxf(u0, u1), mi = wave_scan_max(um, lane);
        float ex = __shfl_up(mi, 1); if (lane == 0) ex = -INFINITY;
        const float mx0 = fmaxf(mprev, fmaxf(ex, u0)), mx1 = fmaxf(mprev, mi);
        *ldsp<f32x2>(L, LM_S + 3 * 512 + lane * 8) = (f32x2){u0, u1};
        *ldsp<f32x2>(L, LM_S + 4 * 512 + lane * 8) = (f32x2){-mx0, -mx1};
        *ldsp<f32x2>(L, LM_S + 5 * 512 + lane * 8) = (f32x2){fexp(mprev - mx0), fexp(mprev - mx1)};
        *ldsp<f32x2>(L, LM_S + 6 * 512 + lane * 8) = (f32x2){fexp(-(b0 + mx0)), fexp(-(b1 + mx1))};
    }
}
__device__ __forceinline__ void mlstm_conv_load(const Frame& F, size_t mrow0, int tseq0, int chq, bf16 (&raw)[35]) {
    const bf16* P = wsp<bf16>(F, WS_R) + PC_MQ + chq;
    if (tseq0 >= 3) { raw[0] = P[(mrow0 - 3) * PW]; raw[1] = P[(mrow0 - 2) * PW]; raw[2] = P[(mrow0 - 1) * PW]; } else { raw[0] = 0; raw[1] = 0; raw[2] = 0; }
#pragma unroll
    for (int i = 0; i < 32; ++i) raw[3 + i] = P[(mrow0 + i) * PW];
}
__device__ __forceinline__ void mlstm_conv_apply(const Frame& F, int l, int chq, const bf16 (&raw)[35], float (&out)[32]) {
    const float w0 = inp(F, 19)[(size_t)(l * 4 + 0) * 1024 + chq], w1 = inp(F, 19)[(size_t)(l * 4 + 1) * 1024 + chq], w2 = inp(F, 19)[(size_t)(l * 4 + 2) * 1024 + chq], w3 = inp(F, 19)[(size_t)(l * 4 + 3) * 1024 + chq], cb = inp(F, 20)[(size_t)l * 1024 + chq];
    float x0 = bf2f(raw[0]), x1 = bf2f(raw[1]), x2 = bf2f(raw[2]);
#pragma unroll
    for (int i = 0; i < 32; ++i) { const float x3 = bf2f(raw[3 + i]); out[i] = siluf_(w0 * x0 + w1 * x1 + w2 * x2 + w3 * x3 + cb); x0 = x1; x1 = x2; x2 = x3; }
}
__device__ __forceinline__ void mlstm_m1_item(Frame& F0, int l, int item) {
    Frame F = relaunder(F0);
    const int c = item % NC2, bh = item / NC2, h = bh % MH, b = bh / MH;
    const int lane = F.lane, w = F.wave, l15 = lane & 15, q = lane >> 4;
    LAS unsigned char* L = F.lds; const bf16* P = wsp<bf16>(F, WS_R);
    const size_t m0 = (size_t)b * SEQ + (size_t)c * 128;
    LAUNDER_S(L);
    const int d = lane + 64 * (w & 1), tg = w >> 1, tb = 32 * tg;
    bf16 kraw[35], vraw[32];
    mlstm_conv_load(F, m0 + tb, c * 128 + tb, 512 + h * 128 + d, kraw);
#pragma unroll
    for (int i = 0; i < 32; ++i) vraw[i] = P[(m0 + tb + i) * PW + PC_MV + h * 128 + d];
    if (w == 0) mlstm_gates<1>(F, l, b, h, c, 0.f);
    lds_barrier();
    LAUNDER_S(L);
    const f32x2 msc = *ldsp<f32x2>(L, LM_S + 7 * 512);
    float kc[32]; mlstm_conv_apply(F, l, 512 + h * 128 + d, kraw, kc);
    float ksum = 0.f;
#pragma unroll
    for (int i = 0; i < 32; ++i) { kc[i] *= *ldsp<float>(L, LM_S + 3 * 512 + (tb + i) * 4); ksum += kc[i]; }
    lds_barrier();
    {
#pragma unroll
        for (int g = 0; g < 4; ++g) { u32x4 o; o.x = pk2(kc[8 * g], kc[8 * g + 1]); o.y = pk2(kc[8 * g + 2], kc[8 * g + 3]); o.z = pk2(kc[8 * g + 4], kc[8 * g + 5]); o.w = pk2(kc[8 * g + 6], kc[8 * g + 7]);
            *ldsp<u32x4>(L, LM_A + (d * MP + tb + 8 * g) * 2) = o; }
        *ldsp<float>(L, LM_S + 4 * 512 + tg * 512 + d * 4) = ksum;
#pragma unroll
        for (int g = 0; g < 4; ++g) { u32x4 o; o.x = (unsigned)vraw[8 * g] | ((unsigned)vraw[8 * g + 1] << 16); o.y = (unsigned)vraw[8 * g + 2] | ((unsigned)vraw[8 * g + 3] << 16);
            o.z = (unsigned)vraw[8 * g + 4] | ((unsigned)vraw[8 * g + 5] << 16); o.w = (unsigned)vraw[8 * g + 6] | ((unsigned)vraw[8 * g + 7] << 16);
            *ldsp<u32x4>(L, LM_B + (d * MP + tb + 8 * g) * 2) = o; }
    }
    lds_barrier();
    LAUNDER_S(L);
    bf16* KVT = wsp<bf16>(F, WS_F + F_MC + (size_t)item * 65536);
    {
        f32x4 acc[8];
#pragma unroll
        for (int et = 0; et < 8; ++et) acc[et] = (f32x4){0.f, 0.f, 0.f, 0.f};
#pragma unroll
        for (int s = 0; s < 4; ++s) { const bf16x8 a = ldfragm(L, LM_A, 16 * w + l15, 32 * s + 8 * q);
#pragma unroll
            for (int et = 0; et < 8; ++et) acc[et] = mfma16(a, ldfragm(L, LM_B, 16 * et + l15, 32 * s + 8 * q), acc[et]); }
#pragma unroll
        for (int et = 0; et < 8; ++et) st4bf_g(KVT + (size_t)(16 * et + l15) * 128 + 16 * w + 4 * q, acc[et]);
    }
    if (F.tid < 128) { float s = 0.f;
#pragma unroll
        for (int g = 0; g < 4; ++g) s += *ldsp<float>(L, LM_S + 4 * 512 + g * 512 + F.tid * 4);
        wsp<float>(F, WS_F + F_KS)[(size_t)item * 128 + F.tid] = s; }
    if (F.tid == 0) { float* mscg = wsp<float>(F, WS_F + F_MSC) + (size_t)item * 4; mscg[0] = msc[0]; mscg[1] = msc[1]; }
    lds_barrier();
}
__device__ __forceinline__ void mlstm_m2(Frame& F0, int first_wg) {
    Frame F = relaunder(F0);
    const int nW = F.G - first_wg; if (F.bid < first_wg || nW <= 0) return;
    const int per = 4096 + 32;
    for (int idx = (F.bid - first_wg) * 512 + F.tid; idx < NB * MH * per; idx += nW * 512) {
        const int bh = idx / per, e4 = idx % per;
        float* msc = wsp<float>(F, WS_F + F_MSC) + (size_t)bh * NC2 * 4;
        f32x2 sc[NC2];
#pragma unroll
        for (int c = 0; c < NC2; ++c) sc[c] = *(const f32x2*)(msc + c * 4);
        float m = -INFINITY; f32x4 st = (f32x4){0.f, 0.f, 0.f, 0.f};
        if (e4 < 4096) {
            bf16* p = wsp<bf16>(F, WS_F + F_MC + (size_t)bh * NC2 * 65536) + 4 * e4;
            u32x2 kvr[NC2];
#pragma unroll
            for (int c = 0; c < NC2; ++c) kvr[c] = *(const u32x2*)(p + (size_t)c * 32768);
#pragma unroll
            for (int c = 0; c < NC2; ++c) { const f32x4 kv = (f32x4){bf2f((bf16)(kvr[c].x & 0xffffu)), bf2f((bf16)(kvr[c].x >> 16)), bf2f((bf16)(kvr[c].y & 0xffffu)), bf2f((bf16)(kvr[c].y >> 16))};
                st4bf_g(p + (size_t)c * 32768 + 16384, st);
                if (e4 == 0) msc[c * 4 + 2] = m;
                const float mn = fmaxf(sc[c][1] + m, sc[c][0]), keep = fexp(sc[c][1] + m - mn), w2 = fexp(sc[c][0] - mn);
                st = st * keep + kv * w2; m = mn; }
        } else {
            f32x4* p = (f32x4*)(wsp<float>(F, WS_F + F_KS) + (size_t)bh * NC2 * 128) + (e4 - 4096);
            constexpr int HB = NC2 < 16 ? NC2 : 16;
#pragma unroll
            for (int c0 = 0; c0 < NC2; c0 += HB) { f32x4 kvr[HB];
#pragma unroll
                for (int c = 0; c < HB; ++c) kvr[c] = p[(c0 + c) * 32];
#pragma unroll
                for (int c = 0; c < HB; ++c) { p[(c0 + c) * 32] = st;
                    const float mn = fmaxf(sc[c0 + c][1] + m, sc[c0 + c][0]), keep = fexp(sc[c0 + c][1] + m - mn), w2 = fexp(sc[c0 + c][0] - mn);
                    st = st * keep + kvr[c] * w2; m = mn; } }
        }
    }
}
__device__ __forceinline__ void mlstm_m3_item(Frame& F0, int l, int item) {
    Frame F = relaunder(F0);
    const int c = item % NC2, bh = item / NC2, h = bh % MH, b = bh / MH;
    const int lane = F.lane, w = F.wave, l15 = lane & 15, q = lane >> 4;
    LAS unsigned char* L = F.lds; bf16* P = wsp<bf16>(F, WS_R);
    const size_t m0 = (size_t)b * SEQ + (size_t)c * 128;
    LAUNDER_S(L);
    const int d = lane + 64 * (w & 1), tg = w >> 1, tb = 32 * tg;
    bf16 qraw[35], kraw[35], vraw[32];
    mlstm_conv_load(F, m0 + tb, c * 128 + tb, h * 128 + d, qraw);
    mlstm_conv_load(F, m0 + tb, c * 128 + tb, 512 + h * 128 + d, kraw);
#pragma unroll
    for (int i = 0; i < 32; ++i) vraw[i] = P[(m0 + tb + i) * PW + PC_MV + h * 128 + d];
    if (w == 0) mlstm_gates<3>(F, l, b, h, c, wsp<float>(F, WS_F + F_MSC)[(size_t)item * 4 + 2]);
    {
        float cv[32];
        mlstm_conv_apply(F, l, h * 128 + d, qraw, cv);
#pragma unroll
        for (int i = 0; i < 32; ++i) *ldsp<bf16>(L, LM_A + ((tb + i) * MP + d) * 2) = (bf16)f2bf(cv[i] * 0.08838834764831845f);
        mlstm_conv_apply(F, l, 512 + h * 128 + d, kraw, cv);
#pragma unroll
        for (int i = 0; i < 32; ++i) *ldsp<bf16>(L, LM_B + ((tb + i) * MP + d) * 2) = (bf16)f2bf(cv[i]);
#pragma unroll
        for (int g = 0; g < 4; ++g) { u32x4 o; o.x = (unsigned)vraw[8 * g] | ((unsigned)vraw[8 * g + 1] << 16); o.y = (unsigned)vraw[8 * g + 2] | ((unsigned)vraw[8 * g + 3] << 16);
            o.z = (unsigned)vraw[8 * g + 4] | ((unsigned)vraw[8 * g + 5] << 16); o.w = (unsigned)vraw[8 * g + 6] | ((unsigned)vraw[8 * g + 7] << 16);
            *ldsp<u32x4>(L, LM_C + (d * MP + tb + 8 * g) * 2) = o; }
    }
    lds_barrier();
    LAUNDER_S(L);
    const int lq = 16 * w + l15;
    f32x4 a1[9], a2[9];
#pragma unroll
    for (int et = 0; et < 9; ++et) { a1[et] = (f32x4){0.f, 0.f, 0.f, 0.f}; a2[et] = (f32x4){0.f, 0.f, 0.f, 0.f}; }
    {
        const bf16* CP = wsp<bf16>(F, WS_F + F_MC + (size_t)item * 65536) + 16384 + (size_t)l15 * 128 + 8 * q; const float* NP = wsp<float>(F, WS_F + F_KS) + (size_t)item * 128;
        bf16x8 ca[8], cb[8];
#pragma unroll
        for (int et = 0; et < 8; ++et) ca[et] = *(const bf16x8*)(CP + (size_t)et * 2048);
#pragma unroll
        for (int s = 0; s < 4; ++s) {
            if (s < 3) {
#pragma unroll
                for (int et = 0; et < 8; ++et) { if (s & 1) ca[et] = *(const bf16x8*)(CP + (size_t)et * 2048 + 32 * (s + 1)); else cb[et] = *(const bf16x8*)(CP + (size_t)et * 2048 + 32 * (s + 1)); } }
            EMU_FENCE();
            const bf16x8 bq = ldfragm(L, LM_A, lq, 32 * s + 8 * q);
#pragma unroll
            for (int et = 0; et < 8; ++et) a2[et] = mfma16((s & 1) ? cb[et] : ca[et], bq, a2[et]);
            const float* np = NP + 32 * s + 8 * q; const f32x4 n0 = *(const f32x4*)np, n1 = *(const f32x4*)(np + 4);
            u32x4 o; o.x = pk2(n0[0], n0[1]); o.y = pk2(n0[2], n0[3]); o.z = pk2(n1[0], n1[1]); o.w = pk2(n1[2], n1[3]);
            if (l15 != 0) o = (u32x4){0u, 0u, 0u, 0u};
            a2[8] = mfma16(__builtin_bit_cast(bf16x8, o), bq, a2[8]); }
    }
    {
        bf16x8 bq[4];
#pragma unroll
        for (int s = 0; s < 4; ++s) bq[s] = ldfragm(L, LM_A, lq, 32 * s + 8 * q);
        const float al = *ldsp<float>(L, LM_S + 4 * 512 + lq * 4);
        const int nsb = 2 * (w >> 1) + 2;
        for (int sb = 0; sb < nsb; ++sb) { f32x4 acc = (f32x4){0.f, 0.f, 0.f, 0.f};
            if (sb <= w) {
#pragma unroll
                for (int s = 0; s < 4; ++s) acc = mfma16(ldfragm(L, LM_B, 16 * sb + l15, 32 * s + 8 * q), bq[s], acc);
#pragma unroll
                for (int r = 0; r < 4; ++r) { const int ss = 16 * sb + 4 * q + r; acc[r] = ss <= lq ? acc[r] * fexp(al + *ldsp<float>(L, LM_S + 3 * 512 + ss * 4)) : 0.f; } }
            u32x2 o; o.x = pk2(acc[0], acc[1]); o.y = pk2(acc[2], acc[3]); *ldsp<u32x2>(L, LM_D + (lq * MP + 16 * sb + 4 * q) * 2) = o; }
    }
    WAVE_LDS_FENCE();
    LAUNDER_S(L);
    {
        const int ns = (w >> 1) + 1;
        for (int s = 0; s < ns; ++s) { const bf16x8 bs = ldfragm(L, LM_D, lq, 32 * s + 8 * q);
#pragma unroll
            for (int et = 0; et < 8; ++et) a1[et] = mfma16(ldfragm(L, LM_C, 16 * et + l15, 32 * s + 8 * q), bs, a1[et]);
            const short one = l15 == 0 ? (short)0x3F80 : (short)0; const bf16x8 ones = (bf16x8){one, one, one, one, one, one, one, one};
            a1[8] = mfma16(ones, bs, a1[8]); }
    }
    {
        const float inter = *ldsp<float>(L, LM_S + 5 * 512 + lq * 4), emt = *ldsp<float>(L, LM_S + 6 * 512 + lq * 4);
        const float den = __shfl(a1[8][0] + inter * a2[8][0], l15);
        const float rden = frcp(fmaxf(fabsf(den), emt));
        float s1 = 0.f;
#pragma unroll
        for (int et = 0; et < 8; ++et) { a1[et] = (a1[et] + a2[et] * inter) * rden; s1 += (a1[et][0] + a1[et][1]) + (a1[et][2] + a1[et][3]); }
        s1 += __shfl_xor(s1, 16); s1 += __shfl_xor(s1, 32);
        const float mean = s1 * (1.0f / 128.0f); float s2 = 0.f;
#pragma unroll
        for (int et = 0; et < 8; ++et) { a1[et] = a1[et] - mean; s2 += (a1[et][0] * a1[et][0] + a1[et][1] * a1[et][1]) + (a1[et][2] * a1[et][2] + a1[et][3] * a1[et][3]); }
        s2 += __shfl_xor(s2, 16); s2 += __shfl_xor(s2, 32);
        const float rstd = frsq(s2 * (1.0f / 128.0f) + 1e-5f);
        bf16* prow = P + (m0 + lq) * PW;
#pragma unroll
        for (int et = 0; et < 8; ++et) { const int e = 16 * et + 4 * q; const f32x4 lg = *(const f32x4*)(inp(F, 22) + (size_t)l * MW + h * 128 + e);
            const f32x4 og = ld4bf_g(prow + PC_MO + h * 128 + e); f32x4 o;
#pragma unroll
            for (int r = 0; r < 4; ++r) o[r] = sigmoidf_(og[r]) * (a1[et][r] * rstd * lg[r]);
            st4bf_g(prow + 512 + h * 128 + e, o); }
    }
    lds_barrier();
}

constexpr int NSTAGES = 2 + 10 * DEPTH + 1;
#ifndef PG8_SP2
#define PG8_SP2 true
#endif
#ifndef PG8_ALIGN
#define PG8_ALIGN true
#endif
__device__ __forceinline__ void run_stage(Frame& F0, int s) {
    Frame F = F0; LAUNDER(F.lane); LAUNDER_S(F.wave); LAUNDER_S(F.bid); LAUNDER_S(F.G); F.tid = F.wave * 64 + F.lane;
    int r = -1, l = 0;
    if (s >= 2 && s < NSTAGES - 1) { r = (s - 2) % 10; l = (s - 2) / 10; }
    unsigned char* wl = wlayer(F, l);
    bf16* XN = wsp<bf16>(F, WS_XN); bf16* R = wsp<bf16>(F, WS_R);
    float* bl = wsp<float>(F, WS_F + F_BIAS) + (size_t)l * BIAS_LAYER;
    if (s == 0) { ph_p0(F); return; }
    if (s == 1) { ph_prenorm(F, inp(F, 0), inp(F, 4), modp(F, 0, 1)); ph_bias(F); return; }
    if (s == NSTAGES - 1) { ph_finalnorm(F, inp(F, 26)); return; }
    if (r == 0 || r == 8) {
        const int i = r == 0 ? 0 : 1;
        pg8::Gemm g{XN, (const bf16*)(wl + W_FFIN + i * W_FFIN_SZ), MTOK, 2 * FF, DM, DM}; pg8::StaticOrder S; S.init(MTOK, 2 * FF, F.G, F.bid);
        EpiSwiglu E{R, rowsq16(F), bl + i * BIAS_FF};
        pg8::gemm_phase<EpiSwiglu, pg8::StaticOrder, PG8_ALIGN, PG8_SP2>(F.lds, g, S, E); return;
    }
    if (r == 1 || r == 9 || r == 7) {
        const int i = r == 1 ? 0 : 1; const bool ffn = r != 7;
        const int nl = r == 9 ? l + 1 : l, nw = r == 1 ? 1 : (r == 7 ? 2 : 0);
        const bool has_next = nl < DEPTH;
        const bf16* Ap = ffn ? (const bf16*)R : (const bf16*)wsp<bf16>(F, WS_F + F_GV); const bf16* Bp = (const bf16*)(wl + (ffn ? W_FFOUT + i * W_FFOUT_SZ : W_WOUT)); const int Kd = ffn ? FF : DM;
        pg8::Gemm g{Ap, Bp, MTOK, DM, Kd, Kd}; pg8::StaticOrder S; S.init(MTOK, DM, F.G, F.bid);
        const float* xin = (l == 0 && r == 1) ? inp(F, 0) : (const float*)xout(F); float* xo = xout(F); const float* gt = modp(F, l, r == 1 ? 2 : (r == 7 ? 5 : 8));
        const float* csp = has_next ? wsp<float>(F, WS_F + F_CS) + (size_t)(nl * 3 + nw) * NB * DM : nullptr; float* rq = rowsq16(F);
        if (ffn) { EpiRes<true> E; E.Xin = xin; E.Xout = xo; E.gate = gt; E.XS = XN; E.csn = csp; E.rsq = rq;
            pg8::gemm_phase<EpiRes<true>, pg8::StaticOrder, false, PG8_SP2>(F.lds, g, S, E); }
        else { EpiRes<false> E; E.Xin = xin; E.Xout = xo; E.gate = gt; E.XS = XN; E.csn = csp; E.rsq = rq;
            pg8::gemm_phase<EpiRes<false>, pg8::StaticOrder, false, PG8_SP2>(F.lds, g, S, E); }
        return;
    }
    if (r == 2) {
        pg8::Gemm g{XN, (const bf16*)(wl + W_MIXIN), MTOK, PW, DM, DM}; pg8::StaticOrder S; S.init(MTOK, PW, F.G, F.bid);
        EpiBf<0> E{R, PW, nullptr, 0, rowsq16(F), bl + 2 * BIAS_FF, PW};
        pg8::gemm_phase<EpiBf<0>, pg8::StaticOrder, PG8_ALIGN, PG8_SP2>(F.lds, g, S, E); return;
    }
    if (r == 3) {
        { PSEC_B(1) PrepRaw raw; if (F.bid < NIT1) rwkv_prep_fetch(F, l, F.bid, raw);
          for (int it = F.bid; it < NIT1; it += F.G) rwkv_prep_item(F, l, it, raw, it + F.G < NIT1 ? it + F.G : -1); PSEC_E(F, 1) }
        { PSEC_B(2) for (int it = F.bid; it < NIT2; it += F.G) mlstm_m1_item(F, l, it); PSEC_E(F, 2) }
        return;
    }
    if (r == 4) {
        { PSEC_B(5) for (int bh = F.bid; bh < NB * RH; bh += F.G) rwkv_scan_bh(F, bh); PSEC_E(F, 5) }
        { PSEC_B(8) mlstm_m2(F, F.G > NB * RH ? NB * RH : 0); PSEC_E(F, 8) }
        return;
    }
    if (r == 5) {
        { PSEC_B(3) OutRaw oraw; if (F.bid < NIT1) rwkv_out_fetch(F, l, F.bid, oraw);
          for (int it = F.bid; it < NIT1; it += F.G) rwkv_out_item(F, l, it, oraw, it + F.G < NIT1 ? it + F.G : -1); PSEC_E(F, 3) }
        { PSEC_B(4) for (int it = F.bid; it < NIT2; it += F.G) mlstm_m3_item(F, l, it); PSEC_E(F, 4) }
        return;
    }
    if (r == 6) {
        bf16* SG = wsp<bf16>(F, WS_F + F_EV); bf16* TU = wsp<bf16>(F, WS_F + F_GV);
        { pg8::Gemm g{XN, (const bf16*)(wl + W_GATE), MTOK, 2048, DM, DM}; pg8::GateOrder S; S.init(MTOK, F.G, F.bid);
          EpiBf<1> E{SG, 2048, nullptr, 0, rowsq16(F), bl + 2 * BIAS_FF + BIAS_MIX, 2048};
          pg8::gemm_phase<EpiBf<1>, pg8::GateOrder, PG8_ALIGN, PG8_SP2>(F.lds, g, S, E); }
        { pg8::Gemm g{R, (const bf16*)(wl + W_BR), MTOK, DM, 512, PW}; pg8::StaticOrder S; S.init(MTOK, DM, F.G, F.bid);
          EpiBf<2> E{TU, DM, SG, 2048, nullptr, nullptr, 0};
          pg8::gemm_phase<EpiBf<2>, pg8::StaticOrder, false, PG8_SP2>(F.lds, g, S, E); }
        { pg8::Gemm g{R + 512, (const bf16*)(wl + W_BR + W_BR_SZ), MTOK, DM, 512, PW}; pg8::StaticOrder S; S.init(MTOK, DM, F.G, F.bid);
          EpiBf<3> E{TU, DM, SG + 1024, 2048, nullptr, nullptr, 0};
          pg8::gemm_phase<EpiBf<3>, pg8::StaticOrder, false, PG8_SP2>(F.lds, g, S, E); }
        return;
    }
}

struct Args { const float* in[27]; float* out; unsigned char* ws; int s_lo, s_hi; };

#ifndef EMU
#define XB_TMO      128
#define XB_XCNT(j)  (256  + 64 * (j))
#define XB_XSUB(j)  (1280 + 64 * (j))
#define XB_XGEN(j)  (2304 + 64 * (j))
#define XB_TOP      3328
#define XB_TOPGEN   3392
#define XCD_BAR_WORDS 3456
#define XB_SPIN_CAP (1u << 18)
#ifndef XB_POLL_SLEEP
#define XB_POLL_SLEEP 2
#endif

__device__ __forceinline__ unsigned xb_ld(unsigned* p)              { return __hip_atomic_load(p, __ATOMIC_RELAXED, __HIP_MEMORY_SCOPE_AGENT); }
__device__ __forceinline__ unsigned xb_add(unsigned* p, unsigned v) { return __hip_atomic_fetch_add(p, v, __ATOMIC_RELAXED, __HIP_MEMORY_SCOPE_AGENT); }
__device__ __forceinline__ unsigned xb_xcc_id() { return (unsigned)__builtin_amdgcn_s_getreg((3 << 11) | 20) & 0xFu; }
#define XB_SPIN(cond, bar) do { unsigned _sp = 0; while (cond) { __builtin_amdgcn_s_sleep(XB_POLL_SLEEP); \
    if ((++_sp & 255u) == 0u) { if (xb_ld(&(bar)[XB_TMO])) break; if (_sp > XB_SPIN_CAP) { atomicAdd(&(bar)[XB_TMO], 1u); break; } } } } while (0)

struct XcdBarrier {
    unsigned* bar; unsigned x;
    volatile LAS unsigned* st;
};

__device__ __forceinline__ XcdBarrier xcd_barrier_post(unsigned* bar, volatile LAS unsigned* st) {
    XcdBarrier b; b.bar = bar; b.x = xb_xcc_id(); b.st = st;
    if (threadIdx.x == 0) (void)xb_add(&bar[XB_XCNT(b.x)], 1u);
    return b;
}
__device__ __forceinline__ void xcd_barrier_complete(unsigned* bar, unsigned x, unsigned& nloc, unsigned& nx) {
    const unsigned G = gridDim.x * gridDim.y * gridDim.z;
    unsigned sum, cnt, mine, sp = 0u;
    for (;;) {
        sum = 0u; cnt = 0u; mine = 0u;
#pragma unroll
        for (unsigned j = 0; j < 16; ++j) { const unsigned c = xb_ld(&bar[XB_XCNT(j)]); sum += c; cnt += (c > 0u) ? 1u : 0u; mine = (j == x) ? c : mine; }
        if (sum == G) break;
        __builtin_amdgcn_s_sleep(1);
        if ((++sp & 255u) == 0u) { if (xb_ld(&bar[XB_TMO])) break; if (sp > XB_SPIN_CAP) { atomicAdd(&bar[XB_TMO], 1u); break; } }
    }
    nloc = mine > 0u ? mine : 1u; nx = cnt > 0u ? cnt : 1u;
}

__device__ __forceinline__ void xcd_barrier(const XcdBarrier& b) {
    asm volatile("s_waitcnt vmcnt(0)" ::: "memory");
    __syncthreads();
    if (threadIdx.x == 0) {
        unsigned* bar = b.bar;
        __builtin_amdgcn_s_waitcnt(0);
        unsigned nloc = b.st[0], nx = b.st[1];
        if (nloc == 0u) { xcd_barrier_complete(bar, b.x, nloc, nx); b.st[0] = nloc; b.st[1] = nx; }
        const unsigned old = xb_add(&bar[XB_XSUB(b.x)], 1u);
        const unsigned gen = old / nloc;
        if (old + 1u == (gen + 1u) * nloc) {
            __builtin_amdgcn_fence(__ATOMIC_RELEASE, "agent");
            asm volatile("s_waitcnt vmcnt(0)" ::: "memory");
            const unsigned og = xb_add(&bar[XB_TOP], 1u);
            const unsigned tg = og / nx;
            if (og + 1u == (tg + 1u) * nx) xb_add(&bar[XB_TOPGEN], 1u);
            else XB_SPIN(xb_ld(&bar[XB_TOPGEN]) == tg, bar);
            __builtin_amdgcn_fence(__ATOMIC_ACQUIRE, "agent");
            xb_add(&bar[XB_XGEN(b.x)], 1u);
            asm volatile("s_waitcnt vmcnt(0)" ::: "memory");
        } else {
            XB_SPIN(xb_ld(&bar[XB_XGEN(b.x)]) == gen, bar);
            __builtin_amdgcn_fence(__ATOMIC_ACQUIRE, "agent");
            asm volatile("s_waitcnt vmcnt(0)" ::: "memory");
        }
    }
    __syncthreads();
}

#ifndef PROBE_MASK
#define PROBE_MASK 0ull
#endif
#ifndef PROBE_AMP
#define PROBE_AMP 4
#endif
#ifndef MK_N_LAUNCHES
#define MK_N_LAUNCHES 1
#endif
__global__ void __launch_bounds__(NWAVES * 64, 2) mk_fwd(Args a) {
    extern __shared__ __attribute__((aligned(16))) unsigned char lds_raw[];
    Frame F;
    F.lds = (LAS unsigned char*)lds_raw;
    F.tid = threadIdx.x; F.lane = F.tid & 63; F.wave = __builtin_amdgcn_readfirstlane(F.tid >> 6); F.G = gridDim.x; F.bid = blockIdx.x;
    if (F.tid < 27) *(const float* LAS*)(F.lds + TBL_OFF + 8 * F.tid) = a.in[F.tid];
    if (F.tid == 27) *(float* LAS*)(F.lds + TBL_OFF + 8 * 27) = a.out;
    if (F.tid == 28) *(unsigned char* LAS*)(F.lds + TBL_OFF + 8 * 28) = a.ws;
    volatile LAS unsigned* MISC = (volatile LAS unsigned*)(F.lds + MISC_OFF);
    for (int u = F.tid; u < 64; u += NWAVES * 64) MISC[u] = 0u;
    __syncthreads();
    XcdBarrier bar; bar.bar = (unsigned*)(a.ws + WS_CTL) + CW_BAR; bar.x = 0; bar.st = nullptr;
    const int s_lo = (MK_N_LAUNCHES == 1) ? 0 : a.s_lo, s_hi = (MK_N_LAUNCHES == 1) ? NSTAGES : a.s_hi;
    if (s_hi - s_lo > 1) bar = xcd_barrier_post((unsigned*)(a.ws + WS_CTL) + CW_BAR, MISC + 8);
#if PROBE_MASK
    unsigned long long tacc = 0ull;
#endif
    for (int s = s_lo; s < s_hi; ++s) {
#if PROBE_MASK
        const unsigned long long t0 = __builtin_amdgcn_s_memrealtime();
#endif
        run_stage(F, s);
        if (s + 1 < s_hi) { XcdBarrier b2 = bar; asm volatile("" : "+s"(b2.bar));
            xcd_barrier(b2); }
#if PROBE_MASK
        if ((PROBE_MASK >> s) & 1ull) tacc += __builtin_amdgcn_s_memrealtime() - t0;
#endif
    }
#if PROBE_SEC
    if (threadIdx.x == 0) { const unsigned long long ts = *(LAS unsigned long long*)(F.lds + MISC_OFF + 64), t0 = __builtin_amdgcn_s_memrealtime(); while (__builtin_amdgcn_s_memrealtime() - t0 < (unsigned long long)PROBE_AMP * ts) __builtin_amdgcn_s_sleep(32); }
#endif
#if PROBE_MASK
    if (blockIdx.x == 0 && threadIdx.x == 0) { const unsigned long long t0 = __builtin_amdgcn_s_memrealtime(); while (__builtin_amdgcn_s_memrealtime() - t0 < (unsigned long long)PROBE_AMP * tacc) __builtin_amdgcn_s_sleep(32); }
#endif
}

extern "C" void kernel_launch(void* const* d_in, const int* in_sizes, int n_in, void* d_out, int out_size, void* d_ws, size_t ws_size, hipStream_t stream) {
    static int grid = 0;
    if (grid == 0) {
        if (n_in != 27 || in_sizes[0] != MTOK * DM || out_size != MTOK * DM || ws_size < WS_END) { fprintf(stderr, "kernel_launch: unexpected problem shape (n_in %d, in0 %d, out %d, ws %zu < %zu); nothing launched\n", n_in, n_in > 0 ? in_sizes[0] : -1, out_size, ws_size, (size_t)WS_END); grid = -1; return; }
        int dev = 0, cus = 0, per_cu = 0;
        if (hipGetDevice(&dev) != hipSuccess || hipDeviceGetAttribute(&cus, hipDeviceAttributeMultiprocessorCount, dev) != hipSuccess) { grid = -1; return; }
        if (hipFuncSetAttribute((const void*)mk_fwd, hipFuncAttributeMaxDynamicSharedMemorySize, LDS_BYTES) != hipSuccess) { fprintf(stderr, "kernel_launch: hipFuncSetAttribute failed\n"); grid = -1; return; }
        if (hipOccupancyMaxActiveBlocksPerMultiprocessor(&per_cu, (const void*)mk_fwd, NWAVES * 64, LDS_BYTES) != hipSuccess || per_cu < 1) { fprintf(stderr, "kernel_launch: occupancy query reports %d workgroups per CU\n", per_cu); }
        (void)hipGetLastError();
        grid = cus;
    }
    if (grid < 0) return;
    if (hipMemsetAsync((char*)d_ws + WS_CTL, 0, CTL_ZERO_BYTES, stream) != hipSuccess) return;
    Args a{};
    for (int i = 0; i < 27; ++i) a.in[i] = (const float*)d_in[i];
    a.out = (float*)d_out; a.ws = (unsigned char*)d_ws;
    if (MK_N_LAUNCHES == 1) { a.s_lo = 0; a.s_hi = NSTAGES; hipLaunchKernelGGL(mk_fwd, dim3(grid), dim3(NWAVES * 64), LDS_BYTES, stream, a); }
    else for (int s = 0; s < NSTAGES; ++s) { a.s_lo = s; a.s_hi = s + 1; hipLaunchKernelGGL(mk_fwd, dim3(grid), dim3(NWAVES * 64), LDS_BYTES, stream, a); }
}
#endif
```

```cpp
#ifndef EMU
#include <hip/hip_runtime.h>
#include <cstdio>
#include <cstdint>
#define LAS __attribute__((address_space(3)))
#define GAS __attribute__((address_space(1)))
#endif

#ifndef CFG_B
#define CFG_B 4
#endif
#ifndef CFG_T
#define CFG_T 4096
#endif

typedef unsigned short bf16;
typedef short bf16x8 __attribute__((ext_vector_type(8)));
typedef float f32x4 __attribute__((ext_vector_type(4)));
typedef float f32x2 __attribute__((ext_vector_type(2)));
typedef unsigned u32x4 __attribute__((ext_vector_type(4)));
typedef unsigned u32x2 __attribute__((ext_vector_type(2)));

constexpr int NB = CFG_B, SEQ = CFG_T, MTOK = NB * SEQ, DM = 1024, FF = 2816, DEPTH = 2;
constexpr int RH = 8, RD = 64, RW = 512, MH = 4, MD = 128, MW = 512;
constexpr int RCOLS = 1696, MCOLS = 2056, NIN = 5800, PW = 3840;
constexpr int NC1 = SEQ / 64, NC2 = SEQ / 128;
constexpr int NIT1 = NB * RH * NC1, NIT2 = NB * MH * NC2;
static_assert(MTOK % 256 == 0 && SEQ % 256 == 0, "token tiles");
constexpr int PC_R = 0, PC_K = 512, PC_V = 1024, PC_LORA = 1536, PC_GLO = 1600;
constexpr int PC_MQ = 1696, PC_MK = 2208, PC_MV = 2720, PC_MO = 3232, PC_MI = 3744, PC_MF = 3748;

constexpr size_t MiB = 1u << 20;
constexpr size_t WS_CTL = 0, CTL_ZERO_BYTES = 1 * MiB;
constexpr size_t CTL_MOD_OFF = 512 * 1024;
constexpr size_t WS_W = 1 * MiB;
constexpr size_t W_FFIN = 0, W_FFIN_SZ = (size_t)2 * FF * DM * 2;
constexpr size_t W_FFOUT = 2 * W_FFIN_SZ, W_FFOUT_SZ = (size_t)DM * FF * 2;
constexpr size_t W_MIXIN = W_FFOUT + 2 * W_FFOUT_SZ, W_MIXIN_SZ = (size_t)PW * DM * 2;
constexpr size_t W_GATE = W_MIXIN + W_MIXIN_SZ, W_GATE_SZ = (size_t)2048 * DM * 2;
constexpr size_t W_BR = W_GATE + W_GATE_SZ, W_BR_SZ = (size_t)DM * 512 * 2;
constexpr size_t W_WOUT = W_BR + 2 * W_BR_SZ, W_WOUT_SZ = (size_t)DM * DM * 2;
constexpr size_t W_SMALL = W_WOUT + W_WOUT_SZ;
constexpr size_t W_SMALL_WUP = 0, W_SMALL_AUP = 8 * 64 * 32 * 2, W_SMALL_GUP = 2 * 8 * 64 * 32 * 2, W_SMALL_SZ = 512 * 1024;
constexpr size_t W_LAYER = W_SMALL + W_SMALL_SZ;
static_assert(W_LAYER == 49 * MiB, "weight block");
constexpr size_t WS_XN = WS_W + 2 * W_LAYER;
constexpr size_t WS_R = WS_XN + (size_t)MTOK * DM * 2;
constexpr size_t WS_F = WS_R + (size_t)MTOK * PW * 2;
constexpr size_t F_GV = 0;
constexpr size_t F_EV = F_GV + (size_t)NIT1 * 16384;
constexpr size_t F_MC = F_EV + (size_t)NIT1 * 16384;
constexpr size_t F_KS = F_MC + (size_t)NIT2 * 65536;
constexpr size_t F_MSC = F_KS + (size_t)NIT2 * 512;
constexpr size_t F_RHO = F_MSC + (size_t)NIT2 * 16;
constexpr size_t F_RSQ = F_RHO + (size_t)MTOK * 32;
constexpr size_t F_BIAS = F_RSQ + (size_t)MTOK * 64;
constexpr size_t BIAS_FF = (size_t)NB * 2 * FF, BIAS_MIX = (size_t)NB * PW, BIAS_GATE = (size_t)NB * 2048, BIAS_LAYER = 2 * BIAS_FF + BIAS_MIX + BIAS_GATE;
constexpr size_t F_CS = F_BIAS + 2 * BIAS_LAYER * 4;
constexpr size_t WS_END = WS_F + F_CS + (size_t)DEPTH * 3 * NB * DM * 4;
static_assert(F_EV + (size_t)MTOK * 2048 * 2 <= F_KS, "SG overlay");
static_assert((size_t)MTOK * DM * 2 <= F_EV, "T1/U overlay");
constexpr int CW_BAR = 4096;

constexpr int LDS_BYTES = 147456;
constexpr int MISC_OFF = LDS_BYTES - 256;
constexpr int NWAVES = 8;

#ifndef PROBE_SEC
#define PROBE_SEC 0
#endif
#if PROBE_SEC && !defined(EMU)
#define PSEC_B(id) unsigned long long _tp##id = 0ull; if (PROBE_SEC == id) _tp##id = __builtin_amdgcn_s_memrealtime();
#define PSEC_E(F, id) if (PROBE_SEC == id && threadIdx.x == 0) *(LAS unsigned long long*)((F).lds + MISC_OFF + 64) += __builtin_amdgcn_s_memrealtime() - _tp##id;
#else
#define PSEC_B(id)
#define PSEC_E(F, id)
#endif
#ifdef EMU
static inline float fexp(float x) { return expf(x); }
#else
__device__ __forceinline__ float fexp(float x) { return __expf(x); }
#endif
__device__ __forceinline__ float bf2f(bf16 b) { unsigned u = ((unsigned)b) << 16; return __builtin_bit_cast(float, u); }
#ifdef EMU
__device__ __forceinline__ unsigned f2bf(float f) { unsigned u = __builtin_bit_cast(unsigned, f); return (u + 0x7fffu + ((u >> 16) & 1u)) >> 16; }
__device__ __forceinline__ unsigned pk2(float lo, float hi) { return f2bf(lo) | (f2bf(hi) << 16); }
#else
typedef __bf16 hwbf16x2 __attribute__((ext_vector_type(2)));
__device__ __forceinline__ unsigned pk2(float lo, float hi) { const f32x2 v = {lo, hi}; return __builtin_bit_cast(unsigned, __builtin_convertvector(v, hwbf16x2)); }
__device__ __forceinline__ unsigned f2bf(float f) { return pk2(f, 0.f) & 0xffffu; }
#endif
#ifdef EMU
static inline float frcp(float x) { return 1.0f / x; }
static inline float frsq(float x) { return 1.0f / sqrtf(x); }
static inline float fsqrt(float x) { return sqrtf(x); }
static inline float flog(float x) { return logf(x); }
#else
__device__ __forceinline__ float frcp(float x) { return __builtin_amdgcn_rcpf(x); }
__device__ __forceinline__ float frsq(float x) { return __builtin_amdgcn_rsqf(x); }
__device__ __forceinline__ float fsqrt(float x) { return __builtin_amdgcn_sqrtf(x); }
__device__ __forceinline__ float flog(float x) { return __logf(x); }
#endif
__device__ __forceinline__ float sigmoidf_(float x) { return frcp(1.0f + fexp(-x)); }
__device__ __forceinline__ float siluf_(float x) { return x * frcp(1.0f + fexp(-x)); }
__device__ __forceinline__ float softplusf_(float x) { return fmaxf(x, 0.f) + flog(1.0f + fexp(-fabsf(x))); }
__device__ __forceinline__ float tanhf_(float x) { return 1.0f - 2.0f * frcp(fexp(2.0f * x) + 1.0f); }

#ifdef EMU
#define WAVE_LDS_FENCE() emu::wave_sync()
#define EMU_FENCE() do {} while (0)
#define lds_barrier() __syncthreads()
#define vm_lds_barrier() __syncthreads()
static inline void glds16(const void* gsrc_lane, unsigned char* lds_wave_base) { memcpy(lds_wave_base + 16 * (emu::cur & 63), gsrc_lane, 16); }
static inline f32x4 mfma4f(float a, float b, f32x4 c) {
    int w = emu::cur >> 6, l = emu::cur & 63; emu::xf[w][l] = a; emu::xu[w][l] = __builtin_bit_cast(unsigned, b);
    emu::wave_sync();
    for (int r = 0; r < 4; ++r) { int row = 4 * (l >> 4) + r, col = l & 15; float s = 0.f;
        for (int k = 0; k < 4; ++k) s += emu::xf[w][row + 16 * k] * __builtin_bit_cast(float, emu::xu[w][col + 16 * k]);
        c[r] += s; }
    emu::wave_sync(); return c;
}
#define LAUNDER(x) do {} while (0)
#define LAUNDER_S(x) do {} while (0)
static inline f32x4 mfma16(bf16x8 a, bf16x8 b, f32x4 c) {
    int w = emu::cur >> 6, l = emu::cur & 63;
    for (int j = 0; j < 8; ++j) { emu::xa[w][l][j] = (unsigned short)a[j]; emu::xb[w][l][j] = (unsigned short)b[j]; }
    emu::wave_sync();
    for (int r = 0; r < 4; ++r) { int row = 4 * (l >> 4) + r, col = l & 15; float s = 0.f;
        for (int k = 0; k < 32; ++k) s += bf2f(emu::xa[w][row + 16 * (k >> 3)][k & 7]) * bf2f(emu::xb[w][col + 16 * (k >> 3)][k & 7]);
        c[r] += s; }
    emu::wave_sync(); return c;
}
static inline float rdlane(float v, int l) { return __shfl(v, l); }
static inline int wave_id() { return threadIdx.x >> 6; }
#else
#define WAVE_LDS_FENCE() asm volatile("s_waitcnt lgkmcnt(0)" ::: "memory")
#define EMU_FENCE() asm volatile("" ::: "memory")
#define lds_barrier() asm volatile("s_waitcnt lgkmcnt(0)\n\ts_barrier" ::: "memory")
#define vm_lds_barrier() asm volatile("s_waitcnt vmcnt(0) lgkmcnt(0)\n\ts_barrier" ::: "memory")
__device__ __forceinline__ void glds16(const void* gsrc_lane, LAS unsigned char* lds_wave_base) { __builtin_amdgcn_global_load_lds((const unsigned*)gsrc_lane, (LAS unsigned*)lds_wave_base, 16, 0, 0); }
__device__ __forceinline__ f32x4 mfma4f(float a, float b, f32x4 c) { return __builtin_amdgcn_mfma_f32_16x16x4f32(a, b, c, 0, 0, 0); }
#define LAUNDER_S(x) asm volatile("" : "+s"(x))
#define LAUNDER(x) asm volatile("" : "+v"(x))
__device__ __forceinline__ f32x4 mfma16(bf16x8 a, bf16x8 b, f32x4 c) { return __builtin_amdgcn_mfma_f32_16x16x32_bf16(a, b, c, 0, 0, 0); }
__device__ __forceinline__ float rdlane(float v, int l) { return __builtin_bit_cast(float, __builtin_amdgcn_readlane(__builtin_bit_cast(int, v), l)); }
__device__ __forceinline__ int wave_id() { return __builtin_amdgcn_readfirstlane(threadIdx.x >> 6); }
#endif
#ifdef EMU
__device__ __forceinline__ float wave_sum(float v) {
    for (int o = 1; o < 64; o <<= 1) v += __shfl_xor(v, o);
    return v;
}
#else
template <int CTRL, int ROWMASK> __device__ __forceinline__ float dpp_add(float v) {
    return v + __builtin_bit_cast(float, __builtin_amdgcn_update_dpp(0, __builtin_bit_cast(int, v), CTRL, ROWMASK, 0xf, false)); }
__device__ __forceinline__ float wave_sum(float v) {
    v = dpp_add<0xB1, 0xf>(v);
    v = dpp_add<0x4E, 0xf>(v);
    v = dpp_add<0x141, 0xf>(v);
    v = dpp_add<0x140, 0xf>(v);
    v = dpp_add<0x142, 0xa>(v);
    v = dpp_add<0x143, 0xc>(v);
    return rdlane(v, 63);
}
#endif

namespace pg8 {
#define PG8_LAS LAS
typedef unsigned short bf16_t;
constexpr int BM = 256, BK = 64, HALF = 128, HTB = HALF * BK * 2  , STAGE_BYTES = 8 * HTB, NXCD = 8, WGM = 8;
__host__ __device__ __forceinline__ int lds_byte(int r, int c) { const int st = (r >> 4) * 2 + (c >> 5), rr = r & 15, cc = c & 31, ob = rr * 64 + cc * 2; return st * 1024 + (ob ^ (((ob >> 9) & 1) << 5)); }
__host__ __device__ __forceinline__ void stage_rc(int b, int& R, int& C) { const int st = b / 1024, sb = b % 1024, swz = sb ^ (((sb >> 9) & 1) << 5); R = (st >> 1) * 16 + swz / 64; C = (st & 1) * 32 + (swz % 64) / 2; }
__host__ __device__ __forceinline__ int perm32(int rho) { const int n = rho >> 4, i = rho & 15; return 8 * (i >> 2) + 4 * n + (i & 3); }
struct Unit { int pm, pn; };
struct Gemm { const bf16_t* A; const bf16_t* Bt; int M, N, K, lda; };
struct StaticOrder {
    int nM, nN, nwg, G, c;
    __host__ __device__ void init(int M, int N, int G_, int c_) { nM = M / BM; nN = N / BM; nwg = nM * nN; G = G_; c = c_; }
    __host__ __device__ bool next(int i, Unit& u) const {
        const long L = (long)i * G + c; if (L >= nwg) return false;
        int wgid = (int)L; { const int q = nwg / NXCD, r = nwg % NXCD, xcd = wgid % NXCD, off = wgid / NXCD; wgid = (xcd < r ? xcd * (q + 1) : r * (q + 1) + (xcd - r) * q) + off; }
        const int nig = WGM * nN, gid = wgid / nig, fm = gid * WGM, gsz = (nM - fm) < WGM ? (nM - fm) : WGM;
        u.pm = fm + ((wgid % nig) % gsz); u.pn = (wgid % nig) / gsz; return true;
    }
    __device__ __forceinline__ void a_ready(const Unit&) const {}
    __device__ __forceinline__ void done(const Unit&) const {}
};
struct GateOrder {
    StaticOrder base;
    __host__ __device__ void init(int M, int G_, int c_) { base.init(M, 1024, G_, c_); }
    __host__ __device__ bool next(int i, Unit& u) const { if (!base.next(i >> 1, u)) return false; u.pn += 4 * (i & 1); return true; }
    __device__ __forceinline__ void a_ready(const Unit&) const {}
    __device__ __forceinline__ void done(const Unit&) const {}
};
#ifndef EMU
__device__ __forceinline__ unsigned cvt_pk_bf16(float lo, float hi) { unsigned r; asm volatile("v_cvt_pk_bf16_f32 %0, %1, %2" : "=v"(r) : "v"(lo), "v"(hi)); return r; }
template <class Epi, class Sched, bool ALIGN_EPI = false, bool SP2 = false>
__device__ __forceinline__ void gemm_phase(PG8_LAS unsigned char* lds, const Gemm g, const Sched& S, const Epi& E) {
    int tid_ = threadIdx.x; asm volatile("" : "+v"(tid_));
    const int tid = tid_, wid = __builtin_amdgcn_readfirstlane(tid >> 6), lane = tid & 63, wr = wid >> 2, wc = wid & 3, fr = lane & 15, fq = lane >> 4;
    const int K = g.K, nt = K / BK;
    unsigned voffA[2], voffB[2];
#pragma unroll
    for (int i = 0; i < 2; ++i) { int R, C; stage_rc(tid * 16 + i * 8192, R, C); const int Rb = Epi::PERM ? ((R & ~31) + perm32(R & 31)) : R;
        voffA[i] = (unsigned)(R * g.lda + C) * 2u; voffB[i] = (unsigned)(Rb * K + C) * 2u; }
    const size_t kstep = (size_t)(BK * 2);
    const size_t hstep = (size_t)HALF * K * 2;
    const size_t tstep = 2 * hstep; const size_t hstepA = (size_t)HALF * g.lda * 2, tstepA = 2 * hstepA;
    const unsigned ldsw = (unsigned)wid * 1024u;
    const int aoff = lds_byte(wr * 64 + fr, fq * 8), boff = lds_byte(wc * 32 + fr, fq * 8);
#define PG8_SA(b, h) (((b) * 2 + (h)) * HTB)
#define PG8_SB(b, h) ((4 + (b) * 2 + (h)) * HTB)
#define PG8_STAGE(bufoff, gbase, voff) do { _Pragma("unroll") for (int _i = 0; _i < 2; ++_i) \
        __builtin_amdgcn_global_load_lds((const unsigned*)((const char*)(gbase) + (voff)[_i]), (PG8_LAS unsigned*)(lds + (bufoff) + ldsw + _i * 8192), 16, 0, 0); } while (0)
#define PG8_LDA(dst, b, h) do { _Pragma("unroll") for (int m = 0; m < 4; ++m) _Pragma("unroll") for (int k = 0; k < 2; ++k) dst[m][k] = *(const PG8_LAS bf16x8*)(lds + PG8_SA(b, h) + aoff + m * 2048 + k * 1024); } while (0)
#define PG8_LDB(dst, b, h) do { _Pragma("unroll") for (int n = 0; n < 2; ++n) _Pragma("unroll") for (int k = 0; k < 2; ++k) dst[n][k] = *(const PG8_LAS bf16x8*)(lds + PG8_SB(b, h) + boff + n * 2048 + k * 1024); } while (0)
#define PG8_MMA(ai, bj, At, Bt) do { __builtin_amdgcn_s_setprio(1); _Pragma("unroll") for (int m = 0; m < 4; ++m) _Pragma("unroll") for (int n = 0; n < 2; ++n) _Pragma("unroll") for (int k = 0; k < 2; ++k) \
        acc[ai][bj][m][n] = __builtin_amdgcn_mfma_f32_16x16x32_bf16(Bt[n][k], At[m][k], acc[ai][bj][m][n], 0, 0, 0); __builtin_amdgcn_s_setprio(0); } while (0)
#define PG8_WAIT_V(n) asm volatile("s_waitcnt vmcnt(" #n ")" ::: "memory")
#define PG8_WAIT_L(n) asm volatile("s_waitcnt lgkmcnt(" #n ")" ::: "memory")
#define PG8_BAR __builtin_amdgcn_s_barrier()
#define PG8_SCHED __builtin_amdgcn_sched_barrier(0)
    Unit cur, nxt; int ui = 0;
    if (!S.next(0, cur)) return;
    f32x4 acc[2][2][4][2];
#pragma unroll
    for (int a = 0; a < 2; ++a)
#pragma unroll
        for (int b = 0; b < 2; ++b)
#pragma unroll
            for (int m = 0; m < 4; ++m)
#pragma unroll
                for (int n = 0; n < 2; ++n) acc[a][b][m][n] = (f32x4){0.f, 0.f, 0.f, 0.f};
    bf16x8 At[4][2], B0[2][2], B1[2][2];
    const char* cA = (const char*)g.A + (size_t)cur.pm * tstepA; const char* cB = (const char*)g.Bt + (size_t)cur.pn * tstep;
    S.a_ready(cur);
    if constexpr (SP2) {
        PG8_STAGE(PG8_SB(0, 0), cB, voffB); PG8_STAGE(PG8_SB(0, 1), cB + hstep, voffB); PG8_STAGE(PG8_SA(0, 0), cA, voffA); PG8_STAGE(PG8_SA(0, 1), cA + hstepA, voffA);
        if (wr == 1) PG8_BAR;
        PG8_WAIT_V(2); PG8_BAR;
        PG8_STAGE(PG8_SB(1, 0), cB + kstep, voffB); PG8_STAGE(PG8_SA(1, 0), cA + kstep, voffA); PG8_STAGE(PG8_SB(1, 1), cB + hstep + kstep, voffB);
        PG8_WAIT_V(6); PG8_BAR;
    } else {
        PG8_STAGE(PG8_SB(0, 0), cB, voffB); PG8_STAGE(PG8_SA(0, 0), cA, voffA); PG8_STAGE(PG8_SB(0, 1), cB + hstep, voffB); PG8_STAGE(PG8_SA(0, 1), cA + hstepA, voffA);
        if (wr == 1) PG8_BAR;
        PG8_WAIT_V(4); PG8_BAR;
        PG8_STAGE(PG8_SB(1, 0), cB + kstep, voffB); PG8_STAGE(PG8_SA(1, 0), cA + kstep, voffA); PG8_STAGE(PG8_SB(1, 1), cB + hstep + kstep, voffB);
        PG8_WAIT_V(6); PG8_BAR;
    }
    for (;;) {
        const bool has_next = S.next(ui + 1, nxt);
        const char* nA = has_next ? (const char*)g.A + (size_t)nxt.pm * tstepA : cA; const char* nB = has_next ? (const char*)g.Bt + (size_t)nxt.pn * tstep : cB;
        for (int t = 0; t < nt; t += 2) {
            const bool last = (t == nt - 2);
            const char* a1 = cA + (size_t)(t + 1) * kstep;
            const char* a2 = last ? nA : cA + (size_t)(t + 2) * kstep; const char* b2 = last ? nB : cB + (size_t)(t + 2) * kstep;
            const char* a3 = a2 + kstep; const char* b3 = b2 + kstep;
            if (last && has_next) S.a_ready(nxt);
            if constexpr (SP2) {
            PG8_LDB(B0, 0, 0); PG8_LDB(B1, 0, 1); PG8_SCHED; PG8_LDA(At, 0, 0); PG8_STAGE(PG8_SA(1, 1), a1 + hstepA, voffA);
            PG8_WAIT_V(8); PG8_WAIT_L(0); PG8_BAR; PG8_MMA(0, 0, At, B0); PG8_MMA(0, 1, At, B1); PG8_BAR; PG8_SCHED;
            PG8_LDA(At, 0, 1); PG8_STAGE(PG8_SB(0, 0), b2, voffB); PG8_STAGE(PG8_SB(0, 1), b2 + hstep, voffB); PG8_STAGE(PG8_SA(0, 0), a2, voffA);
            PG8_WAIT_V(8); PG8_WAIT_L(0); PG8_BAR; PG8_MMA(1, 0, At, B0); PG8_MMA(1, 1, At, B1); PG8_BAR; PG8_SCHED;
            PG8_LDB(B0, 1, 0); PG8_LDB(B1, 1, 1); PG8_SCHED; PG8_LDA(At, 1, 0); PG8_STAGE(PG8_SA(0, 1), a2 + hstepA, voffA);
            PG8_WAIT_V(8); PG8_WAIT_L(0); PG8_BAR; PG8_MMA(0, 0, At, B0); PG8_MMA(0, 1, At, B1); PG8_BAR; PG8_SCHED;
            PG8_LDA(At, 1, 1); PG8_STAGE(PG8_SB(1, 0), b3, voffB); PG8_STAGE(PG8_SB(1, 1), b3 + hstep, voffB); PG8_STAGE(PG8_SA(1, 0), a3, voffA);
            PG8_WAIT_V(8); PG8_WAIT_L(0); PG8_BAR; PG8_MMA(1, 0, At, B0); PG8_MMA(1, 1, At, B1); PG8_BAR; PG8_SCHED;
            } else {
            PG8_LDB(B0, 0, 0); PG8_SCHED; PG8_LDA(At, 0, 0); PG8_STAGE(PG8_SA(1, 1), a1 + hstepA, voffA);
            PG8_WAIT_L(8); PG8_BAR; PG8_WAIT_L(0); PG8_MMA(0, 0, At, B0); PG8_BAR; PG8_SCHED;
            PG8_LDB(B1, 0, 1); PG8_STAGE(PG8_SB(0, 0), b2, voffB);
            PG8_BAR; PG8_WAIT_L(0); PG8_MMA(0, 1, At, B1); PG8_BAR;
            PG8_LDA(At, 0, 1); PG8_STAGE(PG8_SA(0, 0), a2, voffA);
            PG8_BAR; PG8_WAIT_L(0); PG8_MMA(1, 0, At, B0); PG8_BAR; PG8_SCHED;
            PG8_STAGE(PG8_SB(0, 1), b2 + hstep, voffB);
            PG8_WAIT_V(6); PG8_BAR; PG8_MMA(1, 1, At, B1); PG8_BAR;
            PG8_LDB(B0, 1, 0); PG8_SCHED; PG8_LDA(At, 1, 0); PG8_STAGE(PG8_SA(0, 1), a2 + hstepA, voffA);
            PG8_WAIT_L(8); PG8_BAR; PG8_WAIT_L(0); PG8_MMA(0, 0, At, B0); PG8_BAR; PG8_SCHED;
            PG8_LDB(B1, 1, 1); PG8_STAGE(PG8_SB(1, 0), b3, voffB);
            PG8_BAR; PG8_WAIT_L(0); PG8_MMA(0, 1, At, B1); PG8_BAR;
            PG8_LDA(At, 1, 1); PG8_STAGE(PG8_SA(1, 0), a3, voffA);
            PG8_BAR; PG8_WAIT_L(0); PG8_MMA(1, 0, At, B0); PG8_BAR; PG8_SCHED;
            PG8_STAGE(PG8_SB(1, 1), b3 + hstep, voffB);
            PG8_WAIT_V(6); PG8_BAR; PG8_MMA(1, 1, At, B1); PG8_BAR;
            }
        }
        if constexpr (ALIGN_EPI) { if (wr == 0) PG8_BAR; }
        if constexpr (!Epi::AFTER_DRAIN) { E(acc, cur, wr, wc, fr, fq); S.done(cur); }
        if (!has_next) break;
#pragma unroll
        for (int a = 0; a < 2; ++a)
#pragma unroll
            for (int b = 0; b < 2; ++b)
#pragma unroll
                for (int m = 0; m < 4; ++m)
#pragma unroll
                    for (int n = 0; n < 2; ++n) acc[a][b][m][n] = (f32x4){0.f, 0.f, 0.f, 0.f};
        cur = nxt; cA = nA; cB = nB; ++ui;
        if constexpr (ALIGN_EPI) { if (wr == 1) PG8_BAR; }
    }
    PG8_WAIT_V(0);
    if constexpr (!ALIGN_EPI) { if (wr == 0) PG8_BAR; }
    PG8_BAR;
    if constexpr (Epi::AFTER_DRAIN) { E.fused(acc, cur, wr, wc, fr, fq, lds, wid, lane); S.done(cur); }
#undef PG8_SA
#undef PG8_SB
#undef PG8_STAGE
#undef PG8_LDA
#undef PG8_LDB
#undef PG8_MMA
#undef PG8_WAIT_V
#undef PG8_WAIT_L
#undef PG8_BAR
#undef PG8_SCHED
}

#else
static inline unsigned cvt_pk_bf16(float lo, float hi) { return pk2(lo, hi); }
template <class Epi, class Sched, bool ALIGN_EPI = false, bool SP2 = false>
static void gemm_phase(unsigned char* lds, const Gemm g, const Sched& S, const Epi& E) {
    if (threadIdx.x != 0) return;
    static std::vector<float> C; C.resize(256 * 256);
    Unit u;
    for (int i = 0; S.next(i, u); ++i) {
        for (int r = 0; r < 256; ++r) for (int c = 0; c < 256; ++c) { const bf16_t* a = g.A + (size_t)(u.pm * 256 + r) * g.lda; const bf16_t* b = g.Bt + (size_t)(u.pn * 256 + c) * g.K; float s = 0.f; for (int k = 0; k < g.K; ++k) s += bf2f(a[k]) * bf2f(b[k]); C[r * 256 + c] = s; }
        for (int tid = 0; tid < 512; ++tid) { const int wid = tid >> 6, lane = tid & 63, wr = wid >> 2, wc = wid & 3, fr = lane & 15, fq = lane >> 4;
            f32x4 acc[2][2][4][2];
            for (int ai = 0; ai < 2; ++ai) for (int bj = 0; bj < 2; ++bj) for (int m = 0; m < 4; ++m) for (int n = 0; n < 2; ++n) for (int e = 0; e < 4; ++e) {
                const int r = 128 * ai + 64 * wr + 16 * m + fr, c = Epi::PERM ? (128 * bj + 32 * wc + 8 * fq + 4 * n + e) : (128 * bj + 32 * wc + 16 * n + 4 * fq + e);
                acc[ai][bj][m][n][e] = C[r * 256 + c]; }
            E(acc, u, wr, wc, fr, fq); }
    }
}
#endif
}

struct Frame {
    LAS unsigned char* lds;
    int tid, lane, wave, G, bid;
};
constexpr int TBL_OFF = MISC_OFF - 256;
#ifdef EMU
__device__ __forceinline__ const float* inp(const Frame& F, int i) { return *(const float* const*)(F.lds + TBL_OFF + 8 * i); }
__device__ __forceinline__ float* xout(const Frame& F) { return *(float* const*)(F.lds + TBL_OFF + 8 * 27); }
__device__ __forceinline__ unsigned char* wsb(const Frame& F) { return *(unsigned char* const*)(F.lds + TBL_OFF + 8 * 28); }
#else
__device__ __forceinline__ const float* inp(const Frame& F, int i) { return (const float*)(*(GAS const float* const LAS*)(F.lds + TBL_OFF + 8 * i)); }
__device__ __forceinline__ float* xout(const Frame& F) { return (float*)(*(GAS float* const LAS*)(F.lds + TBL_OFF + 8 * 27)); }
__device__ __forceinline__ unsigned char* wsb(const Frame& F) { return (unsigned char*)(*(GAS unsigned char* const LAS*)(F.lds + TBL_OFF + 8 * 28)); }
#endif
__device__ __forceinline__ Frame relaunder(const Frame& F) { Frame G = F; LAUNDER(G.lane); LAUNDER_S(G.wave); LAUNDER_S(G.lds); G.tid = G.wave * 64 + G.lane; return G; }
template <class T> __device__ __forceinline__ T* wsp(const Frame& F, size_t off) { return (T*)(wsb(F) + off); }
__device__ __forceinline__ unsigned char* wlayer(const Frame& F, int l) { return wsb(F) + WS_W + (size_t)l * W_LAYER; }
__device__ __forceinline__ const float* modp(const Frame& F, int l, int chunk) { return (const float*)(wsb(F) + CTL_MOD_OFF) + (size_t)l * NB * 9216 + chunk * 1024; }
template <class T> __device__ __forceinline__ LAS T* ldsp(LAS unsigned char* base, int off) { return (LAS T*)(base + off); }

__device__ __forceinline__ void p0_item(const float* W, int ldw, int K, int src_col0, int ncols, bf16* WT, int dest_row0, LAS float* scr, int kb, int lane) {
    const int k0 = 64 * kb;
#pragma unroll 8
    for (int i = 0; i < 32; ++i) { const int kk = 2 * i + (lane >> 5), cc = lane & 31;
        scr[kk * 33 + cc] = cc < ncols ? W[(size_t)(k0 + kk) * ldw + src_col0 + cc] : 0.f; }
    WAVE_LDS_FENCE();
    const int c = lane & 7;
#pragma unroll
    for (int j = 0; j < 4; ++j) { const int n = (lane >> 3) + 8 * j; const LAS float* s = scr + (8 * c) * 33 + n;
        u32x4 o; o.x = pk2(s[0], s[33]); o.y = pk2(s[66], s[99]); o.z = pk2(s[132], s[165]); o.w = pk2(s[198], s[231]);
        *(u32x4*)(WT + (size_t)(dest_row0 + n) * K + k0 + 8 * c) = o; }
    WAVE_LDS_FENCE();
}
constexpr int P0_ITEMS_L = 5632 + 2816 + 1920 + 1024 + 512 + 512;
__device__ __forceinline__ void ph_convert(Frame& F0, int lw, int first_wg) {
    Frame F = relaunder(F0);
    if (F.bid < first_wg) return;
    LAS float* scr = ldsp<float>(F.lds, F.wave * 16384);
    const int gw = (F.bid - first_wg) * NWAVES + F.wave, NGW = (F.G - first_wg) * NWAVES, lane = F.lane;
    for (int it = gw; it < P0_ITEMS_L; it += NGW) {
        const int l = lw; int r = it; unsigned char* wl = wlayer(F, l);
        if (r < 5632) { const int i = r / 2816, q = r % 2816, kb = q / 176, rb = q % 176, pn = rb >> 3, qq = rb & 7;
            const int sc0 = qq < 4 ? 128 * pn + 32 * qq : FF + 128 * pn + 32 * (qq - 4);
            p0_item(inp(F, 5) + (size_t)(l * 2 + i) * DM * (2 * FF), 2 * FF, DM, sc0, 32, (bf16*)(wl + W_FFIN + i * W_FFIN_SZ), 32 * rb, scr, kb, lane); continue; }
        r -= 5632;
        if (r < 2816) { const int i = r / 1408, q = r % 1408, kb = q / 32, rb = q % 32;
            p0_item(inp(F, 6) + (size_t)(l * 2 + i) * FF * DM, DM, FF, 32 * rb, 32, (bf16*)(wl + W_FFOUT + i * W_FFOUT_SZ), 32 * rb, scr, kb, lane); continue; }
        r -= 2816;
        if (r < 1920) { const int kb = r / 120, rb = r % 120; int nc = (RCOLS + MCOLS) - 32 * rb; nc = nc < 0 ? 0 : (nc > 32 ? 32 : nc);
            p0_item(inp(F, 7) + (size_t)l * DM * NIN, NIN, DM, 32 * rb, nc, (bf16*)(wl + W_MIXIN), 32 * rb, scr, kb, lane); continue; }
        r -= 1920;
        if (r < 1024) { const int kb = r / 64, rb = r % 64;
            p0_item(inp(F, 7) + (size_t)l * DM * NIN, NIN, DM, (RCOLS + MCOLS) + 32 * rb, 32, (bf16*)(wl + W_GATE), 32 * rb, scr, kb, lane); continue; }
        r -= 1024;
        if (r < 512) { const int j = r / 256, q = r % 256, kb = q / 32, rb = q % 32;
            p0_item(inp(F, 23 + j) + (size_t)l * 512 * DM, DM, 512, 32 * rb, 32, (bf16*)(wl + W_BR + j * W_BR_SZ), 32 * rb, scr, kb, lane); continue; }
        r -= 512;
        { const int kb = r / 32, rb = r % 32;
            p0_item(inp(F, 25) + (size_t)l * DM * DM, DM, DM, 32 * rb, 32, (bf16*)(wl + W_WOUT), 32 * rb, scr, kb, lane); }
    }
    for (int idx = (F.bid - first_wg) * 512 + F.tid; idx < 81920; idx += (F.G - first_wg) * 512) {
        const int l = lw; int r = idx; bf16* sm = (bf16*)(wlayer(F, l) + W_SMALL);
        if (r < 32768) { const int which = r >> 14, e = r & 16383, ch = e >> 5, j = e & 31;
            sm[(which ? W_SMALL_AUP : W_SMALL_WUP) / 2 + e] = (bf16)f2bf(inp(F, which ? 12 : 10)[(size_t)(l * 32 + j) * RW + ch]); }
        else { const int e = r - 32768, ch = e / 96, j = e % 96;
            sm[W_SMALL_GUP / 2 + e] = (bf16)f2bf(inp(F, 13)[(size_t)(l * 96 + j) * RW + ch]); }
    }
}
__device__ __forceinline__ void ph_mod(Frame& F0) {
    Frame F = relaunder(F0);
    const int lane = F.lane;
    float* mod = (float*)(wsb(F) + CTL_MOD_OFF);
    for (int it = F.bid; it < DEPTH * 36; it += F.G) {
        const int l = it / 36, cg = it % 36, c0 = 256 * cg + 4 * lane, k0 = 128 * F.wave;
        f32x4 acc[NB];
#pragma unroll
        for (int b = 0; b < NB; ++b) acc[b] = (f32x4){0.f, 0.f, 0.f, 0.f};
        for (int half = 0; half < 2; ++half) {
            float cb[NB];
#pragma unroll
            for (int b = 0; b < NB; ++b) cb[b] = siluf_(inp(F, 1)[b * DM + k0 + 64 * half + lane]);
            const float* wp = inp(F, 2) + ((size_t)l * DM + k0 + 64 * half) * 9216 + c0;
#pragma unroll 8
            for (int kk = 0; kk < 64; ++kk) { const f32x4 w4 = *(const f32x4*)(wp + (size_t)kk * 9216);
#pragma unroll
                for (int b = 0; b < NB; ++b) acc[b] += w4 * rdlane(cb[b], kk); }
        }
        LAS float* part = ldsp<float>(F.lds, F.wave * 16384 + 8448);
#pragma unroll
        for (int b = 0; b < NB; ++b) *(LAS f32x4*)(part + b * 256 + 4 * lane) = acc[b];
        lds_barrier();
        for (int o = F.tid; o < NB * 256; o += 512) { const int b = o >> 8, cc = o & 255; float s = inp(F, 3)[(size_t)l * 9216 + 256 * cg + cc];
#pragma unroll
            for (int ww = 0; ww < NWAVES; ++ww) s += *ldsp<float>(F.lds, ww * 16384 + 8448 + (b * 256 + cc) * 4);
            mod[((size_t)l * NB + b) * 9216 + 256 * cg + cc] = s; }
        lds_barrier();
    }
}

__device__ __forceinline__ float* rowsq16(const Frame& F) { return wsp<float>(F, WS_F + F_RSQ); }
__device__ __forceinline__ float row_rstd(const float* rsq, size_t m) {
    const f32x4* p = (const f32x4*)(rsq + m * 16); const f32x4 a = p[0], b = p[1], c = p[2], d = p[3];
    const float s = ((a[0] + a[1]) + (a[2] + a[3])) + ((b[0] + b[1]) + (b[2] + b[3])) + (((c[0] + c[1]) + (c[2] + c[3])) + ((d[0] + d[1]) + (d[2] + d[3])));
    return frsq(s * (1.0f / DM) + 1e-6f);
}
__device__ __forceinline__ void ph_prenorm(Frame& F0, const float* xin, const float* g, const float* sc) {
    Frame F = relaunder(F0);
    const int gw = F.bid * NWAVES + F.wave, NGW = F.G * NWAVES, lane = F.lane;
    bf16* XN = wsp<bf16>(F, WS_XN); float* rsq = rowsq16(F);
    for (int m = gw; m < MTOK; m += NGW) {
        const int b = m / SEQ; const f32x4* xr = (const f32x4*)(xin + (size_t)m * DM) + lane;
        f32x4 v[4]; float s = 0.f;
#pragma unroll
        for (int j = 0; j < 4; ++j) { v[j] = xr[64 * j]; s += (v[j][0] * v[j][0] + v[j][1] * v[j][1]) + (v[j][2] * v[j][2] + v[j][3] * v[j][3]); }
        s = wave_sum(s);
        if (lane < 16) rsq[(size_t)m * 16 + lane] = lane == 0 ? s : 0.f;
#pragma unroll
        for (int j = 0; j < 4; ++j) { const int c = 4 * lane + 256 * j; const f32x4 gg = *(const f32x4*)(g + c), s1 = *(const f32x4*)(sc + (size_t)b * 9216 + c);
            const f32x4 y = v[j] * gg * (s1 + 1.0f);
            u32x2 o; o.x = pk2(y[0], y[1]); o.y = pk2(y[2], y[3]); *(u32x2*)(XN + (size_t)m * DM + c) = o; }
    }
}
__device__ __forceinline__ void ph_finalnorm(Frame& F0, const float* g) {
    Frame F = relaunder(F0);
    const int gw = F.bid * NWAVES + F.wave, NGW = F.G * NWAVES, lane = F.lane;
    float* X = xout(F); const float* rsq = rowsq16(F);
    for (int m = gw; m < MTOK; m += NGW) {
        const float rstd = row_rstd(rsq, (size_t)m);
#pragma unroll
        for (int j = 0; j < 4; ++j) { f32x4* p = (f32x4*)(X + (size_t)m * DM) + lane + 64 * j; const f32x4 gg = *((const f32x4*)g + lane + 64 * j); *p = *p * rstd * gg; }
    }
}
__device__ __forceinline__ void ph_bias(Frame& F0, int lb) {
    Frame F = relaunder(F0);
    const int gw = F.bid * NWAVES + F.wave, NGW = F.G * NWAVES, lane = F.lane;
    for (int i0 = F.bid * 512 + F.tid; i0 < 3 * NB * DM; i0 += F.G * 512) { const int i = lb * 3 * NB * DM + i0, c = i % DM, b = (i / DM) % NB, wch = (i / (DM * NB)) % 3, l = lb;
        wsp<float>(F, WS_F + F_CS)[i] = inp(F, 4)[(size_t)(l * 3 + wch) * DM + c] * (1.0f + modp(F, l, 3 * wch + 1)[(size_t)b * 9216 + c]); }
    constexpr int ROWS_L = 2 * (2 * FF) + PW + 2048;
    for (int it = gw; it < ROWS_L; it += NGW) {
        const int l = lb; int r = it; unsigned char* wl = wlayer(F, l);
        const bf16* wrow; const float* sh; float* out; int ldo;
        float* bl = wsp<float>(F, WS_F + F_BIAS) + (size_t)l * BIAS_LAYER;
        if (r < 2 * FF) { wrow = (const bf16*)(wl + W_FFIN) + (size_t)r * DM; sh = modp(F, l, 0); out = bl + r; ldo = 2 * FF; }
        else if (r < 4 * FF) { r -= 2 * FF; wrow = (const bf16*)(wl + W_FFIN + W_FFIN_SZ) + (size_t)r * DM; sh = modp(F, l, 6); out = bl + BIAS_FF + r; ldo = 2 * FF; }
        else if (r < 4 * FF + PW) { r -= 4 * FF; wrow = (const bf16*)(wl + W_MIXIN) + (size_t)r * DM; sh = modp(F, l, 3); out = bl + 2 * BIAS_FF + r; ldo = PW; }
        else { r -= 4 * FF + PW; wrow = (const bf16*)(wl + W_GATE) + (size_t)r * DM; sh = modp(F, l, 3); out = bl + 2 * BIAS_FF + BIAS_MIX + r; ldo = 2048; }
        const u32x4 w0 = *(const u32x4*)(wrow + 8 * lane), w1 = *(const u32x4*)(wrow + 512 + 8 * lane);
        float wf[16];
#pragma unroll
        for (int e = 0; e < 4; ++e) { wf[2 * e] = bf2f((bf16)(w0[e] & 0xffffu)); wf[2 * e + 1] = bf2f((bf16)(w0[e] >> 16)); wf[8 + 2 * e] = bf2f((bf16)(w1[e] & 0xffffu)); wf[8 + 2 * e + 1] = bf2f((bf16)(w1[e] >> 16)); }
#pragma unroll
        for (int b = 0; b < NB; ++b) { const float* sb = sh + (size_t)b * 9216; const f32x4 s0 = *(const f32x4*)(sb + 8 * lane), s1 = *(const f32x4*)(sb + 8 * lane + 4), s2 = *(const f32x4*)(sb + 512 + 8 * lane), s3 = *(const f32x4*)(sb + 512 + 8 * lane + 4);
            float acc = 0.f;
#pragma unroll
            for (int e = 0; e < 4; ++e) acc += wf[e] * s0[e] + wf[4 + e] * s1[e] + wf[8 + e] * s2[e] + wf[12 + e] * s3[e];
            acc = wave_sum(acc);
            if (lane == 0) out[(size_t)b * ldo] = acc; }
    }
}

struct EpiSwiglu {
    static constexpr bool PERM = true, AFTER_DRAIN = false; bf16* H; const float* rsq; const float* bias;
    __device__ __forceinline__ void operator()(const f32x4 (&acc)[2][2][4][2], const pg8::Unit& u, int wr, int wc, int fr, int fq) const {
        const int row0 = u.pm * 256 + wr * 64 + fr, col0 = u.pn * 128 + wc * 32 + 8 * fq, b = (u.pm * 256) / SEQ;
        const float* bp = bias + (size_t)b * (2 * FF) + u.pn * 256 + wc * 32 + 8 * fq;
        f32x4 bg[2], bu[2];
#pragma unroll
        for (int n = 0; n < 2; ++n) { bg[n] = *(const f32x4*)(bp + 4 * n); bu[n] = *(const f32x4*)(bp + 128 + 4 * n); }
#pragma unroll
        for (int ai = 0; ai < 2; ++ai)
#pragma unroll
            for (int m = 0; m < 4; ++m) { const size_t r = (size_t)(row0 + ai * 128 + m * 16); const float rstd = row_rstd(rsq, r); float hh[8];
#pragma unroll
                for (int n = 0; n < 2; ++n)
#pragma unroll
                    for (int e = 0; e < 4; ++e) hh[4 * n + e] = siluf_(acc[ai][0][m][n][e] * rstd + bg[n][e]) * (acc[ai][1][m][n][e] * rstd + bu[n][e]);
                u32x4 o; o.x = pk2(hh[0], hh[1]); o.y = pk2(hh[2], hh[3]); o.z = pk2(hh[4], hh[5]); o.w = pk2(hh[6], hh[7]);
                *(u32x4*)(H + r * FF + col0) = o; }
    }
};
template <bool HALF> struct EpiRes {
    static constexpr bool PERM = false, AFTER_DRAIN = false; const float* Xin; float* Xout; const float* gate; bf16* XS; const float* csn; float* rsq;
    __device__ __forceinline__ void operator()(const f32x4 (&acc)[2][2][4][2], const pg8::Unit& u, int wr, int wc, int fr, int fq) const {
        const int row0 = u.pm * 256 + wr * 64 + fr, col0 = u.pn * 256 + wc * 32 + 4 * fq, b = (u.pm * 256) / SEQ;
        f32x4 gv[2][2]; const float* csb = csn ? csn + (size_t)b * DM + col0 : nullptr;
#pragma unroll
        for (int bj = 0; bj < 2; ++bj)
#pragma unroll
            for (int n = 0; n < 2; ++n) { const int c = col0 + bj * 128 + n * 16; gv[bj][n] = (*(const f32x4*)(gate + (size_t)b * 9216 + c) + 1.0f) * (HALF ? 0.5f : 1.0f); }
        f32x4 xa[2][2], xb[2][2]; float ss[8];
#define EPIRES_LOAD(dst, g) { const size_t off_ = (size_t)(row0 + ((g) >> 2) * 128 + ((g) & 3) * 16) * DM + col0; _Pragma("unroll") for (int bj = 0; bj < 2; ++bj) _Pragma("unroll") for (int n = 0; n < 2; ++n) dst[bj][n] = *(const f32x4*)(Xin + off_ + bj * 128 + n * 16); }
#define EPIRES_DO(src, g) { const size_t off_ = (size_t)(row0 + ((g) >> 2) * 128 + ((g) & 3) * 16) * DM + col0; float s_ = 0.f; \
            _Pragma("unroll") for (int bj = 0; bj < 2; ++bj) _Pragma("unroll") for (int n = 0; n < 2; ++n) { const f32x4 x = src[bj][n] + gv[bj][n] * acc[(g) >> 2][bj][(g) & 3][n]; *(f32x4*)(Xout + off_ + bj * 128 + n * 16) = x; \
                s_ += (x[0] * x[0] + x[1] * x[1]) + (x[2] * x[2] + x[3] * x[3]); \
                if (csn) { const f32x4 y = x * *(const f32x4*)(csb + bj * 128 + n * 16); u32x2 o; o.x = pk2(y[0], y[1]); o.y = pk2(y[2], y[3]); *(u32x2*)(XS + off_ + bj * 128 + n * 16) = o; } } \
            ss[g] = s_; }
        EPIRES_LOAD(xa, 0) EMU_FENCE();
        EPIRES_LOAD(xb, 1) EMU_FENCE(); EPIRES_DO(xa, 0)
        EPIRES_LOAD(xa, 2) EMU_FENCE(); EPIRES_DO(xb, 1)
        EPIRES_LOAD(xb, 3) EMU_FENCE(); EPIRES_DO(xa, 2)
        EPIRES_LOAD(xa, 4) EMU_FENCE(); EPIRES_DO(xb, 3)
        EPIRES_LOAD(xb, 5) EMU_FENCE(); EPIRES_DO(xa, 4)
        EPIRES_LOAD(xa, 6) EMU_FENCE(); EPIRES_DO(xb, 5)
        EPIRES_LOAD(xb, 7) EMU_FENCE(); EPIRES_DO(xa, 6)
        EPIRES_DO(xb, 7)
#undef EPIRES_LOAD
#undef EPIRES_DO
#pragma unroll
        for (int g = 0; g < 8; ++g) { float* rp = rsq + (size_t)(row0 + (g >> 2) * 128 + (g & 3) * 16) * 16 + u.pn * 4 + wc;
#ifdef EMU
            if (fq == 0) *rp = ss[g]; else *rp += ss[g];
#else
            float s = ss[g]; s += __shfl_xor(s, 16); s += __shfl_xor(s, 32);
            if (fq == 0) *rp = s;
#endif
        }
    }
};
template <int MODE  > struct EpiBf {
    static constexpr bool PERM = true, AFTER_DRAIN = false; bf16* O; int ldo; const bf16* S1; int lds1; const float* rsq; const float* bias; int ldb;
    __device__ __forceinline__ void operator()(const f32x4 (&acc)[2][2][4][2], const pg8::Unit& u, int wr, int wc, int fr, int fq) const {
        const int row0 = u.pm * 256 + wr * 64 + fr, col0 = u.pn * 256 + wc * 32 + 8 * fq, b = (u.pm * 256) / SEQ;
        f32x4 bv[2][2];
        if (MODE <= 1) {
#pragma unroll
            for (int bj = 0; bj < 2; ++bj)
#pragma unroll
                for (int n = 0; n < 2; ++n) bv[bj][n] = *(const f32x4*)(bias + (size_t)b * ldb + col0 + bj * 128 + 4 * n); }
#pragma unroll
        for (int ai = 0; ai < 2; ++ai)
#pragma unroll
            for (int m = 0; m < 4; ++m) { const size_t r = (size_t)(row0 + ai * 128 + m * 16); float rstd = 1.f; if (MODE <= 1) rstd = row_rstd(rsq, r);
#pragma unroll
                for (int bj = 0; bj < 2; ++bj) { float v[8];
#pragma unroll
                    for (int n = 0; n < 2; ++n)
#pragma unroll
                        for (int e = 0; e < 4; ++e) v[4 * n + e] = MODE <= 1 ? acc[ai][bj][m][n][e] * rstd + bv[bj][n][e] : acc[ai][bj][m][n][e];
                    bf16* op = O + r * ldo + col0 + bj * 128;
                    if (MODE == 1) {
#pragma unroll
                        for (int e = 0; e < 8; ++e) v[e] = sigmoidf_(v[e]); }
                    if (MODE >= 2) { const u32x4 s = *(const u32x4*)(S1 + r * lds1 + col0 + bj * 128);
#pragma unroll
                        for (int e = 0; e < 4; ++e) { v[2 * e] *= bf2f((bf16)(s[e] & 0xffffu)); v[2 * e + 1] *= bf2f((bf16)(s[e] >> 16)); } }
                    if (MODE == 3) { const u32x4 o = *(const u32x4*)op;
#pragma unroll
                        for (int e = 0; e < 4; ++e) { v[2 * e] += bf2f((bf16)(o[e] & 0xffffu)); v[2 * e + 1] += bf2f((bf16)(o[e] >> 16)); } }
                    u32x4 w; w.x = pk2(v[0], v[1]); w.y = pk2(v[2], v[3]); w.z = pk2(v[4], v[5]); w.w = pk2(v[6], v[7]);
                    *(u32x4*)op = w; }
                if (MODE >= 2) EMU_FENCE(); }
    }
};

constexpr int RP = 72, RBUF = 64 * RP * 2;
constexpr int L4_AT = 0, L4_RT = RBUF, L4_BT = 2 * RBUF, L4_KT = 3 * RBUF, L4_KH = 4 * RBUF, L4_AC = 5 * RBUF, L4_BC = 6 * RBUF, L4_VC = 7 * RBUF;
constexpr int L4_NM = 8 * RBUF, L4_PT = 9 * RBUF, L4_MF = 10 * RBUF  , L4_TOT = L4_MF + 64 * 68 * 4  , L4_GCX = L4_TOT + 2048  , L4_XS = L4_GCX + 256  ;
constexpr int L4_WR = 8 * RBUF  , L4_AP = L4_WR + 64 * 65 * 4, L4_LORA = L4_AT;
constexpr int L4_TT = L4_AT, L4_WM = L4_BT, L4_NTM = L4_KT, L4_HT = L4_NM, L4_FT = L4_AC;
constexpr int L4_TL = L4_BT;
static_assert(L4_AP + 64 * 65 * 4 <= L4_TOT && L4_XS + 3 * 16 * 17 * 4 <= MISC_OFF - 256 && 64 * 68 * 4 <= 2 * RBUF, "RWKV LDS map");

__device__ __forceinline__ bf16x8 ldfrag(const LAS unsigned char* base, int off, int row, int col) { return *(const LAS bf16x8*)(base + off + (row * RP + col) * 2); }
__device__ __forceinline__ void st4bf(LAS unsigned char* base, int off, int row, int col, f32x4 v) { u32x2 o; o.x = pk2(v[0], v[1]); o.y = pk2(v[2], v[3]); *(LAS u32x2*)(base + off + (row * RP + col) * 2) = o; }
__device__ __forceinline__ void st4bf_g(bf16* p, f32x4 v) { u32x2 o; o.x = pk2(v[0], v[1]); o.y = pk2(v[2], v[3]); *(u32x2*)p = o; }
__device__ __forceinline__ f32x4 ld4bf_g(const bf16* p) { const u32x2 o = *(const u32x2*)p; return (f32x4){bf2f((bf16)(o.x & 0xffffu)), bf2f((bf16)(o.x >> 16)), bf2f((bf16)(o.y & 0xffffu)), bf2f((bf16)(o.y >> 16))}; }

struct PrepRaw { bf16 x[4][9]; float mu[4]; float prm[5]; bf16x8 bw[2], ba[2]; };
__device__ __forceinline__ void rwkv_prep_fetch(const Frame& F, int l, int item, PrepRaw& R) {
    const int c = item % NC1, bh = item / NC1, h = bh % RH, b = bh / RH;
    const int lane = F.lane, w = F.wave, l15 = lane & 15, q = lane >> 4, cb0 = 2 * (w & 1), t0 = 8 * w, ch = h * 64 + lane;
    const size_t m0 = (size_t)b * SEQ + (size_t)c * 64;
    const bf16* P = wsp<bf16>(F, WS_R);
    if (c * 64 + t0 > 0) { const bf16* row = P + (m0 + t0 - 1) * PW; R.x[0][0] = row[PC_R + ch]; R.x[1][0] = row[PC_K + ch]; R.x[2][0] = row[PC_V + ch]; R.x[3][0] = row[PC_LORA + lane]; }
    else { R.x[0][0] = 0; R.x[1][0] = 0; R.x[2][0] = 0; R.x[3][0] = 0; }
#pragma unroll
    for (int i = 0; i < 8; ++i) { const bf16* row = P + (m0 + t0 + i) * PW; R.x[0][1 + i] = row[PC_R + ch]; R.x[1][1 + i] = row[PC_K + ch]; R.x[2][1 + i] = row[PC_V + ch]; R.x[3][1 + i] = row[PC_LORA + lane]; }
    const float* mu = inp(F, 8) + (size_t)l * RCOLS;
    R.mu[0] = mu[PC_R + ch]; R.mu[1] = mu[PC_K + ch]; R.mu[2] = mu[PC_V + ch]; R.mu[3] = mu[PC_LORA + lane];
    R.prm[0] = inp(F, 9)[(size_t)l * RW + ch]; R.prm[1] = inp(F, 11)[(size_t)l * RW + ch]; R.prm[2] = inp(F, 14)[(size_t)l * RW + ch]; R.prm[3] = inp(F, 15)[(size_t)l * RW + ch]; R.prm[4] = inp(F, 16)[(size_t)l * RW + ch];
    const bf16* sm = (const bf16*)(wlayer(F, l) + W_SMALL);
#pragma unroll
    for (int cbi = 0; cbi < 2; ++cbi) { const int kc = 16 * (cb0 + cbi) + l15;
        R.bw[cbi] = *(const bf16x8*)(sm + W_SMALL_WUP / 2 + (size_t)(h * 64 + kc) * 32 + 8 * q); R.ba[cbi] = *(const bf16x8*)(sm + W_SMALL_AUP / 2 + (size_t)(h * 64 + kc) * 32 + 8 * q); }
}
__device__ __forceinline__ void rwkv_prep_item(Frame& F0, int l, int item, PrepRaw& raw, int next_item) {
    Frame F = relaunder(F0);
    const int c = item % NC1, bh = item / NC1, h = bh % RH, b = bh / RH;
    const int lane = F.lane, w = F.wave, l15 = lane & 15, q = lane >> 4, rb = w >> 1, cb0 = 2 * (w & 1), t0 = 8 * w;
    const size_t m0 = (size_t)b * SEQ + (size_t)c * 64;
    LAS unsigned char* L = F.lds;
    const f32x4 z4 = (f32x4){0.f, 0.f, 0.f, 0.f};
    LAUNDER_S(L);
    PSEC_B(21)
    float rs[8], ks[8], vs[8];
#pragma unroll
    for (int i = 0; i < 8; ++i) {
        const float xr = bf2f(raw.x[0][1 + i]), xk = bf2f(raw.x[1][1 + i]), xv = bf2f(raw.x[2][1 + i]), xl = bf2f(raw.x[3][1 + i]);
        rs[i] = xr + (bf2f(raw.x[0][i]) - xr) * raw.mu[0]; ks[i] = xk + (bf2f(raw.x[1][i]) - xk) * raw.mu[1]; vs[i] = xv + (bf2f(raw.x[2][i]) - xv) * raw.mu[2];
        const float ls = xl + (bf2f(raw.x[3][i]) - xl) * raw.mu[3];
        *ldsp<bf16>(L, L4_LORA + ((t0 + i) * RP + lane) * 2) = (bf16)f2bf(lane < 32 ? tanhf_(ls) : ls); }
    const float w0 = raw.prm[0], a0 = raw.prm[1], kkw = raw.prm[2], kaw = raw.prm[3], rkw = raw.prm[4];
    const bf16x8 bw0 = raw.bw[0], bw1 = raw.bw[1], ba0 = raw.ba[0], ba1 = raw.ba[1];
    if (next_item >= 0) rwkv_prep_fetch(F, l, next_item, raw);
    lds_barrier();
    LAUNDER_S(L);
    PSEC_E(F, 21)
    PSEC_B(22)
    {
        const bf16x8 aw = ldfrag(L, L4_LORA, 16 * rb + l15, 8 * q), aa = ldfrag(L, L4_LORA, 16 * rb + l15, 32 + 8 * q);
#pragma unroll
        for (int cbi = 0; cbi < 2; ++cbi) { const int kc = 16 * (cb0 + cbi) + l15;
            const f32x4 cw = mfma16(aw, cbi ? bw1 : bw0, z4), ca = mfma16(aa, cbi ? ba1 : ba0, z4);
#pragma unroll
            for (int r = 0; r < 4; ++r) { *ldsp<float>(L, L4_WR + ((16 * rb + 4 * q + r) * 65 + kc) * 4) = cw[r]; *ldsp<float>(L, L4_AP + ((16 * rb + 4 * q + r) * 65 + kc) * 4) = ca[r]; } }
    }
    lds_barrier();
    LAUNDER_S(L);
    PSEC_E(F, 22)
    PSEC_B(23)
    float ar[8], br[8], k2[8], ld[8], gin[8];
    {
        float cs = 0.f;
#pragma unroll
        for (int i = 0; i < 8; ++i) { const int t = t0 + i;
            const float wraw = w0 + *ldsp<float>(L, L4_WR + (t * 65 + lane) * 4);
            const float wl = -softplusf_(-wraw) - 0.5f; ld[i] = -fexp(wl);
            const float a = sigmoidf_(a0 + *ldsp<float>(L, L4_AP + (t * 65 + lane) * 4));
            float kk = ks[i] * kkw; const float nrm = fsqrt(wave_sum(kk * kk)); kk = kk * frcp(fmaxf(nrm, 1e-12f));
            k2[i] = ks[i] * (1.0f + (a - 1.0f) * kaw);
            const float rho = wave_sum(rs[i] * k2[i] * rkw);
            if (lane == 0) wsp<float>(F, WS_F + F_RHO)[(m0 + t) * 8 + h] = rho;
            ar[i] = -kk; br[i] = kk * a; cs += ld[i]; gin[i] = cs; }
        *ldsp<float>(L, L4_TOT + (w * 64 + lane) * 4) = cs;
    }
    lds_barrier();
    LAUNDER_S(L);
    PSEC_E(F, 23)
    PSEC_B(24)
    {
        float pre = 0.f, gC = 0.f;
#pragma unroll
        for (int ww = 0; ww < 8; ++ww) { const float tv = *ldsp<float>(L, L4_TOT + (ww * 64 + lane) * 4); gC += tv; if (ww < w) pre += tv; }
        if (w == 0) *ldsp<float>(L, L4_GCX + lane * 4) = fexp(gC);
        float acv[8], bcv[8];
#pragma unroll
        for (int i = 0; i < 8; ++i) { const int t = t0 + i; const float gi = pre + gin[i], ge = gi - ld[i];
            const float e_gi = fexp(gi), e_ngi = fexp(-gi), e_ge = fexp(ge), e_c = fexp(gC - gi);
            const float at = ar[i] * e_ge; acv[i] = at; bcv[i] = br[i] * e_c;
            *ldsp<bf16>(L, L4_AT + (t * RP + lane) * 2) = (bf16)f2bf(at);
            *ldsp<bf16>(L, L4_RT + (t * RP + lane) * 2) = (bf16)f2bf(rs[i] * e_gi);
            *ldsp<bf16>(L, L4_BT + (t * RP + lane) * 2) = (bf16)f2bf(br[i] * e_ngi);
            *ldsp<bf16>(L, L4_KT + (t * RP + lane) * 2) = (bf16)f2bf(k2[i] * e_ngi);
            *ldsp<bf16>(L, L4_KH + (t * RP + lane) * 2) = (bf16)f2bf(k2[i] * e_c); }
        u32x4 o;
        o.x = pk2(acv[0], acv[1]); o.y = pk2(acv[2], acv[3]); o.z = pk2(acv[4], acv[5]); o.w = pk2(acv[6], acv[7]); *ldsp<u32x4>(L, L4_AC + (lane * RP + t0) * 2) = o;
        o.x = pk2(bcv[0], bcv[1]); o.y = pk2(bcv[2], bcv[3]); o.z = pk2(bcv[4], bcv[5]); o.w = pk2(bcv[6], bcv[7]); *ldsp<u32x4>(L, L4_BC + (lane * RP + t0) * 2) = o;
        o.x = pk2(vs[0], vs[1]); o.y = pk2(vs[2], vs[3]); o.z = pk2(vs[4], vs[5]); o.w = pk2(vs[6], vs[7]); *ldsp<u32x4>(L, L4_VC + (lane * RP + t0) * 2) = o;
    }
    lds_barrier();
    LAUNDER_S(L);
    PSEC_E(F, 24)
    PSEC_B(25)
    f32x4 qreg[2];
    {
        bf16x8 aA[2], aB[2], aK[2];
#pragma unroll
        for (int s = 0; s < 2; ++s) { aA[s] = ldfrag(L, L4_AT, 16 * rb + l15, 32 * s + 8 * q); aB[s] = ldfrag(L, L4_BT, 16 * rb + l15, 32 * s + 8 * q); aK[s] = ldfrag(L, L4_KT, 16 * rb + l15, 32 * s + 8 * q); }
#pragma unroll
        for (int cbi = 0; cbi < 2; ++cbi) { const int cb = cb0 + cbi, cc = 16 * cb + l15, r0 = 16 * rb + 4 * q;
            f32x4 cm = z4, cn = z4, cp = z4, cq = z4;
#pragma unroll
            for (int s = 0; s < 2; ++s) { const bf16x8 bB = ldfrag(L, L4_BT, cc, 32 * s + 8 * q), bK = ldfrag(L, L4_KT, cc, 32 * s + 8 * q), bR = ldfrag(L, L4_RT, cc, 32 * s + 8 * q);
                cm = mfma16(aA[s], bB, cm); cn = mfma16(aA[s], bK, cn); cp = mfma16(aB[s], bR, cp); cq = mfma16(aK[s], bR, cq); }
#pragma unroll
            for (int r = 0; r < 4; ++r) { const int rr = r0 + r;
                if (!(cc < rr)) { cm[r] = 0.f; cn[r] = 0.f; }
                if (!(rr <= cc)) { cp[r] = 0.f; cq[r] = 0.f; } }
            *ldsp<f32x4>(L, L4_MF + (cc * 68 + r0) * 4) = cm;
            st4bf(L, L4_NM, cc, r0, cn);
            st4bf(L, L4_PT, cc, r0, cp);
            qreg[cbi] = cq; }
    }
    lds_barrier();
    LAUNDER_S(L);
    PSEC_E(F, 25)
    PSEC_B(26)
    if (w == 0) {
        int lnq = lane; LAUNDER(lnq);
        const int I16 = 16 * (lnq >> 4), tt = lnq & 15;
        float acc[16];
#pragma unroll
        for (int r = 0; r < 16; ++r) acc[r] = (r == tt) ? 1.0f : 0.0f;
#pragma unroll
        for (int r = 14; r >= 0; --r) {
#pragma unroll
            for (int g = (r + 1) >> 2; g < 4; ++g) { const f32x4 m4 = *ldsp<f32x4>(L, L4_MF + ((I16 + r) * 68 + I16 + 4 * g) * 4);
#pragma unroll
                for (int e = 0; e < 4; ++e) if (4 * g + e > r) acc[r] += m4[e] * acc[4 * g + e]; } }
#pragma unroll
        for (int r = 0; r < 16; ++r) *ldsp<float>(L, L4_TL + ((I16 + r) * 68 + I16 + tt) * 4) = acc[r];
    }
    lds_barrier();
    LAUNDER_S(L);
#pragma unroll
    for (int dd = 1; dd < 4; ++dd) {
        if (w < 4 - dd) { const int I16 = 16 * w, J16 = 16 * (w + dd);
            f32x4 x = z4;
            for (int K16 = I16; K16 < J16; K16 += 16) {
#pragma unroll
                for (int s = 0; s < 4; ++s) x = mfma4f(*ldsp<float>(L, L4_TL + ((I16 + l15) * 68 + K16 + 4 * s + q) * 4), *ldsp<float>(L, L4_MF + ((K16 + 4 * s + q) * 68 + J16 + l15) * 4), x); }
#pragma unroll
            for (int r = 0; r < 4; ++r) *ldsp<float>(L, L4_XS + (w * 272 + (4 * q + r) * 17 + l15) * 4) = x[r];
            WAVE_LDS_FENCE();
            f32x4 y = z4;
#pragma unroll
            for (int s = 0; s < 4; ++s) y = mfma4f(*ldsp<float>(L, L4_XS + (w * 272 + l15 * 17 + 4 * s + q) * 4), *ldsp<float>(L, L4_TL + ((J16 + 4 * s + q) * 68 + J16 + l15) * 4), y);
#pragma unroll
            for (int r = 0; r < 4; ++r) *ldsp<float>(L, L4_TL + ((I16 + 4 * q + r) * 68 + J16 + l15) * 4) = y[r];
        }
        lds_barrier();
    }
    {
        const int t = F.tid >> 3, g = F.tid & 7; float tv[8];
#pragma unroll
        for (int e = 0; e < 8; ++e) { const int j = 8 * g + e; tv[e] = (j >> 4) <= (t >> 4) ? *ldsp<float>(L, L4_TL + (j * 68 + t) * 4) : 0.0f; }
        u32x4 o; o.x = pk2(tv[0], tv[1]); o.y = pk2(tv[2], tv[3]); o.z = pk2(tv[4], tv[5]); o.w = pk2(tv[6], tv[7]);
        *ldsp<u32x4>(L, L4_TT + (t * RP + 8 * g) * 2) = o;
    }
    lds_barrier();
    LAUNDER_S(L);
    PSEC_E(F, 26)
    PSEC_B(27)
    {
        bf16x8 aT[2];
#pragma unroll
        for (int s = 0; s < 2; ++s) aT[s] = ldfrag(L, L4_TT, 16 * rb + l15, 32 * s + 8 * q);
#pragma unroll
        for (int cbi = 0; cbi < 2; ++cbi) { const int cc = 16 * (cb0 + cbi) + l15, r0 = 16 * rb + 4 * q; f32x4 cw = z4, cn = z4;
#pragma unroll
            for (int s = 0; s < 2; ++s) { cw = mfma16(aT[s], ldfrag(L, L4_AC, cc, 32 * s + 8 * q), cw); cn = mfma16(aT[s], ldfrag(L, L4_NM, cc, 32 * s + 8 * q), cn); }
            st4bf(L, L4_WM, cc, r0, cw); st4bf(L, L4_NTM, cc, r0, cn); }
    }
    lds_barrier();
    LAUNDER_S(L);
    PSEC_E(F, 27)
    PSEC_B(28)
    const size_t slot = (size_t)c * (NB * RH) + bh;
    bf16* GT = wsp<bf16>(F, WS_F + F_GV + slot * 16384); bf16* VH = GT + 4096;
    bf16* ET = wsp<bf16>(F, WS_F + F_EV + slot * 16384); bf16* VFT = ET + 4096;
    {
        bf16x8 aW[2], aN[2];
#pragma unroll
        for (int s = 0; s < 2; ++s) { aW[s] = ldfrag(L, L4_WM, 16 * rb + l15, 32 * s + 8 * q); aN[s] = ldfrag(L, L4_NTM, 16 * rb + l15, 32 * s + 8 * q); }
#pragma unroll
        for (int cbi = 0; cbi < 2; ++cbi) { const int cc = 16 * (cb0 + cbi) + l15, r0 = 16 * rb + 4 * q; f32x4 cg = z4, ce = z4, chh = z4, cf = qreg[cbi];
#pragma unroll
            for (int s = 0; s < 2; ++s) { const bf16x8 bB = ldfrag(L, L4_BC, cc, 32 * s + 8 * q), bP = ldfrag(L, L4_PT, cc, 32 * s + 8 * q);
                cg = mfma16(aW[s], bB, cg); ce = mfma16(aW[s], bP, ce); chh = mfma16(aN[s], bB, chh); cf = mfma16(aN[s], bP, cf); }
#pragma unroll
            for (int r = 0; r < 4; ++r) { if (r0 + r == cc) cg[r] += *ldsp<float>(L, L4_GCX + cc * 4);
                chh[r] += bf2f(*ldsp<bf16>(L, L4_KH + ((r0 + r) * RP + cc) * 2)); }
            const u32x2 rt = *ldsp<u32x2>(L, L4_RT + (cc * RP + r0) * 2);
            ce[0] += bf2f((bf16)(rt.x & 0xffffu)); ce[1] += bf2f((bf16)(rt.x >> 16)); ce[2] += bf2f((bf16)(rt.y & 0xffffu)); ce[3] += bf2f((bf16)(rt.y >> 16));
            st4bf_g(GT + cc * 64 + 32 * (rb >> 1) + 8 * q + 4 * (rb & 1), cg);
            st4bf_g(ET + cc * 64 + r0, ce);
            st4bf(L, L4_HT, cc, r0, chh);
            st4bf(L, L4_FT, cc, r0, cf); }
    }
    lds_barrier();
    LAUNDER_S(L);
    PSEC_E(F, 28)
    PSEC_B(29)
    {
#pragma unroll
        for (int cbi = 0; cbi < 2; ++cbi) { const int cc = 16 * (cb0 + cbi) + l15, r0 = 16 * rb + 4 * q; f32x4 c1 = z4, c2 = z4;
#pragma unroll
            for (int s = 0; s < 2; ++s) { c1 = mfma16(ldfrag(L, L4_HT, 16 * rb + l15, 32 * s + 8 * q), ldfrag(L, L4_VC, cc, 32 * s + 8 * q), c1);
                c2 = mfma16(ldfrag(L, L4_VC, 16 * rb + l15, 32 * s + 8 * q), ldfrag(L, L4_FT, cc, 32 * s + 8 * q), c2); }
            st4bf_g(VH + cc * 64 + r0, c1); st4bf_g(VFT + cc * 64 + r0, c2); }
    }
    lds_barrier();
    PSEC_E(F, 29)
}

constexpr int L5_G = 0, L5_GBUF = 65536, SCG = 8;
static_assert(NC1 % SCG == 0, "scan groups of eight chunks");
__device__ __forceinline__ void scan_fetch_group(const Frame& F, const bf16* gbase  , size_t CS, int buf, u32x2 (&vhN)[SCG][4], int offV, bool consumer) {
    const int lane = F.lane, w = F.wave;
#pragma unroll
    for (int i = 0; i < SCG; ++i) {
        const int g = 64 * w + lane, r = g >> 3, c16 = (g & 7) ^ (r & 7);
        glds16((const char*)(gbase + (size_t)i * CS) + r * 128 + c16 * 16, F.lds + L5_G + buf * L5_GBUF + i * 8192 + w * 1024); }
    if (consumer) {
#pragma unroll
        for (int i = 0; i < SCG; ++i) { const char* gV = (const char*)(gbase + (size_t)i * CS) + 8192 + offV;
#pragma unroll
            for (int mt = 0; mt < 4; ++mt) vhN[i][mt] = *(const u32x2*)(gV + mt * 32); } }
}
__device__ __forceinline__ void scan_step(const Frame& F, int buf, int i, const u32x2 (&vh)[4], bf16* it, f32x4 (&st)[4], int offV, int l15, int q) {
    u32x4 b0, b1;
    b0.x = pk2(st[0][0], st[0][1]); b0.y = pk2(st[0][2], st[0][3]); b0.z = pk2(st[1][0], st[1][1]); b0.w = pk2(st[1][2], st[1][3]);
    b1.x = pk2(st[2][0], st[2][1]); b1.y = pk2(st[2][2], st[2][3]); b1.z = pk2(st[3][0], st[3][1]); b1.w = pk2(st[3][2], st[3][3]);
    char* sp = (char*)it + 8192 + offV;
    *(u32x2*)(sp) = (u32x2){b0.x, b0.y}; *(u32x2*)(sp + 32) = (u32x2){b0.z, b0.w}; *(u32x2*)(sp + 64) = (u32x2){b1.x, b1.y}; *(u32x2*)(sp + 96) = (u32x2){b1.z, b1.w};
    const bf16x8 f0 = __builtin_bit_cast(bf16x8, b0), f1 = __builtin_bit_cast(bf16x8, b1);
    const LAS unsigned char* G = F.lds + L5_G + buf * L5_GBUF + i * 8192;
#pragma unroll
    for (int mt = 0; mt < 4; ++mt) { const int r = 16 * mt + l15;
        f32x4 acc = (f32x4){bf2f((bf16)(vh[mt].x & 0xffffu)), bf2f((bf16)(vh[mt].x >> 16)), bf2f((bf16)(vh[mt].y & 0xffffu)), bf2f((bf16)(vh[mt].y >> 16))};
        acc = mfma16(*(const LAS bf16x8*)(G + (r * 8 + ((q) ^ (r & 7))) * 16), f0, acc);
        acc = mfma16(*(const LAS bf16x8*)(G + (r * 8 + ((4 + q) ^ (r & 7))) * 16), f1, acc);
        st[mt] = acc; }
}
__device__ __forceinline__ void rwkv_scan_bh(Frame& F0, int bh) {
    Frame F = relaunder(F0);
    const int lane = F.lane, vb = F.wave, l15 = lane & 15, q = lane >> 4;
    const bool consumer = vb < 4;
    const f32x4 z4 = (f32x4){0.f, 0.f, 0.f, 0.f};
    f32x4 st[4] = {z4, z4, z4, z4};
    bf16* base = wsp<bf16>(F, WS_F + F_GV + (size_t)bh * 16384); constexpr size_t CS = (size_t)NB * RH * 8192;
    int offV = ((16 * (vb & 3) + l15) * 64 + 4 * q) * 2;
    u32x2 vh[SCG][4], vhN[SCG][4];
#pragma unroll
    for (int i = 0; i < SCG; ++i)
#pragma unroll
        for (int mt = 0; mt < 4; ++mt) vhN[i][mt] = (u32x2){0u, 0u};
    scan_fetch_group(F, base, CS, 0, vhN, offV, consumer);
    vm_lds_barrier();
    for (int g = 0; g < NC1 / SCG; ++g) {
        LAUNDER(offV);
        bf16* gb = base + (size_t)g * SCG * CS;
#pragma unroll
        for (int i = 0; i < SCG; ++i)
#pragma unroll
            for (int mt = 0; mt < 4; ++mt) vh[i][mt] = vhN[i][mt];
        if (g + 1 < NC1 / SCG) scan_fetch_group(F, gb + (size_t)SCG * CS, CS, (g + 1) & 1, vhN, offV, consumer);
        if (consumer) {
#pragma unroll
            for (int i = 0; i < SCG; ++i) scan_step(F, g & 1, i, vh[i], gb + (size_t)i * CS, st, offV, l15, q); }
        vm_lds_barrier();
    }
}

constexpr int L6_SG = 0  , L6_YL = 64 * 104 * 2  , L6_GL = L6_YL + 64 * 68 * 4;
struct OutRaw { bf16 v[9], g0[9], g1[9]; float mu[3], ln[2], rho[8]; bf16x8 aS[2], aG[3], bE[2][2]; u32x2 vf[2]; };
__device__ __forceinline__ void rwkv_out_fetch(const Frame& F, int l, int item, OutRaw& R) {
    const int c = item % NC1, bh = item / NC1, h = bh % RH, b = bh / RH;
    const int lane = F.lane, w = F.wave, l15 = lane & 15, q = lane >> 4, rb = w >> 1, cb0 = 2 * (w & 1), t0 = 8 * w, ch = h * 64 + lane;
    const size_t m0 = (size_t)b * SEQ + (size_t)c * 64;
    const bf16* P = wsp<bf16>(F, WS_R);
    R.v[0] = 0; R.g0[0] = 0; R.g1[0] = 0;
    if (c * 64 + t0 > 0) { const bf16* row = P + (m0 + t0 - 1) * PW; R.v[0] = row[PC_V + ch]; R.g0[0] = row[PC_GLO + lane]; if (lane < 32) R.g1[0] = row[PC_GLO + 64 + lane]; }
#pragma unroll
    for (int i = 0; i < 8; ++i) { const bf16* row = P + (m0 + t0 + i) * PW; R.v[1 + i] = row[PC_V + ch]; R.g0[1 + i] = row[PC_GLO + lane]; R.g1[1 + i] = 0; if (lane < 32) R.g1[1 + i] = row[PC_GLO + 64 + lane]; }
    const float* mu = inp(F, 8) + (size_t)l * RCOLS;
    R.mu[0] = mu[PC_V + ch]; R.mu[1] = mu[PC_GLO + lane]; R.mu[2] = lane < 32 ? mu[PC_GLO + 64 + lane] : 0.f;
    R.ln[0] = inp(F, 17)[(size_t)l * RW + ch]; R.ln[1] = inp(F, 18)[(size_t)l * RW + ch];
#pragma unroll
    for (int i = 0; i < 8; ++i) R.rho[i] = wsp<float>(F, WS_F + F_RHO)[(m0 + t0 + i) * 8 + h];
    const size_t slot = (size_t)c * (NB * RH) + bh;
    const bf16* Sc = wsp<bf16>(F, WS_F + F_GV + slot * 16384) + 4096;
    const bf16* ET = wsp<bf16>(F, WS_F + F_EV + slot * 16384); const bf16* VFT = ET + 4096;
    const bf16* gup = (const bf16*)(wlayer(F, l) + W_SMALL + W_SMALL_GUP) + (size_t)(h * 64) * 96;
#pragma unroll
    for (int s = 0; s < 2; ++s) R.aS[s] = *(const bf16x8*)(Sc + (16 * rb + l15) * 64 + 32 * s + 8 * q);
#pragma unroll
    for (int s = 0; s < 3; ++s) R.aG[s] = *(const bf16x8*)(gup + (16 * rb + l15) * 96 + 32 * s + 8 * q);
#pragma unroll
    for (int cbi = 0; cbi < 2; ++cbi) { const int tt = 16 * (cb0 + cbi) + l15;
#pragma unroll
        for (int s = 0; s < 2; ++s) R.bE[cbi][s] = *(const bf16x8*)(ET + tt * 64 + 32 * s + 8 * q);
        R.vf[cbi] = *(const u32x2*)(VFT + tt * 64 + 16 * rb + 4 * q); }
}
__device__ __forceinline__ void rwkv_out_item(Frame& F0, int l, int item, OutRaw& raw, int next_item) {
    Frame F = relaunder(F0);
    const int c = item % NC1, bh = item / NC1, h = bh % RH, b = bh / RH;
    const int lane = F.lane, w = F.wave, l15 = lane & 15, q = lane >> 4, rb = w >> 1, cb0 = 2 * (w & 1), t0 = 8 * w;
    const size_t m0 = (size_t)b * SEQ + (size_t)c * 64;
    bf16* P = wsp<bf16>(F, WS_R);
    LAS unsigned char* L = F.lds;
    const int ch = h * 64 + lane;
    LAUNDER_S(L);
    float vs[8];
#pragma unroll
    for (int i = 0; i < 8; ++i) { const float xv = bf2f(raw.v[1 + i]), x0 = bf2f(raw.g0[1 + i]), x1 = bf2f(raw.g1[1 + i]);
        vs[i] = xv + (bf2f(raw.v[i]) - xv) * raw.mu[0];
        *ldsp<bf16>(L, L6_SG + ((t0 + i) * 104 + lane) * 2) = (bf16)f2bf(sigmoidf_(x0 + (bf2f(raw.g0[i]) - x0) * raw.mu[1]));
        if (lane < 32) *ldsp<bf16>(L, L6_SG + ((t0 + i) * 104 + 64 + lane) * 2) = (bf16)f2bf(sigmoidf_(x1 + (bf2f(raw.g1[i]) - x1) * raw.mu[2])); }
    const float lng = raw.ln[0], lnb = raw.ln[1];
    float rho[8];
#pragma unroll
    for (int i = 0; i < 8; ++i) rho[i] = raw.rho[i];
    const bf16x8 aS0 = raw.aS[0], aS1 = raw.aS[1], aG0 = raw.aG[0], aG1 = raw.aG[1], aG2 = raw.aG[2], bE00 = raw.bE[0][0], bE01 = raw.bE[0][1], bE10 = raw.bE[1][0], bE11 = raw.bE[1][1];
    const u32x2 vf0 = raw.vf[0], vf1 = raw.vf[1];
    if (next_item >= 0) rwkv_out_fetch(F, l, next_item, raw);
    lds_barrier();
    LAUNDER_S(L);
#pragma unroll
    for (int cbi = 0; cbi < 2; ++cbi) { const int tt = 16 * (cb0 + cbi) + l15, v0 = 16 * rb + 4 * q; const u32x2 vf = cbi ? vf1 : vf0;
        f32x4 cy = (f32x4){bf2f((bf16)(vf.x & 0xffffu)), bf2f((bf16)(vf.x >> 16)), bf2f((bf16)(vf.y & 0xffffu)), bf2f((bf16)(vf.y >> 16))}, cg = (f32x4){0.f, 0.f, 0.f, 0.f};
        cy = mfma16(aS0, cbi ? bE10 : bE00, cy); cy = mfma16(aS1, cbi ? bE11 : bE01, cy);
        cg = mfma16(aG0, *(const LAS bf16x8*)(L + L6_SG + (tt * 104 + 8 * q) * 2), cg);
        cg = mfma16(aG1, *(const LAS bf16x8*)(L + L6_SG + (tt * 104 + 32 + 8 * q) * 2), cg);
        cg = mfma16(aG2, *(const LAS bf16x8*)(L + L6_SG + (tt * 104 + 64 + 8 * q) * 2), cg);
        *ldsp<f32x4>(L, L6_YL + (tt * 68 + v0) * 4) = cy; *ldsp<f32x4>(L, L6_GL + (tt * 68 + v0) * 4) = cg; }
    lds_barrier();
    LAUNDER_S(L);
#pragma unroll
    for (int i = 0; i < 8; ++i) { const int t = t0 + i; const float y = *ldsp<float>(L, L6_YL + (t * 68 + lane) * 4);
        const float mean = wave_sum(y) * (1.0f / 64.0f), d = y - mean, var = wave_sum(d * d) * (1.0f / 64.0f);
        const float yn = d * frsq(var + 64e-5f) * lng + lnb;
        const float o = (yn + rho[i] * vs[i]) * *ldsp<float>(L, L6_GL + (t * 68 + lane) * 4);
        P[(m0 + t) * PW + ch] = (bf16)f2bf(o); }
    lds_barrier();
}

constexpr int MP = 136, MBUF = 128 * MP * 2;
constexpr int LM_A = 0, LM_B = MBUF, LM_C = 2 * MBUF, LM_D = 3 * MBUF, LM_S = 4 * MBUF;
static_assert(LM_S + 8 * 512 <= MISC_OFF - 256, "mLSTM LDS map");
__device__ __forceinline__ bf16x8 ldfragm(const LAS unsigned char* base, int off, int row, int col) { return *(const LAS bf16x8*)(base + off + (row * MP + col) * 2); }
__device__ __forceinline__ float logsigmoidf_(float x) { return -softplusf_(-x); }
__device__ __forceinline__ float wave_scan_add(float v, int lane) {
#pragma unroll
    for (int o = 1; o < 64; o <<= 1) { const float t = __shfl_up(v, o); if (lane >= o) v += t; }
    return v;
}
__device__ __forceinline__ float wave_scan_max(float v, int lane) {
#pragma unroll
    for (int o = 1; o < 64; o <<= 1) { const float t = __shfl_up(v, o); if (lane >= o) v = fmaxf(v, t); }
    return v;
}
__device__ __forceinline__ float wave_max(float v) {
#pragma unroll
    for (int o = 1; o < 64; o <<= 1) v = fmaxf(v, __shfl_xor(v, o));
    return v;
}

template <int MODE> __device__ __forceinline__ void mlstm_gates(const Frame& F, int l, int b, int h, int c, float mprev) {
    LAS unsigned char* L = F.lds; const bf16* P = wsp<bf16>(F, WS_R); const int lane = F.lane;
    const bf16* row = P + ((size_t)b * SEQ + (size_t)c * 128 + 2 * lane) * PW;
    const float bi = inp(F, 21)[l * 8 + h], bf = inp(F, 21)[l * 8 + 4 + h];
    const float i0 = bf2f(row[PC_MI + h]) + bi, i1 = bf2f(row[PW + PC_MI + h]) + bi;
    const float f0 = logsigmoidf_(bf2f(row[PC_MF + h]) + bf), f1 = logsigmoidf_(bf2f(row[PW + PC_MF + h]) + bf);
    const float p = f0 + f1, incl = wave_scan_add(p, lane), b0 = incl - p + f0, b1 = incl;
    if (MODE == 1) {
        const float bend = rdlane(incl, 63), g0 = bend - b0 + i0, g1 = bend - b1 + i1, mloc = wave_max(fmaxf(g0, g1));
        *ldsp<f32x2>(L, LM_S + 3 * 512 + lane * 8) = (f32x2){fexp(g0 - mloc), fexp(g1 - mloc)};
        if (lane == 0) *ldsp<f32x2>(L, LM_S + 7 * 512) = (f32x2){mloc, bend};
    } else {
        const float u0 = i0 - b0, u1 = i1 - b1, um = fmaxf(u0, u1), mi = wave_scan_max(um, lane);
        float ex = __shfl_up(mi, 1); if (lane == 0) ex = -INFINITY;
        const float mx0 = fmaxf(mprev, fmaxf(ex, u0)), mx1 = fmaxf(mprev, mi);
        *ldsp<f32x2>(L, LM_S + 3 * 512 + lane * 8) = (f32x2){u0, u1};
        *ldsp<f32x2>(L, LM_S + 4 * 512 + lane * 8) = (f32x2){-mx0, -mx1};
        *ldsp<f32x2>(L, LM_S + 5 * 512 + lane * 8) = (f32x2){fexp(mprev - mx0), fexp(mprev - mx1)};
        *ldsp<f32x2>(L, LM_S + 6 * 512 + lane * 8) = (f32x2){fexp(-(b0 + mx0)), fexp(-(b1 + mx1))};
    }
}
__device__ __forceinline__ void mlstm_conv_load(const Frame& F, size_t mrow0, int tseq0, int chq, bf16 (&raw)[35]) {
    const bf16* P = wsp<bf16>(F, WS_R) + PC_MQ + chq;
    if (tseq0 >= 3) { raw[0] = P[(mrow0 - 3) * PW]; raw[1] = P[(mrow0 - 2) * PW]; raw[2] = P[(mrow0 - 1) * PW]; } else { raw[0] = 0; raw[1] = 0; raw[2] = 0; }
#pragma unroll
    for (int i = 0; i < 32; ++i) raw[3 + i] = P[(mrow0 + i) * PW];
}
__device__ __forceinline__ void mlstm_conv_apply(const Frame& F, int l, int chq, const bf16 (&raw)[35], float (&out)[32]) {
    const float w0 = inp(F, 19)[(size_t)(l * 4 + 0) * 1024 + chq], w1 = inp(F, 19)[(size_t)(l * 4 + 1) * 1024 + chq], w2 = inp(F, 19)[(size_t)(l * 4 + 2) * 1024 + chq], w3 = inp(F, 19)[(size_t)(l * 4 + 3) * 1024 + chq], cb = inp(F, 20)[(size_t)l * 1024 + chq];
    float x0 = bf2f(raw[0]), x1 = bf2f(raw[1]), x2 = bf2f(raw[2]);
#pragma unroll
    for (int i = 0; i < 32; ++i) { const float x3 = bf2f(raw[3 + i]); out[i] = siluf_(w0 * x0 + w1 * x1 + w2 * x2 + w3 * x3 + cb); x0 = x1; x1 = x2; x2 = x3; }
}
__device__ __forceinline__ void mlstm_m1_item(Frame& F0, int l, int item) {
    Frame F = relaunder(F0);
    const int c = item % NC2, bh = item / NC2, h = bh % MH, b = bh / MH;
    const int lane = F.lane, w = F.wave, l15 = lane & 15, q = lane >> 4;
    LAS unsigned char* L = F.lds; const bf16* P = wsp<bf16>(F, WS_R);
    const size_t m0 = (size_t)b * SEQ + (size_t)c * 128;
    LAUNDER_S(L);
    const int d = lane + 64 * (w & 1), tg = w >> 1, tb = 32 * tg;
    bf16 kraw[35], vraw[32];
    mlstm_conv_load(F, m0 + tb, c * 128 + tb, 512 + h * 128 + d, kraw);
#pragma unroll
    for (int i = 0; i < 32; ++i) vraw[i] = P[(m0 + tb + i) * PW + PC_MV + h * 128 + d];
    if (w == 0) mlstm_gates<1>(F, l, b, h, c, 0.f);
    lds_barrier();
    LAUNDER_S(L);
    const f32x2 msc = *ldsp<f32x2>(L, LM_S + 7 * 512);
    float kc[32]; mlstm_conv_apply(F, l, 512 + h * 128 + d, kraw, kc);
    float ksum = 0.f;
#pragma unroll
    for (int i = 0; i < 32; ++i) { kc[i] *= *ldsp<float>(L, LM_S + 3 * 512 + (tb + i) * 4); ksum += kc[i]; }
    lds_barrier();
    {
#pragma unroll
        for (int g = 0; g < 4; ++g) { u32x4 o; o.x = pk2(kc[8 * g], kc[8 * g + 1]); o.y = pk2(kc[8 * g + 2], kc[8 * g + 3]); o.z = pk2(kc[8 * g + 4], kc[8 * g + 5]); o.w = pk2(kc[8 * g + 6], kc[8 * g + 7]);
            *ldsp<u32x4>(L, LM_A + (d * MP + tb + 8 * g) * 2) = o; }
        *ldsp<float>(L, LM_S + 4 * 512 + tg * 512 + d * 4) = ksum;
#pragma unroll
        for (int g = 0; g < 4; ++g) { u32x4 o; o.x = (unsigned)vraw[8 * g] | ((unsigned)vraw[8 * g + 1] << 16); o.y = (unsigned)vraw[8 * g + 2] | ((unsigned)vraw[8 * g + 3] << 16);
            o.z = (unsigned)vraw[8 * g + 4] | ((unsigned)vraw[8 * g + 5] << 16); o.w = (unsigned)vraw[8 * g + 6] | ((unsigned)vraw[8 * g + 7] << 16);
            *ldsp<u32x4>(L, LM_B + (d * MP + tb + 8 * g) * 2) = o; }
    }
    lds_barrier();
    LAUNDER_S(L);
    bf16* KVT = wsp<bf16>(F, WS_F + F_MC + (size_t)item * 65536);
    {
        f32x4 acc[8];
#pragma unroll
        for (int et = 0; et < 8; ++et) acc[et] = (f32x4){0.f, 0.f, 0.f, 0.f};
#pragma unroll
        for (int s = 0; s < 4; ++s) { const bf16x8 a = ldfragm(L, LM_A, 16 * w + l15, 32 * s + 8 * q);
#pragma unroll
            for (int et = 0; et < 8; ++et) acc[et] = mfma16(a, ldfragm(L, LM_B, 16 * et + l15, 32 * s + 8 * q), acc[et]); }
#pragma unroll
        for (int et = 0; et < 8; ++et) st4bf_g(KVT + (size_t)(16 * et + l15) * 128 + 16 * w + 4 * q, acc[et]);
    }
    if (F.tid < 128) { float s = 0.f;
#pragma unroll
        for (int g = 0; g < 4; ++g) s += *ldsp<float>(L, LM_S + 4 * 512 + g * 512 + F.tid * 4);
        wsp<float>(F, WS_F + F_KS)[(size_t)item * 128 + F.tid] = s; }
    if (F.tid == 0) { float* mscg = wsp<float>(F, WS_F + F_MSC) + (size_t)item * 4; mscg[0] = msc[0]; mscg[1] = msc[1]; }
    lds_barrier();
}
__device__ __forceinline__ void mlstm_m2(Frame& F0, int first_wg) {
    Frame F = relaunder(F0);
    const int nW = F.G - first_wg; if (F.bid < first_wg || nW <= 0) return;
    const int per = 4096 + 32;
    for (int idx = (F.bid - first_wg) * 512 + F.tid; idx < NB * MH * per; idx += nW * 512) {
        const int bh = idx / per, e4 = idx % per;
        float* msc = wsp<float>(F, WS_F + F_MSC) + (size_t)bh * NC2 * 4;
        f32x2 sc[NC2];
#pragma unroll
        for (int c = 0; c < NC2; ++c) sc[c] = *(const f32x2*)(msc + c * 4);
        float m = -INFINITY; f32x4 st = (f32x4){0.f, 0.f, 0.f, 0.f};
        if (e4 < 4096) {
            bf16* p = wsp<bf16>(F, WS_F + F_MC + (size_t)bh * NC2 * 65536) + 4 * e4;
            u32x2 kvr[NC2];
#pragma unroll
            for (int c = 0; c < NC2; ++c) kvr[c] = *(const u32x2*)(p + (size_t)c * 32768);
#pragma unroll
            for (int c = 0; c < NC2; ++c) { const f32x4 kv = (f32x4){bf2f((bf16)(kvr[c].x & 0xffffu)), bf2f((bf16)(kvr[c].x >> 16)), bf2f((bf16)(kvr[c].y & 0xffffu)), bf2f((bf16)(kvr[c].y >> 16))};
                st4bf_g(p + (size_t)c * 32768 + 16384, st);
                if (e4 == 0) msc[c * 4 + 2] = m;
                const float mn = fmaxf(sc[c][1] + m, sc[c][0]), keep = fexp(sc[c][1] + m - mn), w2 = fexp(sc[c][0] - mn);
                st = st * keep + kv * w2; m = mn; }
        } else {
            f32x4* p = (f32x4*)(wsp<float>(F, WS_F + F_KS) + (size_t)bh * NC2 * 128) + (e4 - 4096);
            constexpr int HB = NC2 < 16 ? NC2 : 16;
#pragma unroll
            for (int c0 = 0; c0 < NC2; c0 += HB) { f32x4 kvr[HB];
#pragma unroll
                for (int c = 0; c < HB; ++c) kvr[c] = p[(c0 + c) * 32];
#pragma unroll
                for (int c = 0; c < HB; ++c) { p[(c0 + c) * 32] = st;
                    const float mn = fmaxf(sc[c0 + c][1] + m, sc[c0 + c][0]), keep = fexp(sc[c0 + c][1] + m - mn), w2 = fexp(sc[c0 + c][0] - mn);
                    st = st * keep + kvr[c] * w2; m = mn; } }
        }
    }
}
__device__ __forceinline__ void mlstm_m3_item(Frame& F0, int l, int item) {
    Frame F = relaunder(F0);
    const int c = item % NC2, bh = item / NC2, h = bh % MH, b = bh / MH;
    const int lane = F.lane, w = F.wave, l15 = lane & 15, q = lane >> 4;
    LAS unsigned char* L = F.lds; bf16* P = wsp<bf16>(F, WS_R);
    const size_t m0 = (size_t)b * SEQ + (size_t)c * 128;
    LAUNDER_S(L);
    const int d = lane + 64 * (w & 1), tg = w >> 1, tb = 32 * tg;
    bf16 qraw[35], kraw[35], vraw[32];
    mlstm_conv_load(F, m0 + tb, c * 128 + tb, h * 128 + d, qraw);
    mlstm_conv_load(F, m0 + tb, c * 128 + tb, 512 + h * 128 + d, kraw);
#pragma unroll
    for (int i = 0; i < 32; ++i) vraw[i] = P[(m0 + tb + i) * PW + PC_MV + h * 128 + d];
    if (w == 0) mlstm_gates<3>(F, l, b, h, c, wsp<float>(F, WS_F + F_MSC)[(size_t)item * 4 + 2]);
    {
        float cv[32];
        mlstm_conv_apply(F, l, h * 128 + d, qraw, cv);
#pragma unroll
        for (int i = 0; i < 32; ++i) *ldsp<bf16>(L, LM_A + ((tb + i) * MP + d) * 2) = (bf16)f2bf(cv[i] * 0.08838834764831845f);
        mlstm_conv_apply(F, l, 512 + h * 128 + d, kraw, cv);
#pragma unroll
        for (int i = 0; i < 32; ++i) *ldsp<bf16>(L, LM_B + ((tb + i) * MP + d) * 2) = (bf16)f2bf(cv[i]);
#pragma unroll
        for (int g = 0; g < 4; ++g) { u32x4 o; o.x = (unsigned)vraw[8 * g] | ((unsigned)vraw[8 * g + 1] << 16); o.y = (unsigned)vraw[8 * g + 2] | ((unsigned)vraw[8 * g + 3] << 16);
            o.z = (unsigned)vraw[8 * g + 4] | ((unsigned)vraw[8 * g + 5] << 16); o.w = (unsigned)vraw[8 * g + 6] | ((unsigned)vraw[8 * g + 7] << 16);
            *ldsp<u32x4>(L, LM_C + (d * MP + tb + 8 * g) * 2) = o; }
    }
    lds_barrier();
    LAUNDER_S(L);
    const int lq = 16 * w + l15;
    f32x4 a1[9], a2[9];
#pragma unroll
    for (int et = 0; et < 9; ++et) { a1[et] = (f32x4){0.f, 0.f, 0.f, 0.f}; a2[et] = (f32x4){0.f, 0.f, 0.f, 0.f}; }
    {
        const bf16* CP = wsp<bf16>(F, WS_F + F_MC + (size_t)item * 65536) + 16384 + (size_t)l15 * 128 + 8 * q; const float* NP = wsp<float>(F, WS_F + F_KS) + (size_t)item * 128;
        bf16x8 ca[8], cb[8];
#pragma unroll
        for (int et = 0; et < 8; ++et) ca[et] = *(const bf16x8*)(CP + (size_t)et * 2048);
#pragma unroll
        for (int s = 0; s < 4; ++s) {
            if (s < 3) {
#pragma unroll
                for (int et = 0; et < 8; ++et) { if (s & 1) ca[et] = *(const bf16x8*)(CP + (size_t)et * 2048 + 32 * (s + 1)); else cb[et] = *(const bf16x8*)(CP + (size_t)et * 2048 + 32 * (s + 1)); } }
            EMU_FENCE();
            const bf16x8 bq = ldfragm(L, LM_A, lq, 32 * s + 8 * q);
#pragma unroll
            for (int et = 0; et < 8; ++et) a2[et] = mfma16((s & 1) ? cb[et] : ca[et], bq, a2[et]);
            const float* np = NP + 32 * s + 8 * q; const f32x4 n0 = *(const f32x4*)np, n1 = *(const f32x4*)(np + 4);
            u32x4 o; o.x = pk2(n0[0], n0[1]); o.y = pk2(n0[2], n0[3]); o.z = pk2(n1[0], n1[1]); o.w = pk2(n1[2], n1[3]);
            if (l15 != 0) o = (u32x4){0u, 0u, 0u, 0u};
            a2[8] = mfma16(__builtin_bit_cast(bf16x8, o), bq, a2[8]); }
    }
    {
        bf16x8 bq[4];
#pragma unroll
        for (int s = 0; s < 4; ++s) bq[s] = ldfragm(L, LM_A, lq, 32 * s + 8 * q);
        const float al = *ldsp<float>(L, LM_S + 4 * 512 + lq * 4);
        const int nsb = 2 * (w >> 1) + 2;
        for (int sb = 0; sb < nsb; ++sb) { f32x4 acc = (f32x4){0.f, 0.f, 0.f, 0.f};
            if (sb <= w) {
#pragma unroll
                for (int s = 0; s < 4; ++s) acc = mfma16(ldfragm(L, LM_B, 16 * sb + l15, 32 * s + 8 * q), bq[s], acc);
#pragma unroll
                for (int r = 0; r < 4; ++r) { const int ss = 16 * sb + 4 * q + r; acc[r] = ss <= lq ? acc[r] * fexp(al + *ldsp<float>(L, LM_S + 3 * 512 + ss * 4)) : 0.f; } }
            u32x2 o; o.x = pk2(acc[0], acc[1]); o.y = pk2(acc[2], acc[3]); *ldsp<u32x2>(L, LM_D + (lq * MP + 16 * sb + 4 * q) * 2) = o; }
    }
    WAVE_LDS_FENCE();
    LAUNDER_S(L);
    {
        const int ns = (w >> 1) + 1;
        for (int s = 0; s < ns; ++s) { const bf16x8 bs = ldfragm(L, LM_D, lq, 32 * s + 8 * q);
#pragma unroll
            for (int et = 0; et < 8; ++et) a1[et] = mfma16(ldfragm(L, LM_C, 16 * et + l15, 32 * s + 8 * q), bs, a1[et]);
            const short one = l15 == 0 ? (short)0x3F80 : (short)0; const bf16x8 ones = (bf16x8){one, one, one, one, one, one, one, one};
            a1[8] = mfma16(ones, bs, a1[8]); }
    }
    {
        const float inter = *ldsp<float>(L, LM_S + 5 * 512 + lq * 4), emt = *ldsp<float>(L, LM_S + 6 * 512 + lq * 4);
        const float den = __shfl(a1[8][0] + inter * a2[8][0], l15);
        const float rden = frcp(fmaxf(fabsf(den), emt));
        float s1 = 0.f;
#pragma unroll
        for (int et = 0; et < 8; ++et) { a1[et] = (a1[et] + a2[et] * inter) * rden; s1 += (a1[et][0] + a1[et][1]) + (a1[et][2] + a1[et][3]); }
        s1 += __shfl_xor(s1, 16); s1 += __shfl_xor(s1, 32);
        const float mean = s1 * (1.0f / 128.0f); float s2 = 0.f;
#pragma unroll
        for (int et = 0; et < 8; ++et) { a1[et] = a1[et] - mean; s2 += (a1[et][0] * a1[et][0] + a1[et][1] * a1[et][1]) + (a1[et][2] * a1[et][2] + a1[et][3] * a1[et][3]); }
        s2 += __shfl_xor(s2, 16); s2 += __shfl_xor(s2, 32);
        const float rstd = frsq(s2 * (1.0f / 128.0f) + 1e-5f);
        bf16* prow = P + (m0 + lq) * PW;
#pragma unroll
        for (int et = 0; et < 8; ++et) { const int e = 16 * et + 4 * q; const f32x4 lg = *(const f32x4*)(inp(F, 22) + (size_t)l * MW + h * 128 + e);
            const f32x4 og = ld4bf_g(prow + PC_MO + h * 128 + e); f32x4 o;
#pragma unroll
            for (int r = 0; r < 4; ++r) o[r] = sigmoidf_(og[r]) * (a1[et][r] * rstd * lg[r]);
            st4bf_g(prow + 512 + h * 128 + e, o); }
    }
    lds_barrier();
}

constexpr int NSTAGES = 2 + 10 * DEPTH + 1;
#ifndef PG8_SP2
#define PG8_SP2 true
#endif
#ifndef PG8_ALIGN
#define PG8_ALIGN true
#endif
__device__ __forceinline__ void run_stage(Frame& F0, int s) {
    Frame F = F0; LAUNDER(F.lane); LAUNDER_S(F.wave); LAUNDER_S(F.bid); LAUNDER_S(F.G); F.tid = F.wave * 64 + F.lane;
    int r = -1, l = 0;
    if (s >= 2 && s < NSTAGES - 1) { r = (s - 2) % 10; l = (s - 2) / 10; }
    unsigned char* wl = wlayer(F, l);
    bf16* XN = wsp<bf16>(F, WS_XN); bf16* R = wsp<bf16>(F, WS_R);
    float* bl = wsp<float>(F, WS_F + F_BIAS) + (size_t)l * BIAS_LAYER;
    if (s == 0) { ph_mod(F); ph_convert(F, 0, 0); return; }
    if (s == 1) { ph_prenorm(F, inp(F, 0), inp(F, 4), modp(F, 0, 1)); ph_bias(F, 0); return; }
    if (s == NSTAGES - 1) { ph_finalnorm(F, inp(F, 26)); return; }
    if (r == 0 || r == 8) {
        const int i = r == 0 ? 0 : 1;
        pg8::Gemm g{XN, (const bf16*)(wl + W_FFIN + i * W_FFIN_SZ), MTOK, 2 * FF, DM, DM}; pg8::StaticOrder S; S.init(MTOK, 2 * FF, F.G, F.bid);
        EpiSwiglu E{R, rowsq16(F), bl + i * BIAS_FF};
        pg8::gemm_phase<EpiSwiglu, pg8::StaticOrder, PG8_ALIGN, PG8_SP2>(F.lds, g, S, E); return;
    }
    if (r == 1 || r == 9 || r == 7) {
        const int i = r == 1 ? 0 : 1; const bool ffn = r != 7;
        const int nl = r == 9 ? l + 1 : l, nw = r == 1 ? 1 : (r == 7 ? 2 : 0);
        const bool has_next = nl < DEPTH;
        const bf16* Ap = ffn ? (const bf16*)R : (const bf16*)wsp<bf16>(F, WS_F + F_GV); const bf16* Bp = (const bf16*)(wl + (ffn ? W_FFOUT + i * W_FFOUT_SZ : W_WOUT)); const int Kd = ffn ? FF : DM;
        pg8::Gemm g{Ap, Bp, MTOK, DM, Kd, Kd}; pg8::StaticOrder S; S.init(MTOK, DM, F.G, F.bid);
        const float* xin = (l == 0 && r == 1) ? inp(F, 0) : (const float*)xout(F); float* xo = xout(F); const float* gt = modp(F, l, r == 1 ? 2 : (r == 7 ? 5 : 8));
        const float* csp = has_next ? wsp<float>(F, WS_F + F_CS) + (size_t)(nl * 3 + nw) * NB * DM : nullptr; float* rq = rowsq16(F);
        if (ffn) { EpiRes<true> E; E.Xin = xin; E.Xout = xo; E.gate = gt; E.XS = XN; E.csn = csp; E.rsq = rq;
            pg8::gemm_phase<EpiRes<true>, pg8::StaticOrder, false, PG8_SP2>(F.lds, g, S, E); }
        else { EpiRes<false> E; E.Xin = xin; E.Xout = xo; E.gate = gt; E.XS = XN; E.csn = csp; E.rsq = rq;
            pg8::gemm_phase<EpiRes<false>, pg8::StaticOrder, false, PG8_SP2>(F.lds, g, S, E); }
        return;
    }
    if (r == 2) {
        pg8::Gemm g{XN, (const bf16*)(wl + W_MIXIN), MTOK, PW, DM, DM}; pg8::StaticOrder S; S.init(MTOK, PW, F.G, F.bid);
        EpiBf<0> E{R, PW, nullptr, 0, rowsq16(F), bl + 2 * BIAS_FF, PW};
        pg8::gemm_phase<EpiBf<0>, pg8::StaticOrder, PG8_ALIGN, PG8_SP2>(F.lds, g, S, E); return;
    }
    if (r == 3) {
        { PSEC_B(1) PrepRaw raw; if (F.bid < NIT1) rwkv_prep_fetch(F, l, F.bid, raw);
          for (int it = F.bid; it < NIT1; it += F.G) rwkv_prep_item(F, l, it, raw, it + F.G < NIT1 ? it + F.G : -1); PSEC_E(F, 1) }
        { PSEC_B(2) for (int it = F.bid; it < NIT2; it += F.G) mlstm_m1_item(F, l, it); PSEC_E(F, 2) }
        return;
    }
    if (r == 4) {
        { PSEC_B(5) for (int bh = F.bid; bh < NB * RH; bh += F.G) rwkv_scan_bh(F, bh); PSEC_E(F, 5) }
        { PSEC_B(8) mlstm_m2(F, F.G > NB * RH ? NB * RH : 0); PSEC_E(F, 8) }
        if (l + 1 < DEPTH) ph_convert(F, l + 1, F.G > NB * RH ? NB * RH : 0);
        return;
    }
    if (r == 5) {
        if (l + 1 < DEPTH) ph_bias(F, l + 1);
        { PSEC_B(3) OutRaw oraw; if (F.bid < NIT1) rwkv_out_fetch(F, l, F.bid, oraw);
          for (int it = F.bid; it < NIT1; it += F.G) rwkv_out_item(F, l, it, oraw, it + F.G < NIT1 ? it + F.G : -1); PSEC_E(F, 3) }
        { PSEC_B(4) for (int it = F.bid; it < NIT2; it += F.G) mlstm_m3_item(F, l, it); PSEC_E(F, 4) }
        return;
    }
    if (r == 6) {
        bf16* SG = wsp<bf16>(F, WS_F + F_EV); bf16* TU = wsp<bf16>(F, WS_F + F_GV);
        { pg8::Gemm g{XN, (const bf16*)(wl + W_GATE), MTOK, 2048, DM, DM}; pg8::GateOrder S; S.init(MTOK, F.G, F.bid);
          EpiBf<1> E{SG, 2048, nullptr, 0, rowsq16(F), bl + 2 * BIAS_FF + BIAS_MIX, 2048};
          pg8::gemm_phase<EpiBf<1>, pg8::GateOrder, PG8_ALIGN, PG8_SP2>(F.lds, g, S, E); }
        { pg8::Gemm g{R, (const bf16*)(wl + W_BR), MTOK, DM, 512, PW}; pg8::StaticOrder S; S.init(MTOK, DM, F.G, F.bid);
          EpiBf<2> E{TU, DM, SG, 2048, nullptr, nullptr, 0};
          pg8::gemm_phase<EpiBf<2>, pg8::StaticOrder, false, PG8_SP2>(F.lds, g, S, E); }
        { pg8::Gemm g{R + 512, (const bf16*)(wl + W_BR + W_BR_SZ), MTOK, DM, 512, PW}; pg8::StaticOrder S; S.init(MTOK, DM, F.G, F.bid);
          EpiBf<3> E{TU, DM, SG + 1024, 2048, nullptr, nullptr, 0};
          pg8::gemm_phase<EpiBf<3>, pg8::StaticOrder, false, PG8_SP2>(F.lds, g, S, E); }
        return;
    }
}

struct Args { const float* in[27]; float* out; unsigned char* ws; int s_lo, s_hi; };

#ifndef EMU
#define XB_TMO      128
#define XB_XCNT(j)  (256  + 64 * (j))
#define XB_XSUB(j)  (1280 + 64 * (j))
#define XB_XGEN(j)  (2304 + 64 * (j))
#define XB_TOP      3328
#define XB_TOPGEN   3392
#define XCD_BAR_WORDS 3456
#define XB_SPIN_CAP (1u << 18)
#ifndef XB_POLL_SLEEP
#define XB_POLL_SLEEP 2
#endif

__device__ __forceinline__ unsigned xb_ld(unsigned* p)              { return __hip_atomic_load(p, __ATOMIC_RELAXED, __HIP_MEMORY_SCOPE_AGENT); }
__device__ __forceinline__ unsigned xb_add(unsigned* p, unsigned v) { return __hip_atomic_fetch_add(p, v, __ATOMIC_RELAXED, __HIP_MEMORY_SCOPE_AGENT); }
__device__ __forceinline__ unsigned xb_xcc_id() { return (unsigned)__builtin_amdgcn_s_getreg((3 << 11) | 20) & 0xFu; }
#define XB_SPIN(cond, bar) do { unsigned _sp = 0; while (cond) { __builtin_amdgcn_s_sleep(XB_POLL_SLEEP); \
    if ((++_sp & 255u) == 0u) { if (xb_ld(&(bar)[XB_TMO])) break; if (_sp > XB_SPIN_CAP) { atomicAdd(&(bar)[XB_TMO], 1u); break; } } } } while (0)

struct XcdBarrier {
    unsigned* bar; unsigned x;
    volatile LAS unsigned* st;
};

__device__ __forceinline__ XcdBarrier xcd_barrier_post(unsigned* bar, volatile LAS unsigned* st) {
    XcdBarrier b; b.bar = bar; b.x = xb_xcc_id(); b.st = st;
    if (threadIdx.x == 0) (void)xb_add(&bar[XB_XCNT(b.x)], 1u);
    return b;
}
__device__ __forceinline__ void xcd_barrier_complete(unsigned* bar, unsigned x, unsigned& nloc, unsigned& nx) {
    const unsigned G = gridDim.x * gridDim.y * gridDim.z;
    unsigned sum, cnt, mine, sp = 0u;
    for (;;) {
        sum = 0u; cnt = 0u; mine = 0u;
#pragma unroll
        for (unsigned j = 0; j < 16; ++j) { const unsigned c = xb_ld(&bar[XB_XCNT(j)]); sum += c; cnt += (c > 0u) ? 1u : 0u; mine = (j == x) ? c : mine; }
        if (sum == G) break;
        __builtin_amdgcn_s_sleep(1);
        if ((++sp & 255u) == 0u) { if (xb_ld(&bar[XB_TMO])) break; if (sp > XB_SPIN_CAP) { atomicAdd(&bar[XB_TMO], 1u); break; } }
    }
    nloc = mine > 0u ? mine : 1u; nx = cnt > 0u ? cnt : 1u;
}

__device__ __forceinline__ void xcd_barrier(const XcdBarrier& b) {
    asm volatile("s_waitcnt vmcnt(0)" ::: "memory");
    __syncthreads();
    if (threadIdx.x == 0) {
        unsigned* bar = b.bar;
        __builtin_amdgcn_s_waitcnt(0);
        unsigned nloc = b.st[0], nx = b.st[1];
        if (nloc == 0u) { xcd_barrier_complete(bar, b.x, nloc, nx); b.st[0] = nloc; b.st[1] = nx; }
        const unsigned old = xb_add(&bar[XB_XSUB(b.x)], 1u);
        const unsigned gen = old / nloc;
        if (old + 1u == (gen + 1u) * nloc) {
            __builtin_amdgcn_fence(__ATOMIC_RELEASE, "agent");
            asm volatile("s_waitcnt vmcnt(0)" ::: "memory");
            const unsigned og = xb_add(&bar[XB_TOP], 1u);
            const unsigned tg = og / nx;
            if (og + 1u == (tg + 1u) * nx) xb_add(&bar[XB_TOPGEN], 1u);
            else XB_SPIN(xb_ld(&bar[XB_TOPGEN]) == tg, bar);
            __builtin_amdgcn_fence(__ATOMIC_ACQUIRE, "agent");
            xb_add(&bar[XB_XGEN(b.x)], 1u);
            asm volatile("s_waitcnt vmcnt(0)" ::: "memory");
        } else {
            XB_SPIN(xb_ld(&bar[XB_XGEN(b.x)]) == gen, bar);
            __builtin_amdgcn_fence(__ATOMIC_ACQUIRE, "agent");
            asm volatile("s_waitcnt vmcnt(0)" ::: "memory");
        }
    }
    __syncthreads();
}

#ifndef PROBE_MASK
#define PROBE_MASK 0ull
#endif
#ifndef PROBE_AMP
#define PROBE_AMP 4
#endif
#ifndef MK_N_LAUNCHES
#define MK_N_LAUNCHES 1
#endif
__global__ void __launch_bounds__(NWAVES * 64, 2) mk_fwd(Args a) {
    extern __shared__ __attribute__((aligned(16))) unsigned char lds_raw[];
    Frame F;
    F.lds = (LAS unsigned char*)lds_raw;
    F.tid = threadIdx.x; F.lane = F.tid & 63; F.wave = __builtin_amdgcn_readfirstlane(F.tid >> 6); F.G = gridDim.x; F.bid = blockIdx.x;
    if (F.tid < 27) *(const float* LAS*)(F.lds + TBL_OFF + 8 * F.tid) = a.in[F.tid];
    if (F.tid == 27) *(float* LAS*)(F.lds + TBL_OFF + 8 * 27) = a.out;
    if (F.tid == 28) *(unsigned char* LAS*)(F.lds + TBL_OFF + 8 * 28) = a.ws;
    volatile LAS unsigned* MISC = (volatile LAS unsigned*)(F.lds + MISC_OFF);
    for (int u = F.tid; u < 64; u += NWAVES * 64) MISC[u] = 0u;
    __syncthreads();
    XcdBarrier bar; bar.bar = (unsigned*)(a.ws + WS_CTL) + CW_BAR; bar.x = 0; bar.st = nullptr;
    const int s_lo = (MK_N_LAUNCHES == 1) ? 0 : a.s_lo, s_hi = (MK_N_LAUNCHES == 1) ? NSTAGES : a.s_hi;
    if (s_hi - s_lo > 1) bar = xcd_barrier_post((unsigned*)(a.ws + WS_CTL) + CW_BAR, MISC + 8);
#if PROBE_MASK
    unsigned long long tacc = 0ull;
#endif
    for (int s = s_lo; s < s_hi; ++s) {
#if PROBE_MASK
        const unsigned long long t0 = __builtin_amdgcn_s_memrealtime();
#endif
        run_stage(F, s);
        if (s + 1 < s_hi) { XcdBarrier b2 = bar; asm volatile("" : "+s"(b2.bar));
            xcd_barrier(b2); }
#if PROBE_MASK
        if ((PROBE_MASK >> s) & 1ull) tacc += __builtin_amdgcn_s_memrealtime() - t0;
#endif
    }
#if PROBE_SEC
    if (threadIdx.x == 0) { const unsigned long long ts = *(LAS unsigned long long*)(F.lds + MISC_OFF + 64), t0 = __builtin_amdgcn_s_memrealtime(); while (__builtin_amdgcn_s_memrealtime() - t0 < (unsigned long long)PROBE_AMP * ts) __builtin_amdgcn_s_sleep(32); }
#endif
#if PROBE_MASK
    if (blockIdx.x == 0 && threadIdx.x == 0) { const unsigned long long t0 = __builtin_amdgcn_s_memrealtime(); while (__builtin_amdgcn_s_memrealtime() - t0 < (unsigned long long)PROBE_AMP * tacc) __builtin_amdgcn_s_sleep(32); }
#endif
}

extern "C" void kernel_launch(void* const* d_in, const int* in_sizes, int n_in, void* d_out, int out_size, void* d_ws, size_t ws_size, hipStream_t stream) {
    static int grid = 0;
    if (grid == 0) {
        if (n_in != 27 || in_sizes[0] != MTOK * DM || out_size != MTOK * DM || ws_size < WS_END) { fprintf(stderr, "kernel_launch: unexpected problem shape (n_in %d, in0 %d, out %d, ws %zu < %zu); nothing launched\n", n_in, n_in > 0 ? in_sizes[0] : -1, out_size, ws_size, (size_t)WS_END); grid = -1; return; }
        int dev = 0, cus = 0, per_cu = 0;
        if (hipGetDevice(&dev) != hipSuccess || hipDeviceGetAttribute(&cus, hipDeviceAttributeMultiprocessorCount, dev) != hipSuccess) { grid = -1; return; }
        if (hipFuncSetAttribute((const void*)mk_fwd, hipFuncAttributeMaxDynamicSharedMemorySize, LDS_BYTES) != hipSuccess) { fprintf(stderr, "kernel_launch: hipFuncSetAttribute failed\n"); grid = -1; return; }
        if (hipOccupancyMaxActiveBlocksPerMultiprocessor(&per_cu, (const void*)mk_fwd, NWAVES * 64, LDS_BYTES) != hipSuccess || per_cu < 1) { fprintf(stderr, "kernel_launch: occupancy query reports %d workgroups per CU\n", per_cu); }
        (void)hipGetLastError();
        grid = cus;
    }
    if (grid < 0) return;
    if (hipMemsetAsync((char*)d_ws + WS_CTL, 0, CTL_ZERO_BYTES, stream) != hipSuccess) return;
    Args a{};
    for (int i = 0; i < 27; ++i) a.in[i] = (const float*)d_in[i];
    a.out = (float*)d_out; a.ws = (unsigned char*)d_ws;
    if (MK_N_LAUNCHES == 1) { a.s_lo = 0; a.s_hi = NSTAGES; hipLaunchKernelGGL(mk_fwd, dim3(grid), dim3(NWAVES * 64), LDS_BYTES, stream, a); }
    else for (int s = 0; s < NSTAGES; ++s) { a.s_lo = s; a.s_hi = s + 1; hipLaunchKernelGGL(mk_fwd, dim3(grid), dim3(NWAVES * 64), LDS_BYTES, stream, a); }
}
#endif
```

```cpp
#ifndef EMU
#include <hip/hip_runtime.h>
#include <cstdio>
#include <cstdint>
#define LAS __attribute__((address_space(3)))
#define GAS __attribute__((address_space(1)))
#endif

#ifndef CFG_B
#define CFG_B 4
#endif
#ifndef CFG_T
#define CFG_T 4096
#endif

typedef unsigned short bf16;
typedef short bf16x8 __attribute__((ext_vector_type(8)));
typedef float f32x4 __attribute__((ext_vector_type(4)));
typedef float f32x2 __attribute__((ext_vector_type(2)));
typedef unsigned u32x4 __attribute__((ext_vector_type(4)));
typedef unsigned u32x2 __attribute__((ext_vector_type(2)));

constexpr int NB = CFG_B, SEQ = CFG_T, MTOK = NB * SEQ, DM = 1024, FF = 2816, DEPTH = 2;
constexpr int RH = 8, RD = 64, RW = 512, MH = 4, MD = 128, MW = 512;
constexpr int RCOLS = 1696, MCOLS = 2056, NIN = 5800, PW = 3840;
constexpr int NC1 = SEQ / 64, NC2 = SEQ / 128;
constexpr int NIT1 = NB * RH * NC1, NIT2 = NB * MH * NC2;
static_assert(MTOK % 256 == 0 && SEQ % 256 == 0, "token tiles");
constexpr int PC_R = 0, PC_K = 512, PC_V = 1024, PC_LORA = 1536, PC_GLO = 1600;
constexpr int PC_MQ = 1696, PC_MK = 2208, PC_MV = 2720, PC_MO = 3232, PC_MI = 3744, PC_MF = 3748;

constexpr size_t MiB = 1u << 20;
constexpr size_t WS_CTL = 0, CTL_ZERO_BYTES = 1 * MiB;
constexpr size_t CTL_MOD_OFF = 512 * 1024;
constexpr size_t WS_W = 1 * MiB;
constexpr size_t W_FFIN = 0, W_FFIN_SZ = (size_t)2 * FF * DM * 2;
constexpr size_t W_FFOUT = 2 * W_FFIN_SZ, W_FFOUT_SZ = (size_t)DM * FF * 2;
constexpr size_t W_MIXIN = W_FFOUT + 2 * W_FFOUT_SZ, W_MIXIN_SZ = (size_t)PW * DM * 2;
constexpr size_t W_GATE = W_MIXIN + W_MIXIN_SZ, W_GATE_SZ = (size_t)2048 * DM * 2;
constexpr size_t W_BR = W_GATE + W_GATE_SZ, W_BR_SZ = (size_t)DM * 512 * 2;
constexpr size_t W_WOUT = W_BR + 2 * W_BR_SZ, W_WOUT_SZ = (size_t)DM * DM * 2;
constexpr size_t W_SMALL = W_WOUT + W_WOUT_SZ;
constexpr size_t W_SMALL_WUP = 0, W_SMALL_AUP = 8 * 64 * 32 * 2, W_SMALL_GUP = 2 * 8 * 64 * 32 * 2, W_SMALL_SZ = 512 * 1024;
constexpr size_t W_LAYER = W_SMALL + W_SMALL_SZ;
static_assert(W_LAYER == 49 * MiB, "weight block");
constexpr size_t WS_XN = WS_W + 2 * W_LAYER;
constexpr size_t WS_R = WS_XN + (size_t)MTOK * DM * 2;
constexpr size_t WS_F = WS_R + (size_t)MTOK * PW * 2;
constexpr size_t F_GV = 0;
constexpr size_t F_EV = F_GV + (size_t)NIT1 * 16384;
constexpr size_t F_MC = F_EV + (size_t)NIT1 * 16384;
constexpr size_t F_KS = F_MC + (size_t)NIT2 * 65536;
constexpr size_t F_MSC = F_KS + (size_t)NIT2 * 512;
constexpr size_t F_RHO = F_MSC + (size_t)NIT2 * 16;
constexpr size_t F_RSQ = F_RHO + (size_t)MTOK * 32;
constexpr size_t F_BIAS = F_RSQ + (size_t)MTOK * 64;
constexpr size_t BIAS_FF = (size_t)NB * 2 * FF, BIAS_MIX = (size_t)NB * PW, BIAS_GATE = (size_t)NB * 2048, BIAS_LAYER = 2 * BIAS_FF + BIAS_MIX + BIAS_GATE;
constexpr size_t F_CS = F_BIAS + 2 * BIAS_LAYER * 4;
constexpr size_t WS_END = WS_F + F_CS + (size_t)DEPTH * 3 * NB * DM * 4;
static_assert(F_EV + (size_t)MTOK * 2048 * 2 <= F_KS, "SG overlay");
static_assert((size_t)MTOK * DM * 2 <= F_EV, "T1/U overlay");
constexpr int CW_BAR = 4096;

constexpr int LDS_BYTES = 147456;
constexpr int MISC_OFF = LDS_BYTES - 256;
constexpr int NWAVES = 8;

#ifndef PROBE_SEC
#define PROBE_SEC 0
#endif
#if PROBE_SEC && !defined(EMU)
#define PSEC_B(id) unsigned long long _tp##id = 0ull; if (PROBE_SEC == id) _tp##id = __builtin_amdgcn_s_memrealtime();
#define PSEC_E(F, id) if (PROBE_SEC == id && threadIdx.x == 0) *(LAS unsigned long long*)((F).lds + MISC_OFF + 64) += __builtin_amdgcn_s_memrealtime() - _tp##id;
#else
#define PSEC_B(id)
#define PSEC_E(F, id)
#endif
#ifdef EMU
static inline float fexp(float x) { return expf(x); }
#else
__device__ __forceinline__ float fexp(float x) { return __expf(x); }
#endif
__device__ __forceinline__ float bf2f(bf16 b) { unsigned u = ((unsigned)b) << 16; return __builtin_bit_cast(float, u); }
#ifdef EMU
__device__ __forceinline__ unsigned f2bf(float f) { unsigned u = __builtin_bit_cast(unsigned, f); return (u + 0x7fffu + ((u >> 16) & 1u)) >> 16; }
__device__ __forceinline__ unsigned pk2(float lo, float hi) { return f2bf(lo) | (f2bf(hi) << 16); }
#else
typedef __bf16 hwbf16x2 __attribute__((ext_vector_type(2)));
__device__ __forceinline__ unsigned pk2(float lo, float hi) { const f32x2 v = {lo, hi}; return __builtin_bit_cast(unsigned, __builtin_convertvector(v, hwbf16x2)); }
__device__ __forceinline__ unsigned f2bf(float f) { return pk2(f, 0.f) & 0xffffu; }
#endif
#ifdef EMU
static inline float frcp(float x) { return 1.0f / x; }
static inline float frsq(float x) { return 1.0f / sqrtf(x); }
static inline float fsqrt(float x) { return sqrtf(x); }
static inline float flog(float x) { return logf(x); }
#else
__device__ __forceinline__ float frcp(float x) { return __builtin_amdgcn_rcpf(x); }
__device__ __forceinline__ float frsq(float x) { return __builtin_amdgcn_rsqf(x); }
__device__ __forceinline__ float fsqrt(float x) { return __builtin_amdgcn_sqrtf(x); }
__device__ __forceinline__ float flog(float x) { return __logf(x); }
#endif
__device__ __forceinline__ float sigmoidf_(float x) { return frcp(1.0f + fexp(-x)); }
__device__ __forceinline__ float siluf_(float x) { return x * frcp(1.0f + fexp(-x)); }
__device__ __forceinline__ float softplusf_(float x) { return fmaxf(x, 0.f) + flog(1.0f + fexp(-fabsf(x))); }
__device__ __forceinline__ float tanhf_(float x) { return 1.0f - 2.0f * frcp(fexp(2.0f * x) + 1.0f); }

#ifdef EMU
#define WAVE_LDS_FENCE() emu::wave_sync()
#define EMU_FENCE() do {} while (0)
#define lds_barrier() __syncthreads()
#define vm_lds_barrier() __syncthreads()
static inline void glds16(const void* gsrc_lane, unsigned char* lds_wave_base) { memcpy(lds_wave_base + 16 * (emu::cur & 63), gsrc_lane, 16); }
static inline f32x4 mfma4f(float a, float b, f32x4 c) {
    int w = emu::cur >> 6, l = emu::cur & 63; emu::xf[w][l] = a; emu::xu[w][l] = __builtin_bit_cast(unsigned, b);
    emu::wave_sync();
    for (int r = 0; r < 4; ++r) { int row = 4 * (l >> 4) + r, col = l & 15; float s = 0.f;
        for (int k = 0; k < 4; ++k) s += emu::xf[w][row + 16 * k] * __builtin_bit_cast(float, emu::xu[w][col + 16 * k]);
        c[r] += s; }
    emu::wave_sync(); return c;
}
#define LAUNDER(x) do {} while (0)
#define LAUNDER_S(x) do {} while (0)
static inline f32x4 mfma16(bf16x8 a, bf16x8 b, f32x4 c) {
    int w = emu::cur >> 6, l = emu::cur & 63;
    for (int j = 0; j < 8; ++j) { emu::xa[w][l][j] = (unsigned short)a[j]; emu::xb[w][l][j] = (unsigned short)b[j]; }
    emu::wave_sync();
    for (int r = 0; r < 4; ++r) { int row = 4 * (l >> 4) + r, col = l & 15; float s = 0.f;
        for (int k = 0; k < 32; ++k) s += bf2f(emu::xa[w][row + 16 * (k >> 3)][k & 7]) * bf2f(emu::xb[w][col + 16 * (k >> 3)][k & 7]);
        c[r] += s; }
    emu::wave_sync(); return c;
}
static inline float rdlane(float v, int l) { return __shfl(v, l); }
static inline int wave_id() { return threadIdx.x >> 6; }
#else
#define WAVE_LDS_FENCE() asm volatile("s_waitcnt lgkmcnt(0)" ::: "memory")
#define EMU_FENCE() asm volatile("" ::: "memory")
#define lds_barrier() asm volatile("s_waitcnt lgkmcnt(0)\n\ts_barrier" ::: "memory")
#define vm_lds_barrier() asm volatile("s_waitcnt vmcnt(0) lgkmcnt(0)\n\ts_barrier" ::: "memory")
__device__ __forceinline__ void glds16(const void* gsrc_lane, LAS unsigned char* lds_wave_base) { __builtin_amdgcn_global_load_lds((const unsigned*)gsrc_lane, (LAS unsigned*)lds_wave_base, 16, 0, 0); }
__device__ __forceinline__ f32x4 mfma4f(float a, float b, f32x4 c) { return __builtin_amdgcn_mfma_f32_16x16x4f32(a, b, c, 0, 0, 0); }
#define LAUNDER_S(x) asm volatile("" : "+s"(x))
#define LAUNDER(x) asm volatile("" : "+v"(x))
__device__ __forceinline__ f32x4 mfma16(bf16x8 a, bf16x8 b, f32x4 c) { return __builtin_amdgcn_mfma_f32_16x16x32_bf16(a, b, c, 0, 0, 0); }
__device__ __forceinline__ float rdlane(float v, int l) { return __builtin_bit_cast(float, __builtin_amdgcn_readlane(__builtin_bit_cast(int, v), l)); }
__device__ __forceinline__ int wave_id() { return __builtin_amdgcn_readfirstlane(threadIdx.x >> 6); }
#endif
#ifdef EMU
__device__ __forceinline__ float wave_sum(float v) {
    for (int o = 1; o < 64; o <<= 1) v += __shfl_xor(v, o);
    return v;
}
#else
template <int CTRL, int ROWMASK> __device__ __forceinline__ float dpp_add(float v) {
    return v + __builtin_bit_cast(float, __builtin_amdgcn_update_dpp(0, __builtin_bit_cast(int, v), CTRL, ROWMASK, 0xf, false)); }
__device__ __forceinline__ float wave_sum(float v) {
    v = dpp_add<0xB1, 0xf>(v);
    v = dpp_add<0x4E, 0xf>(v);
    v = dpp_add<0x141, 0xf>(v);
    v = dpp_add<0x140, 0xf>(v);
    v = dpp_add<0x142, 0xa>(v);
    v = dpp_add<0x143, 0xc>(v);
    return rdlane(v, 63);
}
#endif

namespace pg8 {
#define PG8_LAS LAS
typedef unsigned short bf16_t;
constexpr int BM = 256, BK = 64, HALF = 128, HTB = HALF * BK * 2  , STAGE_BYTES = 8 * HTB, NXCD = 8, WGM = 8;
__host__ __device__ __forceinline__ int lds_byte(int r, int c) { const int st = (r >> 4) * 2 + (c >> 5), rr = r & 15, cc = c & 31, ob = rr * 64 + cc * 2; return st * 1024 + (ob ^ (((ob >> 9) & 1) << 5)); }
__host__ __device__ __forceinline__ void stage_rc(int b, int& R, int& C) { const int st = b / 1024, sb = b % 1024, swz = sb ^ (((sb >> 9) & 1) << 5); R = (st >> 1) * 16 + swz / 64; C = (st & 1) * 32 + (swz % 64) / 2; }
__host__ __device__ __forceinline__ int perm32(int rho) { const int n = rho >> 4, i = rho & 15; return 8 * (i >> 2) + 4 * n + (i & 3); }
struct Unit { int pm, pn; };
struct Gemm { const bf16_t* A; const bf16_t* Bt; int M, N, K, lda; };
struct StaticOrder {
    int nM, nN, nwg, G, c;
    __host__ __device__ void init(int M, int N, int G_, int c_) { nM = M / BM; nN = N / BM; nwg = nM * nN; G = G_; c = c_; }
    __host__ __device__ bool next(int i, Unit& u) const {
        const long L = (long)i * G + c; if (L >= nwg) return false;
        int wgid = (int)L; { const int q = nwg / NXCD, r = nwg % NXCD, xcd = wgid % NXCD, off = wgid / NXCD; wgid = (xcd < r ? xcd * (q + 1) : r * (q + 1) + (xcd - r) * q) + off; }
        const int nig = WGM * nN, gid = wgid / nig, fm = gid * WGM, gsz = (nM - fm) < WGM ? (nM - fm) : WGM;
        u.pm = fm + ((wgid % nig) % gsz); u.pn = (wgid % nig) / gsz; return true;
    }
    __device__ __forceinline__ void a_ready(const Unit&) const {}
    __device__ __forceinline__ void done(const Unit&) const {}
};
struct GateOrder {
    StaticOrder base;
    __host__ __device__ void init(int M, int G_, int c_) { base.init(M, 1024, G_, c_); }
    __host__ __device__ bool next(int i, Unit& u) const { if (!base.next(i >> 1, u)) return false; u.pn += 4 * (i & 1); return true; }
    __device__ __forceinline__ void a_ready(const Unit&) const {}
    __device__ __forceinline__ void done(const Unit&) const {}
};
#ifndef EMU
__device__ __forceinline__ unsigned cvt_pk_bf16(float lo, float hi) { unsigned r; asm volatile("v_cvt_pk_bf16_f32 %0, %1, %2" : "=v"(r) : "v"(lo), "v"(hi)); return r; }
template <class Epi, class Sched, bool ALIGN_EPI = false, bool SP2 = false>
__device__ __forceinline__ void gemm_phase(PG8_LAS unsigned char* lds, const Gemm g, const Sched& S, const Epi& E) {
    int tid_ = threadIdx.x; asm volatile("" : "+v"(tid_));
    const int tid = tid_, wid = __builtin_amdgcn_readfirstlane(tid >> 6), lane = tid & 63, wr = wid >> 2, wc = wid & 3, fr = lane & 15, fq = lane >> 4;
    const int K = g.K, nt = K / BK;
    unsigned voffA[2], voffB[2];
#pragma unroll
    for (int i = 0; i < 2; ++i) { int R, C; stage_rc(tid * 16 + i * 8192, R, C); const int Rb = Epi::PERM ? ((R & ~31) + perm32(R & 31)) : R;
        voffA[i] = (unsigned)(R * g.lda + C) * 2u; voffB[i] = (unsigned)(Rb * K + C) * 2u; }
    const size_t kstep = (size_t)(BK * 2);
    const size_t hstep = (size_t)HALF * K * 2;
    const size_t tstep = 2 * hstep; const size_t hstepA = (size_t)HALF * g.lda * 2, tstepA = 2 * hstepA;
    const unsigned ldsw = (unsigned)wid * 1024u;
    const int aoff = lds_byte(wr * 64 + fr, fq * 8), boff = lds_byte(wc * 32 + fr, fq * 8);
#define PG8_SA(b, h) (((b) * 2 + (h)) * HTB)
#define PG8_SB(b, h) ((4 + (b) * 2 + (h)) * HTB)
#define PG8_STAGE(bufoff, gbase, voff) do { _Pragma("unroll") for (int _i = 0; _i < 2; ++_i) \
        __builtin_amdgcn_global_load_lds((const unsigned*)((const char*)(gbase) + (voff)[_i]), (PG8_LAS unsigned*)(lds + (bufoff) + ldsw + _i * 8192), 16, 0, 0); } while (0)
#define PG8_LDA(dst, b, h) do { _Pragma("unroll") for (int m = 0; m < 4; ++m) _Pragma("unroll") for (int k = 0; k < 2; ++k) dst[m][k] = *(const PG8_LAS bf16x8*)(lds + PG8_SA(b, h) + aoff + m * 2048 + k * 1024); } while (0)
#define PG8_LDB(dst, b, h) do { _Pragma("unroll") for (int n = 0; n < 2; ++n) _Pragma("unroll") for (int k = 0; k < 2; ++k) dst[n][k] = *(const PG8_LAS bf16x8*)(lds + PG8_SB(b, h) + boff + n * 2048 + k * 1024); } while (0)
#define PG8_MMA(ai, bj, At, Bt) do { __builtin_amdgcn_s_setprio(1); _Pragma("unroll") for (int m = 0; m < 4; ++m) _Pragma("unroll") for (int n = 0; n < 2; ++n) _Pragma("unroll") for (int k = 0; k < 2; ++k) \
        acc[ai][bj][m][n] = __builtin_amdgcn_mfma_f32_16x16x32_bf16(Bt[n][k], At[m][k], acc[ai][bj][m][n], 0, 0, 0); __builtin_amdgcn_s_setprio(0); } while (0)
#define PG8_WAIT_V(n) asm volatile("s_waitcnt vmcnt(" #n ")" ::: "memory")
#define PG8_WAIT_L(n) asm volatile("s_waitcnt lgkmcnt(" #n ")" ::: "memory")
#define PG8_BAR __builtin_amdgcn_s_barrier()
#define PG8_SCHED __builtin_amdgcn_sched_barrier(0)
    Unit cur, nxt; int ui = 0;
    if (!S.next(0, cur)) return;
    f32x4 acc[2][2][4][2];
#pragma unroll
    for (int a = 0; a < 2; ++a)
#pragma unroll
        for (int b = 0; b < 2; ++b)
#pragma unroll
            for (int m = 0; m < 4; ++m)
#pragma unroll
                for (int n = 0; n < 2; ++n) acc[a][b][m][n] = (f32x4){0.f, 0.f, 0.f, 0.f};
    bf16x8 At[4][2], B0[2][2], B1[2][2];
    const char* cA = (const char*)g.A + (size_t)cur.pm * tstepA; const char* cB = (const char*)g.Bt + (size_t)cur.pn * tstep;
    S.a_ready(cur);
    if constexpr (SP2) {
        PG8_STAGE(PG8_SB(0, 0), cB, voffB); PG8_STAGE(PG8_SB(0, 1), cB + hstep, voffB); PG8_STAGE(PG8_SA(0, 0), cA, voffA); PG8_STAGE(PG8_SA(0, 1), cA + hstepA, voffA);
        if (wr == 1) PG8_BAR;
        PG8_WAIT_V(2); PG8_BAR;
        PG8_STAGE(PG8_SB(1, 0), cB + kstep, voffB); PG8_STAGE(PG8_SA(1, 0), cA + kstep, voffA); PG8_STAGE(PG8_SB(1, 1), cB + hstep + kstep, voffB);
        PG8_WAIT_V(6); PG8_BAR;
    } else {
        PG8_STAGE(PG8_SB(0, 0), cB, voffB); PG8_STAGE(PG8_SA(0, 0), cA, voffA); PG8_STAGE(PG8_SB(0, 1), cB + hstep, voffB); PG8_STAGE(PG8_SA(0, 1), cA + hstepA, voffA);
        if (wr == 1) PG8_BAR;
        PG8_WAIT_V(4); PG8_BAR;
        PG8_STAGE(PG8_SB(1, 0), cB + kstep, voffB); PG8_STAGE(PG8_SA(1, 0), cA + kstep, voffA); PG8_STAGE(PG8_SB(1, 1), cB + hstep + kstep, voffB);
        PG8_WAIT_V(6); PG8_BAR;
    }
    for (;;) {
        const bool has_next = S.next(ui + 1, nxt);
        const char* nA = has_next ? (const char*)g.A + (size_t)nxt.pm * tstepA : cA; const char* nB = has_next ? (const char*)g.Bt + (size_t)nxt.pn * tstep : cB;
        for (int t = 0; t < nt; t += 2) {
            const bool last = (t == nt - 2);
            const char* a1 = cA + (size_t)(t + 1) * kstep;
            const char* a2 = last ? nA : cA + (size_t)(t + 2) * kstep; const char* b2 = last ? nB : cB + (size_t)(t + 2) * kstep;
            const char* a3 = a2 + kstep; const char* b3 = b2 + kstep;
            if (last && has_next) S.a_ready(nxt);
            if constexpr (SP2) {
            PG8_LDB(B0, 0, 0); PG8_LDB(B1, 0, 1); PG8_SCHED; PG8_LDA(At, 0, 0); PG8_STAGE(PG8_SA(1, 1), a1 + hstepA, voffA);
            PG8_WAIT_V(8); PG8_WAIT_L(0); PG8_BAR; PG8_MMA(0, 0, At, B0); PG8_MMA(0, 1, At, B1); PG8_BAR; PG8_SCHED;
            PG8_LDA(At, 0, 1); PG8_STAGE(PG8_SB(0, 0), b2, voffB); PG8_STAGE(PG8_SB(0, 1), b2 + hstep, voffB); PG8_STAGE(PG8_SA(0, 0), a2, voffA);
            PG8_WAIT_V(8); PG8_WAIT_L(0); PG8_BAR; PG8_MMA(1, 0, At, B0); PG8_MMA(1, 1, At, B1); PG8_BAR; PG8_SCHED;
            PG8_LDB(B0, 1, 0); PG8_LDB(B1, 1, 1); PG8_SCHED; PG8_LDA(At, 1, 0); PG8_STAGE(PG8_SA(0, 1), a2 + hstepA, voffA);
            PG8_WAIT_V(8); PG8_WAIT_L(0); PG8_BAR; PG8_MMA(0, 0, At, B0); PG8_MMA(0, 1, At, B1); PG8_BAR; PG8_SCHED;
            PG8_LDA(At, 1, 1); PG8_STAGE(PG8_SB(1, 0), b3, voffB); PG8_STAGE(PG8_SB(1, 1), b3 + hstep, voffB); PG8_STAGE(PG8_SA(1, 0), a3, voffA);
            PG8_WAIT_V(8); PG8_WAIT_L(0); PG8_BAR; PG8_MMA(1, 0, At, B0); PG8_MMA(1, 1, At, B1); PG8_BAR; PG8_SCHED;
            } else {
            PG8_LDB(B0, 0, 0); PG8_SCHED; PG8_LDA(At, 0, 0); PG8_STAGE(PG8_SA(1, 1), a1 + hstepA, voffA);
            PG8_WAIT_L(8); PG8_BAR; PG8_WAIT_L(0); PG8_MMA(0, 0, At, B0); PG8_BAR; PG8_SCHED;
            PG8_LDB(B1, 0, 1); PG8_STAGE(PG8_SB(0, 0), b2, voffB);
            PG8_BAR; PG8_WAIT_L(0); PG8_MMA(0, 1, At, B1); PG8_BAR;
            PG8_LDA(At, 0, 1); PG8_STAGE(PG8_SA(0, 0), a2, voffA);
            PG8_BAR; PG8_WAIT_L(0); PG8_MMA(1, 0, At, B0); PG8_BAR; PG8_SCHED;
            PG8_STAGE(PG8_SB(0, 1), b2 + hstep, voffB);
            PG8_WAIT_V(6); PG8_BAR; PG8_MMA(1, 1, At, B1); PG8_BAR;
            PG8_LDB(B0, 1, 0); PG8_SCHED; PG8_LDA(At, 1, 0); PG8_STAGE(PG8_SA(0, 1), a2 + hstepA, voffA);
            PG8_WAIT_L(8); PG8_BAR; PG8_WAIT_L(0); PG8_MMA(0, 0, At, B0); PG8_BAR; PG8_SCHED;
            PG8_LDB(B1, 1, 1); PG8_STAGE(PG8_SB(1, 0), b3, voffB);
            PG8_BAR; PG8_WAIT_L(0); PG8_MMA(0, 1, At, B1); PG8_BAR;
            PG8_LDA(At, 1, 1); PG8_STAGE(PG8_SA(1, 0), a3, voffA);
            PG8_BAR; PG8_WAIT_L(0); PG8_MMA(1, 0, At, B0); PG8_BAR; PG8_SCHED;
            PG8_STAGE(PG8_SB(1, 1), b3 + hstep, voffB);
            PG8_WAIT_V(6); PG8_BAR; PG8_MMA(1, 1, At, B1); PG8_BAR;
            }
        }
        if constexpr (ALIGN_EPI) { if (wr == 0) PG8_BAR; }
        if constexpr (!Epi::AFTER_DRAIN) { E(acc, cur, wr, wc, fr, fq); S.done(cur); }
        if (!has_next) break;
#pragma unroll
        for (int a = 0; a < 2; ++a)
#pragma unroll
            for (int b = 0; b < 2; ++b)
#pragma unroll
                for (int m = 0; m < 4; ++m)
#pragma unroll
                    for (int n = 0; n < 2; ++n) acc[a][b][m][n] = (f32x4){0.f, 0.f, 0.f, 0.f};
        cur = nxt; cA = nA; cB = nB; ++ui;
        if constexpr (ALIGN_EPI) { if (wr == 1) PG8_BAR; }
    }
    PG8_WAIT_V(0);
    if constexpr (!ALIGN_EPI) { if (wr == 0) PG8_BAR; }
    PG8_BAR;
    if constexpr (Epi::AFTER_DRAIN) { E.fused(acc, cur, wr, wc, fr, fq, lds, wid, lane); S.done(cur); }
#undef PG8_SA
#undef PG8_SB
#undef PG8_STAGE
#undef PG8_LDA
#undef PG8_LDB
#undef PG8_MMA
#undef PG8_WAIT_V
#undef PG8_WAIT_L
#undef PG8_BAR
#undef PG8_SCHED
}

#else
static inline unsigned cvt_pk_bf16(float lo, float hi) { return pk2(lo, hi); }
template <class Epi, class Sched, bool ALIGN_EPI = false, bool SP2 = false>
static void gemm_phase(unsigned char* lds, const Gemm g, const Sched& S, const Epi& E) {
    if (threadIdx.x != 0) return;
    static std::vector<float> C; C.resize(256 * 256);
    Unit u;
    for (int i = 0; S.next(i, u); ++i) {
        for (int r = 0; r < 256; ++r) for (int c = 0; c < 256; ++c) { const bf16_t* a = g.A + (size_t)(u.pm * 256 + r) * g.lda; const bf16_t* b = g.Bt + (size_t)(u.pn * 256 + c) * g.K; float s = 0.f; for (int k = 0; k < g.K; ++k) s += bf2f(a[k]) * bf2f(b[k]); C[r * 256 + c] = s; }
        for (int tid = 0; tid < 512; ++tid) { const int wid = tid >> 6, lane = tid & 63, wr = wid >> 2, wc = wid & 3, fr = lane & 15, fq = lane >> 4;
            f32x4 acc[2][2][4][2];
            for (int ai = 0; ai < 2; ++ai) for (int bj = 0; bj < 2; ++bj) for (int m = 0; m < 4; ++m) for (int n = 0; n < 2; ++n) for (int e = 0; e < 4; ++e) {
                const int r = 128 * ai + 64 * wr + 16 * m + fr, c = Epi::PERM ? (128 * bj + 32 * wc + 8 * fq + 4 * n + e) : (128 * bj + 32 * wc + 16 * n + 4 * fq + e);
                acc[ai][bj][m][n][e] = C[r * 256 + c]; }
            E(acc, u, wr, wc, fr, fq); }
    }
}
#endif
}

struct Frame {
    LAS unsigned char* lds;
    int tid, lane, wave, G, bid;
};
constexpr int TBL_OFF = MISC_OFF - 256;
#ifdef EMU
__device__ __forceinline__ const float* inp(const Frame& F, int i) { return *(const float* const*)(F.lds + TBL_OFF + 8 * i); }
__device__ __forceinline__ float* xout(const Frame& F) { return *(float* const*)(F.lds + TBL_OFF + 8 * 27); }
__device__ __forceinline__ unsigned char* wsb(const Frame& F) { return *(unsigned char* const*)(F.lds + TBL_OFF + 8 * 28); }
#else
__device__ __forceinline__ const float* inp(const Frame& F, int i) { return (const float*)(*(GAS const float* const LAS*)(F.lds + TBL_OFF + 8 * i)); }
__device__ __forceinline__ float* xout(const Frame& F) { return (float*)(*(GAS float* const LAS*)(F.lds + TBL_OFF + 8 * 27)); }
__device__ __forceinline__ unsigned char* wsb(const Frame& F) { return (unsigned char*)(*(GAS unsigned char* const LAS*)(F.lds + TBL_OFF + 8 * 28)); }
#endif
__device__ __forceinline__ Frame relaunder(const Frame& F) { Frame G = F; LAUNDER(G.lane); LAUNDER_S(G.wave); LAUNDER_S(G.lds); G.tid = G.wave * 64 + G.lane; return G; }
template <class T> __device__ __forceinline__ T* wsp(const Frame& F, size_t off) { return (T*)(wsb(F) + off); }
__device__ __forceinline__ unsigned char* wlayer(const Frame& F, int l) { return wsb(F) + WS_W + (size_t)l * W_LAYER; }
__device__ __forceinline__ const float* modp(const Frame& F, int l, int chunk) { return (const float*)(wsb(F) + CTL_MOD_OFF) + (size_t)l * NB * 9216 + chunk * 1024; }
template <class T> __device__ __forceinline__ LAS T* ldsp(LAS unsigned char* base, int off) { return (LAS T*)(base + off); }

__device__ __forceinline__ void p0_item(const float* W, int ldw, int K, int src_col0, int ncols, bf16* WT, int dest_row0, LAS float* scr, int kb, int lane) {
    const int k0 = 64 * kb;
    float wv[32];
#pragma unroll
    for (int i = 0; i < 32; ++i) { const int kk = 2 * i + (lane >> 5), cc = lane & 31; wv[i] = cc < ncols ? W[(size_t)(k0 + kk) * ldw + src_col0 + cc] : 0.f; }
#pragma unroll
    for (int i = 0; i < 32; ++i) { const int kk = 2 * i + (lane >> 5), cc = lane & 31; scr[kk * 33 + cc] = wv[i]; }
    WAVE_LDS_FENCE();
    const int c = lane & 7;
#pragma unroll
    for (int j = 0; j < 4; ++j) { const int n = (lane >> 3) + 8 * j; const LAS float* s = scr + (8 * c) * 33 + n;
        u32x4 o; o.x = pk2(s[0], s[33]); o.y = pk2(s[66], s[99]); o.z = pk2(s[132], s[165]); o.w = pk2(s[198], s[231]);
        *(u32x4*)(WT + (size_t)(dest_row0 + n) * K + k0 + 8 * c) = o; }
    WAVE_LDS_FENCE();
}
constexpr int P0_ITEMS_L = 5632 + 2816 + 1920 + 1024 + 512 + 512;
__device__ __forceinline__ void ph_convert(Frame& F0, int lw, int first_wg) {
    Frame F = relaunder(F0);
    if (F.bid < first_wg) return;
    LAS float* scr = ldsp<float>(F.lds, F.wave * 16384);
    const int gw = (F.bid - first_wg) * NWAVES + F.wave, NGW = (F.G - first_wg) * NWAVES, lane = F.lane;
    for (int it = gw; it < P0_ITEMS_L; it += NGW) {
        const int l = lw; int r = it; unsigned char* wl = wlayer(F, l);
        if (r < 5632) { const int i = r / 2816, q = r % 2816, kb = q / 176, rb = q % 176, pn = rb >> 3, qq = rb & 7;
            const int sc0 = qq < 4 ? 128 * pn + 32 * qq : FF + 128 * pn + 32 * (qq - 4);
            p0_item(inp(F, 5) + (size_t)(l * 2 + i) * DM * (2 * FF), 2 * FF, DM, sc0, 32, (bf16*)(wl + W_FFIN + i * W_FFIN_SZ), 32 * rb, scr, kb, lane); continue; }
        r -= 5632;
        if (r < 2816) { const int i = r / 1408, q = r % 1408, kb = q / 32, rb = q % 32;
            p0_item(inp(F, 6) + (size_t)(l * 2 + i) * FF * DM, DM, FF, 32 * rb, 32, (bf16*)(wl + W_FFOUT + i * W_FFOUT_SZ), 32 * rb, scr, kb, lane); continue; }
        r -= 2816;
        if (r < 1920) { const int kb = r / 120, rb = r % 120; int nc = (RCOLS + MCOLS) - 32 * rb; nc = nc < 0 ? 0 : (nc > 32 ? 32 : nc);
            p0_item(inp(F, 7) + (size_t)l * DM * NIN, NIN, DM, 32 * rb, nc, (bf16*)(wl + W_MIXIN), 32 * rb, scr, kb, lane); continue; }
        r -= 1920;
        if (r < 1024) { const int kb = r / 64, rb = r % 64;
            p0_item(inp(F, 7) + (size_t)l * DM * NIN, NIN, DM, (RCOLS + MCOLS) + 32 * rb, 32, (bf16*)(wl + W_GATE), 32 * rb, scr, kb, lane); continue; }
        r -= 1024;
        if (r < 512) { const int j = r / 256, q = r % 256, kb = q / 32, rb = q % 32;
            p0_item(inp(F, 23 + j) + (size_t)l * 512 * DM, DM, 512, 32 * rb, 32, (bf16*)(wl + W_BR + j * W_BR_SZ), 32 * rb, scr, kb, lane); continue; }
        r -= 512;
        { const int kb = r / 32, rb = r % 32;
            p0_item(inp(F, 25) + (size_t)l * DM * DM, DM, DM, 32 * rb, 32, (bf16*)(wl + W_WOUT), 32 * rb, scr, kb, lane); }
    }
    for (int idx = (F.bid - first_wg) * 512 + F.tid; idx < 81920; idx += (F.G - first_wg) * 512) {
        const int l = lw; int r = idx; bf16* sm = (bf16*)(wlayer(F, l) + W_SMALL);
        if (r < 32768) { const int which = r >> 14, e = r & 16383, ch = e >> 5, j = e & 31;
            sm[(which ? W_SMALL_AUP : W_SMALL_WUP) / 2 + e] = (bf16)f2bf(inp(F, which ? 12 : 10)[(size_t)(l * 32 + j) * RW + ch]); }
        else { const int e = r - 32768, ch = e / 96, j = e % 96;
            sm[W_SMALL_GUP / 2 + e] = (bf16)f2bf(inp(F, 13)[(size_t)(l * 96 + j) * RW + ch]); }
    }
}
__device__ __forceinline__ void ph_mod(Frame& F0) {
    Frame F = relaunder(F0);
    const int lane = F.lane;
    float* mod = (float*)(wsb(F) + CTL_MOD_OFF);
    for (int it = F.bid; it < DEPTH * 144; it += F.G) {
        const int l = it / 144, cg = it % 144, c0 = 64 * cg + lane, k0 = 128 * F.wave;
        float acc[NB];
#pragma unroll
        for (int b = 0; b < NB; ++b) acc[b] = 0.f;
        for (int half = 0; half < 2; ++half) {
            float cb[NB];
#pragma unroll
            for (int b = 0; b < NB; ++b) cb[b] = siluf_(inp(F, 1)[b * DM + k0 + 64 * half + lane]);
            const float* wp = inp(F, 2) + ((size_t)l * DM + k0 + 64 * half) * 9216 + c0;
            float wv[64];
#pragma unroll
            for (int kk = 0; kk < 64; ++kk) wv[kk] = wp[(size_t)kk * 9216];
#pragma unroll
            for (int kk = 0; kk < 64; ++kk) {
#pragma unroll
                for (int b = 0; b < NB; ++b) acc[b] += wv[kk] * rdlane(cb[b], kk); }
        }
        LAS float* part = ldsp<float>(F.lds, F.wave * 16384 + 8448);
#pragma unroll
        for (int b = 0; b < NB; ++b) part[b * 64 + lane] = acc[b];
        lds_barrier();
        for (int o = F.tid; o < NB * 64; o += 512) { const int b = o >> 6, cc = o & 63; float s = inp(F, 3)[(size_t)l * 9216 + 64 * cg + cc];
#pragma unroll
            for (int ww = 0; ww < NWAVES; ++ww) s += *ldsp<float>(F.lds, ww * 16384 + 8448 + (b * 64 + cc) * 4);
            mod[((size_t)l * NB + b) * 9216 + 64 * cg + cc] = s; }
        lds_barrier();
    }
}

__device__ __forceinline__ float* rowsq16(const Frame& F) { return wsp<float>(F, WS_F + F_RSQ); }
__device__ __forceinline__ float row_rstd(const float* rsq, size_t m) {
    const f32x4* p = (const f32x4*)(rsq + m * 16); const f32x4 a = p[0], b = p[1], c = p[2], d = p[3];
    const float s = ((a[0] + a[1]) + (a[2] + a[3])) + ((b[0] + b[1]) + (b[2] + b[3])) + (((c[0] + c[1]) + (c[2] + c[3])) + ((d[0] + d[1]) + (d[2] + d[3])));
    return frsq(s * (1.0f / DM) + 1e-6f);
}
__device__ __forceinline__ void ph_prenorm(Frame& F0, const float* xin, const float* g, const float* sc) {
    Frame F = relaunder(F0);
    const int gw = F.bid * NWAVES + F.wave, NGW = F.G * NWAVES, lane = F.lane;
    bf16* XN = wsp<bf16>(F, WS_XN); float* rsq = rowsq16(F);
    f32x4 vn[4];
    if (gw < MTOK) {
#pragma unroll
        for (int j = 0; j < 4; ++j) vn[j] = *((const f32x4*)(xin + (size_t)gw * DM) + lane + 64 * j); }
    for (int m = gw; m < MTOK; m += NGW) {
        const int b = m / SEQ;
        f32x4 v[4]; float s = 0.f;
#pragma unroll
        for (int j = 0; j < 4; ++j) v[j] = vn[j];
        if (m + NGW < MTOK) {
#pragma unroll
            for (int j = 0; j < 4; ++j) vn[j] = *((const f32x4*)(xin + (size_t)(m + NGW) * DM) + lane + 64 * j); }
#pragma unroll
        for (int j = 0; j < 4; ++j) s += (v[j][0] * v[j][0] + v[j][1] * v[j][1]) + (v[j][2] * v[j][2] + v[j][3] * v[j][3]);
        s = wave_sum(s);
        if (lane < 16) rsq[(size_t)m * 16 + lane] = lane == 0 ? s : 0.f;
#pragma unroll
        for (int j = 0; j < 4; ++j) { const int c = 4 * lane + 256 * j; const f32x4 gg = *(const f32x4*)(g + c), s1 = *(const f32x4*)(sc + (size_t)b * 9216 + c);
            const f32x4 y = v[j] * gg * (s1 + 1.0f);
            u32x2 o; o.x = pk2(y[0], y[1]); o.y = pk2(y[2], y[3]); *(u32x2*)(XN + (size_t)m * DM + c) = o; }
    }
}
__device__ __forceinline__ void ph_finalnorm(Frame& F0, const float* g) {
    Frame F = relaunder(F0);
    const int gw = F.bid * NWAVES + F.wave, NGW = F.G * NWAVES, lane = F.lane;
    float* X = xout(F); const float* rsq = rowsq16(F);
    f32x4 vn[4]; float rn = 0.f;
    if (gw < MTOK) { rn = row_rstd(rsq, (size_t)gw);
#pragma unroll
        for (int j = 0; j < 4; ++j) vn[j] = *((const f32x4*)(X + (size_t)gw * DM) + lane + 64 * j); }
    for (int m = gw; m < MTOK; m += NGW) {
        f32x4 v[4]; const float rstd = rn;
#pragma unroll
        for (int j = 0; j < 4; ++j) v[j] = vn[j];
        if (m + NGW < MTOK) { rn = row_rstd(rsq, (size_t)(m + NGW));
#pragma unroll
            for (int j = 0; j < 4; ++j) vn[j] = *((const f32x4*)(X + (size_t)(m + NGW) * DM) + lane + 64 * j); }
#pragma unroll
        for (int j = 0; j < 4; ++j) { const f32x4 gg = *((const f32x4*)g + lane + 64 * j); *((f32x4*)(X + (size_t)m * DM) + lane + 64 * j) = v[j] * rstd * gg; }
    }
}
__device__ __forceinline__ void ph_bias(Frame& F0, int lb) {
    Frame F = relaunder(F0);
    const int gw = F.bid * NWAVES + F.wave, NGW = F.G * NWAVES, lane = F.lane;
    for (int i0 = F.bid * 512 + F.tid; i0 < 3 * NB * DM; i0 += F.G * 512) { const int i = lb * 3 * NB * DM + i0, c = i % DM, b = (i / DM) % NB, wch = (i / (DM * NB)) % 3, l = lb;
        wsp<float>(F, WS_F + F_CS)[i] = inp(F, 4)[(size_t)(l * 3 + wch) * DM + c] * (1.0f + modp(F, l, 3 * wch + 1)[(size_t)b * 9216 + c]); }
    constexpr int ROWS_L = 2 * (2 * FF) + PW + 2048;
    for (int it = gw; it < ROWS_L; it += NGW) {
        const int l = lb; int r = it; unsigned char* wl = wlayer(F, l);
        const bf16* wrow; const float* sh; float* out; int ldo;
        float* bl = wsp<float>(F, WS_F + F_BIAS) + (size_t)l * BIAS_LAYER;
        if (r < 2 * FF) { wrow = (const bf16*)(wl + W_FFIN) + (size_t)r * DM; sh = modp(F, l, 0); out = bl + r; ldo = 2 * FF; }
        else if (r < 4 * FF) { r -= 2 * FF; wrow = (const bf16*)(wl + W_FFIN + W_FFIN_SZ) + (size_t)r * DM; sh = modp(F, l, 6); out = bl + BIAS_FF + r; ldo = 2 * FF; }
        else if (r < 4 * FF + PW) { r -= 4 * FF; wrow = (const bf16*)(wl + W_MIXIN) + (size_t)r * DM; sh = modp(F, l, 3); out = bl + 2 * BIAS_FF + r; ldo = PW; }
        else { r -= 4 * FF + PW; wrow = (const bf16*)(wl + W_GATE) + (size_t)r * DM; sh = modp(F, l, 3); out = bl + 2 * BIAS_FF + BIAS_MIX + r; ldo = 2048; }
        const u32x4 w0 = *(const u32x4*)(wrow + 8 * lane), w1 = *(const u32x4*)(wrow + 512 + 8 * lane);
        float wf[16];
#pragma unroll
        for (int e = 0; e < 4; ++e) { wf[2 * e] = bf2f((bf16)(w0[e] & 0xffffu)); wf[2 * e + 1] = bf2f((bf16)(w0[e] >> 16)); wf[8 + 2 * e] = bf2f((bf16)(w1[e] & 0xffffu)); wf[8 + 2 * e + 1] = bf2f((bf16)(w1[e] >> 16)); }
#pragma unroll
        for (int b = 0; b < NB; ++b) { const float* sb = sh + (size_t)b * 9216; const f32x4 s0 = *(const f32x4*)(sb + 8 * lane), s1 = *(const f32x4*)(sb + 8 * lane + 4), s2 = *(const f32x4*)(sb + 512 + 8 * lane), s3 = *(const f32x4*)(sb + 512 + 8 * lane + 4);
            float acc = 0.f;
#pragma unroll
            for (int e = 0; e < 4; ++e) acc += wf[e] * s0[e] + wf[4 + e] * s1[e] + wf[8 + e] * s2[e] + wf[12 + e] * s3[e];
            acc = wave_sum(acc);
            if (lane == 0) out[(size_t)b * ldo] = acc; }
    }
}

struct EpiSwiglu {
    static constexpr bool PERM = true, AFTER_DRAIN = false; bf16* H; const float* rsq; const float* bias;
    __device__ __forceinline__ void operator()(const f32x4 (&acc)[2][2][4][2], const pg8::Unit& u, int wr, int wc, int fr, int fq) const {
        const int row0 = u.pm * 256 + wr * 64 + fr, col0 = u.pn * 128 + wc * 32 + 8 * fq, b = (u.pm * 256) / SEQ;
        const float* bp = bias + (size_t)b * (2 * FF) + u.pn * 256 + wc * 32 + 8 * fq;
        f32x4 bg[2], bu[2];
#pragma unroll
        for (int n = 0; n < 2; ++n) { bg[n] = *(const f32x4*)(bp + 4 * n); bu[n] = *(const f32x4*)(bp + 128 + 4 * n); }
#pragma unroll
        for (int ai = 0; ai < 2; ++ai)
#pragma unroll
            for (int m = 0; m < 4; ++m) { const size_t r = (size_t)(row0 + ai * 128 + m * 16); const float rstd = row_rstd(rsq, r); float hh[8];
#pragma unroll
                for (int n = 0; n < 2; ++n)
#pragma unroll
                    for (int e = 0; e < 4; ++e) hh[4 * n + e] = siluf_(acc[ai][0][m][n][e] * rstd + bg[n][e]) * (acc[ai][1][m][n][e] * rstd + bu[n][e]);
                u32x4 o; o.x = pk2(hh[0], hh[1]); o.y = pk2(hh[2], hh[3]); o.z = pk2(hh[4], hh[5]); o.w = pk2(hh[6], hh[7]);
                *(u32x4*)(H + r * FF + col0) = o; }
    }
};
template <bool HALF> struct EpiRes {
    static constexpr bool PERM = false, AFTER_DRAIN = false; const float* Xin; float* Xout; const float* gate; bf16* XS; const float* csn; float* rsq;
    __device__ __forceinline__ void operator()(const f32x4 (&acc)[2][2][4][2], const pg8::Unit& u, int wr, int wc, int fr, int fq) const {
        const int row0 = u.pm * 256 + wr * 64 + fr, col0 = u.pn * 256 + wc * 32 + 4 * fq, b = (u.pm * 256) / SEQ;
        f32x4 gv[2][2]; const float* csb = csn ? csn + (size_t)b * DM + col0 : nullptr;
#pragma unroll
        for (int bj = 0; bj < 2; ++bj)
#pragma unroll
            for (int n = 0; n < 2; ++n) { const int c = col0 + bj * 128 + n * 16; gv[bj][n] = (*(const f32x4*)(gate + (size_t)b * 9216 + c) + 1.0f) * (HALF ? 0.5f : 1.0f); }
        f32x4 xa[2][2], xb[2][2]; float ss[8];
#define EPIRES_LOAD(dst, g) { const size_t off_ = (size_t)(row0 + ((g) >> 2) * 128 + ((g) & 3) * 16) * DM + col0; _Pragma("unroll") for (int bj = 0; bj < 2; ++bj) _Pragma("unroll") for (int n = 0; n < 2; ++n) dst[bj][n] = *(const f32x4*)(Xin + off_ + bj * 128 + n * 16); }
#define EPIRES_DO(src, g) { const size_t off_ = (size_t)(row0 + ((g) >> 2) * 128 + ((g) & 3) * 16) * DM + col0; float s_ = 0.f; \
            _Pragma("unroll") for (int bj = 0; bj < 2; ++bj) _Pragma("unroll") for (int n = 0; n < 2; ++n) { const f32x4 x = src[bj][n] + gv[bj][n] * acc[(g) >> 2][bj][(g) & 3][n]; *(f32x4*)(Xout + off_ + bj * 128 + n * 16) = x; \
                s_ += (x[0] * x[0] + x[1] * x[1]) + (x[2] * x[2] + x[3] * x[3]); \
                if (csn) { const f32x4 y = x * *(const f32x4*)(csb + bj * 128 + n * 16); u32x2 o; o.x = pk2(y[0], y[1]); o.y = pk2(y[2], y[3]); *(u32x2*)(XS + off_ + bj * 128 + n * 16) = o; } } \
            ss[g] = s_; }
        EPIRES_LOAD(xa, 0) EMU_FENCE();
        EPIRES_LOAD(xb, 1) EMU_FENCE(); EPIRES_DO(xa, 0)
        EPIRES_LOAD(xa, 2) EMU_FENCE(); EPIRES_DO(xb, 1)
        EPIRES_LOAD(xb, 3) EMU_FENCE(); EPIRES_DO(xa, 2)
        EPIRES_LOAD(xa, 4) EMU_FENCE(); EPIRES_DO(xb, 3)
        EPIRES_LOAD(xb, 5) EMU_FENCE(); EPIRES_DO(xa, 4)
        EPIRES_LOAD(xa, 6) EMU_FENCE(); EPIRES_DO(xb, 5)
        EPIRES_LOAD(xb, 7) EMU_FENCE(); EPIRES_DO(xa, 6)
        EPIRES_DO(xb, 7)
#undef EPIRES_LOAD
#undef EPIRES_DO
#pragma unroll
        for (int g = 0; g < 8; ++g) { float* rp = rsq + (size_t)(row0 + (g >> 2) * 128 + (g & 3) * 16) * 16 + u.pn * 4 + wc;
#ifdef EMU
            if (fq == 0) *rp = ss[g]; else *rp += ss[g];
#else
            float s = ss[g]; s += __shfl_xor(s, 16); s += __shfl_xor(s, 32);
            if (fq == 0) *rp = s;
#endif
        }
    }
};
template <int MODE  > struct EpiBf {
    static constexpr bool PERM = true, AFTER_DRAIN = false; bf16* O; int ldo; const bf16* S1; int lds1; const float* rsq; const float* bias; int ldb;
    __device__ __forceinline__ void operator()(const f32x4 (&acc)[2][2][4][2], const pg8::Unit& u, int wr, int wc, int fr, int fq) const {
        const int row0 = u.pm * 256 + wr * 64 + fr, col0 = u.pn * 256 + wc * 32 + 8 * fq, b = (u.pm * 256) / SEQ;
        if (MODE <= 1) {
            f32x4 bv[2][2];
#pragma unroll
            for (int bj = 0; bj < 2; ++bj)
#pragma unroll
                for (int n = 0; n < 2; ++n) bv[bj][n] = *(const f32x4*)(bias + (size_t)b * ldb + col0 + bj * 128 + 4 * n);
#pragma unroll
            for (int ai = 0; ai < 2; ++ai)
#pragma unroll
                for (int m = 0; m < 4; ++m) { const size_t r = (size_t)(row0 + ai * 128 + m * 16); const float rstd = row_rstd(rsq, r);
#pragma unroll
                    for (int bj = 0; bj < 2; ++bj) { float v[8];
#pragma unroll
                        for (int n = 0; n < 2; ++n)
#pragma unroll
                            for (int e = 0; e < 4; ++e) { v[4 * n + e] = acc[ai][bj][m][n][e] * rstd + bv[bj][n][e]; if (MODE == 1) v[4 * n + e] = sigmoidf_(v[4 * n + e]); }
                        u32x4 w; w.x = pk2(v[0], v[1]); w.y = pk2(v[2], v[3]); w.z = pk2(v[4], v[5]); w.w = pk2(v[6], v[7]);
                        *(u32x4*)(O + r * ldo + col0 + bj * 128) = w; } }
        } else {
            u32x4 sa[2], sb[2], oa[2], ob[2];
#define EPIBF_LOAD(s_, o_, g) { const size_t r_ = (size_t)(row0 + ((g) >> 2) * 128 + ((g) & 3) * 16); _Pragma("unroll") for (int bj = 0; bj < 2; ++bj) { s_[bj] = *(const u32x4*)(S1 + r_ * lds1 + col0 + bj * 128); \
                if (MODE == 3) o_[bj] = *(const u32x4*)(O + r_ * ldo + col0 + bj * 128); } }
#define EPIBF_DO(s_, o_, g) { const size_t r_ = (size_t)(row0 + ((g) >> 2) * 128 + ((g) & 3) * 16); _Pragma("unroll") for (int bj = 0; bj < 2; ++bj) { float v[8]; \
                _Pragma("unroll") for (int n = 0; n < 2; ++n) _Pragma("unroll") for (int e = 0; e < 4; ++e) v[4 * n + e] = acc[(g) >> 2][bj][(g) & 3][n][e]; \
                _Pragma("unroll") for (int e = 0; e < 4; ++e) { v[2 * e] *= bf2f((bf16)(s_[bj][e] & 0xffffu)); v[2 * e + 1] *= bf2f((bf16)(s_[bj][e] >> 16)); } \
                if (MODE == 3) { _Pragma("unroll") for (int e = 0; e < 4; ++e) { v[2 * e] += bf2f((bf16)(o_[bj][e] & 0xffffu)); v[2 * e + 1] += bf2f((bf16)(o_[bj][e] >> 16)); } } \
                u32x4 w; w.x = pk2(v[0], v[1]); w.y = pk2(v[2], v[3]); w.z = pk2(v[4], v[5]); w.w = pk2(v[6], v[7]); *(u32x4*)(O + r_ * ldo + col0 + bj * 128) = w; } }
            EPIBF_LOAD(sa, oa, 0) EMU_FENCE();
            EPIBF_LOAD(sb, ob, 1) EMU_FENCE(); EPIBF_DO(sa, oa, 0)
            EPIBF_LOAD(sa, oa, 2) EMU_FENCE(); EPIBF_DO(sb, ob, 1)
            EPIBF_LOAD(sb, ob, 3) EMU_FENCE(); EPIBF_DO(sa, oa, 2)
            EPIBF_LOAD(sa, oa, 4) EMU_FENCE(); EPIBF_DO(sb, ob, 3)
            EPIBF_LOAD(sb, ob, 5) EMU_FENCE(); EPIBF_DO(sa, oa, 4)
            EPIBF_LOAD(sa, oa, 6) EMU_FENCE(); EPIBF_DO(sb, ob, 5)
            EPIBF_LOAD(sb, ob, 7) EMU_FENCE(); EPIBF_DO(sa, oa, 6)
            EPIBF_DO(sb, ob, 7)
#undef EPIBF_LOAD
#undef EPIBF_DO
        }
    }
};

constexpr int RP = 72, RBUF = 64 * RP * 2;
constexpr int L4_AT = 0, L4_RT = RBUF, L4_BT = 2 * RBUF, L4_KT = 3 * RBUF, L4_KH = 4 * RBUF, L4_AC = 5 * RBUF, L4_BC = 6 * RBUF, L4_VC = 7 * RBUF;
constexpr int L4_NM = 8 * RBUF, L4_PT = 9 * RBUF, L4_MF = 10 * RBUF  , L4_TOT = L4_MF + 64 * 68 * 4  , L4_GCX = L4_TOT + 2048  , L4_XS = L4_GCX + 256  ;
constexpr int L4_WR = 8 * RBUF  , L4_AP = L4_WR + 64 * 65 * 4, L4_LORA = L4_AT;
constexpr int L4_TT = L4_AT, L4_WM = L4_BT, L4_NTM = L4_KT, L4_HT = L4_NM, L4_FT = L4_AC;
constexpr int L4_TL = L4_BT;
static_assert(L4_AP + 64 * 65 * 4 <= L4_TOT && L4_XS + 3 * 16 * 17 * 4 <= MISC_OFF - 256 && 64 * 68 * 4 <= 2 * RBUF, "RWKV LDS map");

__device__ __forceinline__ bf16x8 ldfrag(const LAS unsigned char* base, int off, int row, int col) { return *(const LAS bf16x8*)(base + off + (row * RP + col) * 2); }
__device__ __forceinline__ void st4bf(LAS unsigned char* base, int off, int row, int col, f32x4 v) { u32x2 o; o.x = pk2(v[0], v[1]); o.y = pk2(v[2], v[3]); *(LAS u32x2*)(base + off + (row * RP + col) * 2) = o; }
__device__ __forceinline__ void st4bf_g(bf16* p, f32x4 v) { u32x2 o; o.x = pk2(v[0], v[1]); o.y = pk2(v[2], v[3]); *(u32x2*)p = o; }
__device__ __forceinline__ f32x4 ld4bf_g(const bf16* p) { const u32x2 o = *(const u32x2*)p; return (f32x4){bf2f((bf16)(o.x & 0xffffu)), bf2f((bf16)(o.x >> 16)), bf2f((bf16)(o.y & 0xffffu)), bf2f((bf16)(o.y >> 16))}; }

struct PrepRaw { bf16 x[4][9]; float mu[4]; float prm[5]; bf16x8 bw[2], ba[2]; };
__device__ __forceinline__ void rwkv_prep_fetch(const Frame& F, int l, int item, PrepRaw& R) {
    const int c = item % NC1, bh = item / NC1, h = bh % RH, b = bh / RH;
    const int lane = F.lane, w = F.wave, l15 = lane & 15, q = lane >> 4, cb0 = 2 * (w & 1), t0 = 8 * w, ch = h * 64 + lane;
    const size_t m0 = (size_t)b * SEQ + (size_t)c * 64;
    const bf16* P = wsp<bf16>(F, WS_R);
    if (c * 64 + t0 > 0) { const bf16* row = P + (m0 + t0 - 1) * PW; R.x[0][0] = row[PC_R + ch]; R.x[1][0] = row[PC_K + ch]; R.x[2][0] = row[PC_V + ch]; R.x[3][0] = row[PC_LORA + lane]; }
    else { R.x[0][0] = 0; R.x[1][0] = 0; R.x[2][0] = 0; R.x[3][0] = 0; }
#pragma unroll
    for (int i = 0; i < 8; ++i) { const bf16* row = P + (m0 + t0 + i) * PW; R.x[0][1 + i] = row[PC_R + ch]; R.x[1][1 + i] = row[PC_K + ch]; R.x[2][1 + i] = row[PC_V + ch]; R.x[3][1 + i] = row[PC_LORA + lane]; }
    const float* mu = inp(F, 8) + (size_t)l * RCOLS;
    R.mu[0] = mu[PC_R + ch]; R.mu[1] = mu[PC_K + ch]; R.mu[2] = mu[PC_V + ch]; R.mu[3] = mu[PC_LORA + lane];
    R.prm[0] = inp(F, 9)[(size_t)l * RW + ch]; R.prm[1] = inp(F, 11)[(size_t)l * RW + ch]; R.prm[2] = inp(F, 14)[(size_t)l * RW + ch]; R.prm[3] = inp(F, 15)[(size_t)l * RW + ch]; R.prm[4] = inp(F, 16)[(size_t)l * RW + ch];
    const bf16* sm = (const bf16*)(wlayer(F, l) + W_SMALL);
#pragma unroll
    for (int cbi = 0; cbi < 2; ++cbi) { const int kc = 16 * (cb0 + cbi) + l15;
        R.bw[cbi] = *(const bf16x8*)(sm + W_SMALL_WUP / 2 + (size_t)(h * 64 + kc) * 32 + 8 * q); R.ba[cbi] = *(const bf16x8*)(sm + W_SMALL_AUP / 2 + (size_t)(h * 64 + kc) * 32 + 8 * q); }
}
__device__ __forceinline__ void rwkv_prep_item(Frame& F0, int l, int item, PrepRaw& raw, int next_item) {
    Frame F = relaunder(F0);
    const int c = item % NC1, bh = item / NC1, h = bh % RH, b = bh / RH;
    const int lane = F.lane, w = F.wave, l15 = lane & 15, q = lane >> 4, rb = w >> 1, cb0 = 2 * (w & 1), t0 = 8 * w;
    const size_t m0 = (size_t)b * SEQ + (size_t)c * 64;
    LAS unsigned char* L = F.lds;
    const f32x4 z4 = (f32x4){0.f, 0.f, 0.f, 0.f};
    LAUNDER_S(L);
    PSEC_B(21)
    float rs[8], ks[8], vs[8];
#pragma unroll
    for (int i = 0; i < 8; ++i) {
        const float xr = bf2f(raw.x[0][1 + i]), xk = bf2f(raw.x[1][1 + i]), xv = bf2f(raw.x[2][1 + i]), xl = bf2f(raw.x[3][1 + i]);
        rs[i] = xr + (bf2f(raw.x[0][i]) - xr) * raw.mu[0]; ks[i] = xk + (bf2f(raw.x[1][i]) - xk) * raw.mu[1]; vs[i] = xv + (bf2f(raw.x[2][i]) - xv) * raw.mu[2];
        const float ls = xl + (bf2f(raw.x[3][i]) - xl) * raw.mu[3];
        *ldsp<bf16>(L, L4_LORA + ((t0 + i) * RP + lane) * 2) = (bf16)f2bf(lane < 32 ? tanhf_(ls) : ls); }
    const float w0 = raw.prm[0], a0 = raw.prm[1], kkw = raw.prm[2], kaw = raw.prm[3], rkw = raw.prm[4];
    const bf16x8 bw0 = raw.bw[0], bw1 = raw.bw[1], ba0 = raw.ba[0], ba1 = raw.ba[1];
    if (next_item >= 0) rwkv_prep_fetch(F, l, next_item, raw);
    lds_barrier();
    LAUNDER_S(L);
    PSEC_E(F, 21)
    PSEC_B(22)
    {
        const bf16x8 aw = ldfrag(L, L4_LORA, 16 * rb + l15, 8 * q), aa = ldfrag(L, L4_LORA, 16 * rb + l15, 32 + 8 * q);
#pragma unroll
        for (int cbi = 0; cbi < 2; ++cbi) { const int kc = 16 * (cb0 + cbi) + l15;
            const f32x4 cw = mfma16(aw, cbi ? bw1 : bw0, z4), ca = mfma16(aa, cbi ? ba1 : ba0, z4);
#pragma unroll
            for (int r = 0; r < 4; ++r) { *ldsp<float>(L, L4_WR + ((16 * rb + 4 * q + r) * 65 + kc) * 4) = cw[r]; *ldsp<float>(L, L4_AP + ((16 * rb + 4 * q + r) * 65 + kc) * 4) = ca[r]; } }
    }
    lds_barrier();
    LAUNDER_S(L);
    PSEC_E(F, 22)
    PSEC_B(23)
    float ar[8], br[8], k2[8], ld[8], gin[8];
    {
        float cs = 0.f;
#pragma unroll
        for (int i = 0; i < 8; ++i) { const int t = t0 + i;
            const float wraw = w0 + *ldsp<float>(L, L4_WR + (t * 65 + lane) * 4);
            const float wl = -softplusf_(-wraw) - 0.5f; ld[i] = -fexp(wl);
            const float a = sigmoidf_(a0 + *ldsp<float>(L, L4_AP + (t * 65 + lane) * 4));
            float kk = ks[i] * kkw; const float nrm = fsqrt(wave_sum(kk * kk)); kk = kk * frcp(fmaxf(nrm, 1e-12f));
            k2[i] = ks[i] * (1.0f + (a - 1.0f) * kaw);
            const float rho = wave_sum(rs[i] * k2[i] * rkw);
            if (lane == 0) wsp<float>(F, WS_F + F_RHO)[(m0 + t) * 8 + h] = rho;
            ar[i] = -kk; br[i] = kk * a; cs += ld[i]; gin[i] = cs; }
        *ldsp<float>(L, L4_TOT + (w * 64 + lane) * 4) = cs;
    }
    lds_barrier();
    LAUNDER_S(L);
    PSEC_E(F, 23)
    PSEC_B(24)
    {
        float pre = 0.f, gC = 0.f;
#pragma unroll
        for (int ww = 0; ww < 8; ++ww) { const float tv = *ldsp<float>(L, L4_TOT + (ww * 64 + lane) * 4); gC += tv; if (ww < w) pre += tv; }
        if (w == 0) *ldsp<float>(L, L4_GCX + lane * 4) = fexp(gC);
        float acv[8], bcv[8];
#pragma unroll
        for (int i = 0; i < 8; ++i) { const int t = t0 + i; const float gi = pre + gin[i], ge = gi - ld[i];
            const float e_gi = fexp(gi), e_ngi = fexp(-gi), e_ge = fexp(ge), e_c = fexp(gC - gi);
            const float at = ar[i] * e_ge; acv[i] = at; bcv[i] = br[i] * e_c;
            *ldsp<bf16>(L, L4_AT + (t * RP + lane) * 2) = (bf16)f2bf(at);
            *ldsp<bf16>(L, L4_RT + (t * RP + lane) * 2) = (bf16)f2bf(rs[i] * e_gi);
            *ldsp<bf16>(L, L4_BT + (t * RP + lane) * 2) = (bf16)f2bf(br[i] * e_ngi);
            *ldsp<bf16>(L, L4_KT + (t * RP + lane) * 2) = (bf16)f2bf(k2[i] * e_ngi);
            *ldsp<bf16>(L, L4_KH + (t * RP + lane) * 2) = (bf16)f2bf(k2[i] * e_c); }
        u32x4 o;
        o.x = pk2(acv[0], acv[1]); o.y = pk2(acv[2], acv[3]); o.z = pk2(acv[4], acv[5]); o.w = pk2(acv[6], acv[7]); *ldsp<u32x4>(L, L4_AC + (lane * RP + t0) * 2) = o;
        o.x = pk2(bcv[0], bcv[1]); o.y = pk2(bcv[2], bcv[3]); o.z = pk2(bcv[4], bcv[5]); o.w = pk2(bcv[6], bcv[7]); *ldsp<u32x4>(L, L4_BC + (lane * RP + t0) * 2) = o;
        o.x = pk2(vs[0], vs[1]); o.y = pk2(vs[2], vs[3]); o.z = pk2(vs[4], vs[5]); o.w = pk2(vs[6], vs[7]); *ldsp<u32x4>(L, L4_VC + (lane * RP + t0) * 2) = o;
    }
    lds_barrier();
    LAUNDER_S(L);
    PSEC_E(F, 24)
    PSEC_B(25)
    f32x4 qreg[2];
    {
        bf16x8 aA[2], aB[2], aK[2];
#pragma unroll
        for (int s = 0; s < 2; ++s) { aA[s] = ldfrag(L, L4_AT, 16 * rb + l15, 32 * s + 8 * q); aB[s] = ldfrag(L, L4_BT, 16 * rb + l15, 32 * s + 8 * q); aK[s] = ldfrag(L, L4_KT, 16 * rb + l15, 32 * s + 8 * q); }
#pragma unroll
        for (int cbi = 0; cbi < 2; ++cbi) { const int cb = cb0 + cbi, cc = 16 * cb + l15, r0 = 16 * rb + 4 * q;
            f32x4 cm = z4, cn = z4, cp = z4, cq = z4;
#pragma unroll
            for (int s = 0; s < 2; ++s) { const bf16x8 bB = ldfrag(L, L4_BT, cc, 32 * s + 8 * q), bK = ldfrag(L, L4_KT, cc, 32 * s + 8 * q), bR = ldfrag(L, L4_RT, cc, 32 * s + 8 * q);
                cm = mfma16(aA[s], bB, cm); cn = mfma16(aA[s], bK, cn); cp = mfma16(aB[s], bR, cp); cq = mfma16(aK[s], bR, cq); }
#pragma unroll
            for (int r = 0; r < 4; ++r) { const int rr = r0 + r;
                if (!(cc < rr)) { cm[r] = 0.f; cn[r] = 0.f; }
                if (!(rr <= cc)) { cp[r] = 0.f; cq[r] = 0.f; } }
            *ldsp<f32x4>(L, L4_MF + (cc * 68 + r0) * 4) = cm;
            st4bf(L, L4_NM, cc, r0, cn);
            st4bf(L, L4_PT, cc, r0, cp);
            qreg[cbi] = cq; }
    }
    lds_barrier();
    LAUNDER_S(L);
    PSEC_E(F, 25)
    PSEC_B(26)
    if (w == 0) {
        int lnq = lane; LAUNDER(lnq);
        const int I16 = 16 * (lnq >> 4), tt = lnq & 15;
        float acc[16];
#pragma unroll
        for (int r = 0; r < 16; ++r) acc[r] = (r == tt) ? 1.0f : 0.0f;
#pragma unroll
        for (int r = 14; r >= 0; --r) {
#pragma unroll
            for (int g = (r + 1) >> 2; g < 4; ++g) { const f32x4 m4 = *ldsp<f32x4>(L, L4_MF + ((I16 + r) * 68 + I16 + 4 * g) * 4);
#pragma unroll
                for (int e = 0; e < 4; ++e) if (4 * g + e > r) acc[r] += m4[e] * acc[4 * g + e]; } }
#pragma unroll
        for (int r = 0; r < 16; ++r) *ldsp<float>(L, L4_TL + ((I16 + r) * 68 + I16 + tt) * 4) = acc[r];
    }
    lds_barrier();
    LAUNDER_S(L);
#pragma unroll
    for (int dd = 1; dd < 4; ++dd) {
        if (w < 4 - dd) { const int I16 = 16 * w, J16 = 16 * (w + dd);
            f32x4 x = z4;
            for (int K16 = I16; K16 < J16; K16 += 16) {
#pragma unroll
                for (int s = 0; s < 4; ++s) x = mfma4f(*ldsp<float>(L, L4_TL + ((I16 + l15) * 68 + K16 + 4 * s + q) * 4), *ldsp<float>(L, L4_MF + ((K16 + 4 * s + q) * 68 + J16 + l15) * 4), x); }
#pragma unroll
            for (int r = 0; r < 4; ++r) *ldsp<float>(L, L4_XS + (w * 272 + (4 * q + r) * 17 + l15) * 4) = x[r];
            WAVE_LDS_FENCE();
            f32x4 y = z4;
#pragma unroll
            for (int s = 0; s < 4; ++s) y = mfma4f(*ldsp<float>(L, L4_XS + (w * 272 + l15 * 17 + 4 * s + q) * 4), *ldsp<float>(L, L4_TL + ((J16 + 4 * s + q) * 68 + J16 + l15) * 4), y);
#pragma unroll
            for (int r = 0; r < 4; ++r) *ldsp<float>(L, L4_TL + ((I16 + 4 * q + r) * 68 + J16 + l15) * 4) = y[r];
        }
        lds_barrier();
    }
    {
        const int t = F.tid >> 3, g = F.tid & 7; float tv[8];
#pragma unroll
        for (int e = 0; e < 8; ++e) { const int j = 8 * g + e; tv[e] = (j >> 4) <= (t >> 4) ? *ldsp<float>(L, L4_TL + (j * 68 + t) * 4) : 0.0f; }
        u32x4 o; o.x = pk2(tv[0], tv[1]); o.y = pk2(tv[2], tv[3]); o.z = pk2(tv[4], tv[5]); o.w = pk2(tv[6], tv[7]);
        *ldsp<u32x4>(L, L4_TT + (t * RP + 8 * g) * 2) = o;
    }
    lds_barrier();
    LAUNDER_S(L);
    PSEC_E(F, 26)
    PSEC_B(27)
    {
        bf16x8 aT[2];
#pragma unroll
        for (int s = 0; s < 2; ++s) aT[s] = ldfrag(L, L4_TT, 16 * rb + l15, 32 * s + 8 * q);
#pragma unroll
        for (int cbi = 0; cbi < 2; ++cbi) { const int cc = 16 * (cb0 + cbi) + l15, r0 = 16 * rb + 4 * q; f32x4 cw = z4, cn = z4;
#pragma unroll
            for (int s = 0; s < 2; ++s) { cw = mfma16(aT[s], ldfrag(L, L4_AC, cc, 32 * s + 8 * q), cw); cn = mfma16(aT[s], ldfrag(L, L4_NM, cc, 32 * s + 8 * q), cn); }
            st4bf(L, L4_WM, cc, r0, cw); st4bf(L, L4_NTM, cc, r0, cn); }
    }
    lds_barrier();
    LAUNDER_S(L);
    PSEC_E(F, 27)
    PSEC_B(28)
    const size_t slot = (size_t)c * (NB * RH) + bh;
    bf16* GT = wsp<bf16>(F, WS_F + F_GV + slot * 16384); bf16* VH = GT + 4096;
    bf16* ET = wsp<bf16>(F, WS_F + F_EV + slot * 16384); bf16* VFT = ET + 4096;
    {
        bf16x8 aW[2], aN[2];
#pragma unroll
        for (int s = 0; s < 2; ++s) { aW[s] = ldfrag(L, L4_WM, 16 * rb + l15, 32 * s + 8 * q); aN[s] = ldfrag(L, L4_NTM, 16 * rb + l15, 32 * s + 8 * q); }
#pragma unroll
        for (int cbi = 0; cbi < 2; ++cbi) { const int cc = 16 * (cb0 + cbi) + l15, r0 = 16 * rb + 4 * q; f32x4 cg = z4, ce = z4, chh = z4, cf = qreg[cbi];
#pragma unroll
            for (int s = 0; s < 2; ++s) { const bf16x8 bB = ldfrag(L, L4_BC, cc, 32 * s + 8 * q), bP = ldfrag(L, L4_PT, cc, 32 * s + 8 * q);
                cg = mfma16(aW[s], bB, cg); ce = mfma16(aW[s], bP, ce); chh = mfma16(aN[s], bB, chh); cf = mfma16(aN[s], bP, cf); }
#pragma unroll
            for (int r = 0; r < 4; ++r) { if (r0 + r == cc) cg[r] += *ldsp<float>(L, L4_GCX + cc * 4);
                chh[r] += bf2f(*ldsp<bf16>(L, L4_KH + ((r0 + r) * RP + cc) * 2)); }
            const u32x2 rt = *ldsp<u32x2>(L, L4_RT + (cc * RP + r0) * 2);
            ce[0] += bf2f((bf16)(rt.x & 0xffffu)); ce[1] += bf2f((bf16)(rt.x >> 16)); ce[2] += bf2f((bf16)(rt.y & 0xffffu)); ce[3] += bf2f((bf16)(rt.y >> 16));
            st4bf_g(GT + cc * 64 + 32 * (rb >> 1) + 8 * q + 4 * (rb & 1), cg);
            st4bf_g(ET + cc * 64 + r0, ce);
            st4bf(L, L4_HT, cc, r0, chh);
            st4bf(L, L4_FT, cc, r0, cf); }
    }
    lds_barrier();
    LAUNDER_S(L);
    PSEC_E(F, 28)
    PSEC_B(29)
    {
#pragma unroll
        for (int cbi = 0; cbi < 2; ++cbi) { const int cc = 16 * (cb0 + cbi) + l15, r0 = 16 * rb + 4 * q; f32x4 c1 = z4, c2 = z4;
#pragma unroll
            for (int s = 0; s < 2; ++s) { c1 = mfma16(ldfrag(L, L4_HT, 16 * rb + l15, 32 * s + 8 * q), ldfrag(L, L4_VC, cc, 32 * s + 8 * q), c1);
                c2 = mfma16(ldfrag(L, L4_VC, 16 * rb + l15, 32 * s + 8 * q), ldfrag(L, L4_FT, cc, 32 * s + 8 * q), c2); }
            st4bf_g(VH + cc * 64 + r0, c1); st4bf_g(VFT + cc * 64 + r0, c2); }
    }
    lds_barrier();
    PSEC_E(F, 29)
}

constexpr int L5_G = 0, L5_GBUF = 65536, SCG = 8;
static_assert(NC1 % SCG == 0, "scan groups of eight chunks");
__device__ __forceinline__ void scan_fetch_group(const Frame& F, const bf16* gbase  , size_t CS, int buf, u32x2 (&vhN)[SCG][4], int offV, bool consumer) {
    const int lane = F.lane, w = F.wave;
#pragma unroll
    for (int i = 0; i < SCG; ++i) {
        const int g = 64 * w + lane, r = g >> 3, c16 = (g & 7) ^ (r & 7);
        glds16((const char*)(gbase + (size_t)i * CS) + r * 128 + c16 * 16, F.lds + L5_G + buf * L5_GBUF + i * 8192 + w * 1024); }
    if (consumer) {
#pragma unroll
        for (int i = 0; i < SCG; ++i) { const char* gV = (const char*)(gbase + (size_t)i * CS) + 8192 + offV;
#pragma unroll
            for (int mt = 0; mt < 4; ++mt) vhN[i][mt] = *(const u32x2*)(gV + mt * 32); } }
}
__device__ __forceinline__ void scan_step(const Frame& F, int buf, int i, const u32x2 (&vh)[4], bf16* it, f32x4 (&st)[4], int offV, int l15, int q) {
    u32x4 b0, b1;
    b0.x = pk2(st[0][0], st[0][1]); b0.y = pk2(st[0][2], st[0][3]); b0.z = pk2(st[1][0], st[1][1]); b0.w = pk2(st[1][2], st[1][3]);
    b1.x = pk2(st[2][0], st[2][1]); b1.y = pk2(st[2][2], st[2][3]); b1.z = pk2(st[3][0], st[3][1]); b1.w = pk2(st[3][2], st[3][3]);
    char* sp = (char*)it + 8192 + offV;
    *(u32x2*)(sp) = (u32x2){b0.x, b0.y}; *(u32x2*)(sp + 32) = (u32x2){b0.z, b0.w}; *(u32x2*)(sp + 64) = (u32x2){b1.x, b1.y}; *(u32x2*)(sp + 96) = (u32x2){b1.z, b1.w};
    const bf16x8 f0 = __builtin_bit_cast(bf16x8, b0), f1 = __builtin_bit_cast(bf16x8, b1);
    const LAS unsigned char* G = F.lds + L5_G + buf * L5_GBUF + i * 8192;
#pragma unroll
    for (int mt = 0; mt < 4; ++mt) { const int r = 16 * mt + l15;
        f32x4 acc = (f32x4){bf2f((bf16)(vh[mt].x & 0xffffu)), bf2f((bf16)(vh[mt].x >> 16)), bf2f((bf16)(vh[mt].y & 0xffffu)), bf2f((bf16)(vh[mt].y >> 16))};
        acc = mfma16(*(const LAS bf16x8*)(G + (r * 8 + ((q) ^ (r & 7))) * 16), f0, acc);
        acc = mfma16(*(const LAS bf16x8*)(G + (r * 8 + ((4 + q) ^ (r & 7))) * 16), f1, acc);
        st[mt] = acc; }
}
__device__ __forceinline__ void rwkv_scan_bh(Frame& F0, int bh) {
    Frame F = relaunder(F0);
    const int lane = F.lane, vb = F.wave, l15 = lane & 15, q = lane >> 4;
    const bool consumer = vb < 4;
    const f32x4 z4 = (f32x4){0.f, 0.f, 0.f, 0.f};
    f32x4 st[4] = {z4, z4, z4, z4};
    bf16* base = wsp<bf16>(F, WS_F + F_GV + (size_t)bh * 16384); constexpr size_t CS = (size_t)NB * RH * 8192;
    int offV = ((16 * (vb & 3) + l15) * 64 + 4 * q) * 2;
    u32x2 vh[SCG][4], vhN[SCG][4];
#pragma unroll
    for (int i = 0; i < SCG; ++i)
#pragma unroll
        for (int mt = 0; mt < 4; ++mt) vhN[i][mt] = (u32x2){0u, 0u};
    scan_fetch_group(F, base, CS, 0, vhN, offV, consumer);
    vm_lds_barrier();
    for (int g = 0; g < NC1 / SCG; ++g) {
        LAUNDER(offV);
        bf16* gb = base + (size_t)g * SCG * CS;
#pragma unroll
        for (int i = 0; i < SCG; ++i)
#pragma unroll
            for (int mt = 0; mt < 4; ++mt) vh[i][mt] = vhN[i][mt];
        if (g + 1 < NC1 / SCG) scan_fetch_group(F, gb + (size_t)SCG * CS, CS, (g + 1) & 1, vhN, offV, consumer);
        if (consumer) {
#pragma unroll
            for (int i = 0; i < SCG; ++i) scan_step(F, g & 1, i, vh[i], gb + (size_t)i * CS, st, offV, l15, q); }
        vm_lds_barrier();
    }
}

constexpr int L6_SG = 0  , L6_YL = 64 * 104 * 2  , L6_GL = L6_YL + 64 * 68 * 4;
struct OutRaw { bf16 v[9], g0[9], g1[9]; float mu[3], ln[2], rho[8]; bf16x8 aS[2], aG[3], bE[2][2]; u32x2 vf[2]; };
__device__ __forceinline__ void rwkv_out_fetch(const Frame& F, int l, int item, OutRaw& R) {
    const int c = item % NC1, bh = item / NC1, h = bh % RH, b = bh / RH;
    const int lane = F.lane, w = F.wave, l15 = lane & 15, q = lane >> 4, rb = w >> 1, cb0 = 2 * (w & 1), t0 = 8 * w, ch = h * 64 + lane;
    const size_t m0 = (size_t)b * SEQ + (size_t)c * 64;
    const bf16* P = wsp<bf16>(F, WS_R);
    R.v[0] = 0; R.g0[0] = 0; R.g1[0] = 0;
    if (c * 64 + t0 > 0) { const bf16* row = P + (m0 + t0 - 1) * PW; R.v[0] = row[PC_V + ch]; R.g0[0] = row[PC_GLO + lane]; if (lane < 32) R.g1[0] = row[PC_GLO + 64 + lane]; }
#pragma unroll
    for (int i = 0; i < 8; ++i) { const bf16* row = P + (m0 + t0 + i) * PW; R.v[1 + i] = row[PC_V + ch]; R.g0[1 + i] = row[PC_GLO + lane]; R.g1[1 + i] = 0; if (lane < 32) R.g1[1 + i] = row[PC_GLO + 64 + lane]; }
    const float* mu = inp(F, 8) + (size_t)l * RCOLS;
    R.mu[0] = mu[PC_V + ch]; R.mu[1] = mu[PC_GLO + lane]; R.mu[2] = lane < 32 ? mu[PC_GLO + 64 + lane] : 0.f;
    R.ln[0] = inp(F, 17)[(size_t)l * RW + ch]; R.ln[1] = inp(F, 18)[(size_t)l * RW + ch];
#pragma unroll
    for (int i = 0; i < 8; ++i) R.rho[i] = wsp<float>(F, WS_F + F_RHO)[(m0 + t0 + i) * 8 + h];
    const size_t slot = (size_t)c * (NB * RH) + bh;
    const bf16* Sc = wsp<bf16>(F, WS_F + F_GV + slot * 16384) + 4096;
    const bf16* ET = wsp<bf16>(F, WS_F + F_EV + slot * 16384); const bf16* VFT = ET + 4096;
    const bf16* gup = (const bf16*)(wlayer(F, l) + W_SMALL + W_SMALL_GUP) + (size_t)(h * 64) * 96;
#pragma unroll
    for (int s = 0; s < 2; ++s) R.aS[s] = *(const bf16x8*)(Sc + (16 * rb + l15) * 64 + 32 * s + 8 * q);
#pragma unroll
    for (int s = 0; s < 3; ++s) R.aG[s] = *(const bf16x8*)(gup + (16 * rb + l15) * 96 + 32 * s + 8 * q);
#pragma unroll
    for (int cbi = 0; cbi < 2; ++cbi) { const int tt = 16 * (cb0 + cbi) + l15;
#pragma unroll
        for (int s = 0; s < 2; ++s) R.bE[cbi][s] = *(const bf16x8*)(ET + tt * 64 + 32 * s + 8 * q);
        R.vf[cbi] = *(const u32x2*)(VFT + tt * 64 + 16 * rb + 4 * q); }
}
__device__ __forceinline__ void rwkv_out_item(Frame& F0, int l, int item, OutRaw& raw, int next_item) {
    Frame F = relaunder(F0);
    const int c = item % NC1, bh = item / NC1, h = bh % RH, b = bh / RH;
    const int lane = F.lane, w = F.wave, l15 = lane & 15, q = lane >> 4, rb = w >> 1, cb0 = 2 * (w & 1), t0 = 8 * w;
    const size_t m0 = (size_t)b * SEQ + (size_t)c * 64;
    bf16* P = wsp<bf16>(F, WS_R);
    LAS unsigned char* L = F.lds;
    const int ch = h * 64 + lane;
    LAUNDER_S(L);
    float vs[8];
#pragma unroll
    for (int i = 0; i < 8; ++i) { const float xv = bf2f(raw.v[1 + i]), x0 = bf2f(raw.g0[1 + i]), x1 = bf2f(raw.g1[1 + i]);
        vs[i] = xv + (bf2f(raw.v[i]) - xv) * raw.mu[0];
        *ldsp<bf16>(L, L6_SG + ((t0 + i) * 104 + lane) * 2) = (bf16)f2bf(sigmoidf_(x0 + (bf2f(raw.g0[i]) - x0) * raw.mu[1]));
        if (lane < 32) *ldsp<bf16>(L, L6_SG + ((t0 + i) * 104 + 64 + lane) * 2) = (bf16)f2bf(sigmoidf_(x1 + (bf2f(raw.g1[i]) - x1) * raw.mu[2])); }
    const float lng = raw.ln[0], lnb = raw.ln[1];
    float rho[8];
#pragma unroll
    for (int i = 0; i < 8; ++i) rho[i] = raw.rho[i];
    const bf16x8 aS0 = raw.aS[0], aS1 = raw.aS[1], aG0 = raw.aG[0], aG1 = raw.aG[1], aG2 = raw.aG[2], bE00 = raw.bE[0][0], bE01 = raw.bE[0][1], bE10 = raw.bE[1][0], bE11 = raw.bE[1][1];
    const u32x2 vf0 = raw.vf[0], vf1 = raw.vf[1];
    if (next_item >= 0) rwkv_out_fetch(F, l, next_item, raw);
    lds_barrier();
    LAUNDER_S(L);
#pragma unroll
    for (int cbi = 0; cbi < 2; ++cbi) { const int tt = 16 * (cb0 + cbi) + l15, v0 = 16 * rb + 4 * q; const u32x2 vf = cbi ? vf1 : vf0;
        f32x4 cy = (f32x4){bf2f((bf16)(vf.x & 0xffffu)), bf2f((bf16)(vf.x >> 16)), bf2f((bf16)(vf.y & 0xffffu)), bf2f((bf16)(vf.y >> 16))}, cg = (f32x4){0.f, 0.f, 0.f, 0.f};
        cy = mfma16(aS0, cbi ? bE10 : bE00, cy); cy = mfma16(aS1, cbi ? bE11 : bE01, cy);
        cg = mfma16(aG0, *(const LAS bf16x8*)(L + L6_SG + (tt * 104 + 8 * q) * 2), cg);
        cg = mfma16(aG1, *(const LAS bf16x8*)(L + L6_SG + (tt * 104 + 32 + 8 * q) * 2), cg);
        cg = mfma16(aG2, *(const LAS bf16x8*)(L + L6_SG + (tt * 104 + 64 + 8 * q) * 2), cg);
        *ldsp<f32x4>(L, L6_YL + (tt * 68 + v0) * 4) = cy; *ldsp<f32x4>(L, L6_GL + (tt * 68 + v0) * 4) = cg; }
    lds_barrier();
    LAUNDER_S(L);
#pragma unroll
    for (int i = 0; i < 8; ++i) { const int t = t0 + i; const float y = *ldsp<float>(L, L6_YL + (t * 68 + lane) * 4);
        const float mean = wave_sum(y) * (1.0f / 64.0f), d = y - mean, var = wave_sum(d * d) * (1.0f / 64.0f);
        const float yn = d * frsq(var + 64e-5f) * lng + lnb;
        const float o = (yn + rho[i] * vs[i]) * *ldsp<float>(L, L6_GL + (t * 68 + lane) * 4);
        P[(m0 + t) * PW + ch] = (bf16)f2bf(o); }
    lds_barrier();
}

constexpr int MP = 136, MBUF = 128 * MP * 2;
constexpr int LM_A = 0, LM_B = MBUF, LM_C = 2 * MBUF, LM_D = 3 * MBUF, LM_S = 4 * MBUF;
static_assert(LM_S + 8 * 512 <= MISC_OFF - 256, "mLSTM LDS map");
__device__ __forceinline__ bf16x8 ldfragm(const LAS unsigned char* base, int off, int row, int col) { return *(const LAS bf16x8*)(base + off + (row * MP + col) * 2); }
__device__ __forceinline__ float logsigmoidf_(float x) { return -softplusf_(-x); }
__device__ __forceinline__ float wave_scan_add(float v, int lane) {
#pragma unroll
    for (int o = 1; o < 64; o <<= 1) { const float t = __shfl_up(v, o); if (lane >= o) v += t; }
    return v;
}
__device__ __forceinline__ float wave_scan_max(float v, int lane) {
#pragma unroll
    for (int o = 1; o < 64; o <<= 1) { const float t = __shfl_up(v, o); if (lane >= o) v = fmaxf(v, t); }
    return v;
}
__device__ __forceinline__ float wave_max(float v) {
#pragma unroll
    for (int o = 1; o < 64; o <<= 1) v = fmaxf(v, __shfl_xor(v, o));
    return v;
}

template <int MODE> __device__ __forceinline__ void mlstm_gates(const Frame& F, int l, int b, int h, int c, float mprev) {
    LAS unsigned char* L = F.lds; const bf16* P = wsp<bf16>(F, WS_R); const int lane = F.lane;
    const bf16* row = P + ((size_t)b * SEQ + (size_t)c * 128 + 2 * lane) * PW;
    const float bi = inp(F, 21)[l * 8 + h], bf = inp(F, 21)[l * 8 + 4 + h];
    const float i0 = bf2f(row[PC_MI + h]) + bi, i1 = bf2f(row[PW + PC_MI + h]) + bi;
    const float f0 = logsigmoidf_(bf2f(row[PC_MF + h]) + bf), f1 = logsigmoidf_(bf2f(row[PW + PC_MF + h]) + bf);
    const float p = f0 + f1, incl = wave_scan_add(p, lane), b0 = incl - p + f0, b1 = incl;
    if (MODE == 1) {
        const float bend = rdlane(incl, 63), g0 = bend - b0 + i0, g1 = bend - b1 + i1, mloc = wave_max(fmaxf(g0, g1));
        *ldsp<f32x2>(L, LM_S + 3 * 512 + lane * 8) = (f32x2){fexp(g0 - mloc), fexp(g1 - mloc)};
        if (lane == 0) *ldsp<f32x2>(L, LM_S + 7 * 512) = (f32x2){mloc, bend};
    } else {
        const float u0 = i0 - b0, u1 = i1 - b1, um = fmaxf(u0, u1), mi = wave_scan_max(um, lane);
        float ex = __shfl_up(mi, 1); if (lane == 0) ex = -INFINITY;
        const float mx0 = fmaxf(mprev, fmaxf(ex, u0)), mx1 = fmaxf(mprev, mi);
        *ldsp<f32x2>(L, LM_S + 3 * 512 + lane * 8) = (f32x2){u0, u1};
        *ldsp<f32x2>(L, LM_S + 4 * 512 + lane * 8) = (f32x2){-mx0, -mx1};
        *ldsp<f32x2>(L, LM_S + 5 * 512 + lane * 8) = (f32x2){fexp(mprev - mx0), fexp(mprev - mx1)};
        *ldsp<f32x2>(L, LM_S + 6 * 512 + lane * 8) = (f32x2){fexp(-(b0 + mx0)), fexp(-(b1 + mx1))};
    }
}
__device__ __forceinline__ void mlstm_conv_load(const Frame& F, size_t mrow0, int tseq0, int chq, bf16 (&raw)[35]) {
    const bf16* P = wsp<bf16>(F, WS_R) + PC_MQ + chq;
    if (tseq0 >= 3) { raw[0] = P[(mrow0 - 3) * PW]; raw[1] = P[(mrow0 - 2) * PW]; raw[2] = P[(mrow0 - 1) * PW]; } else { raw[0] = 0; raw[1] = 0; raw[2] = 0; }
#pragma unroll
    for (int i = 0; i < 32; ++i) raw[3 + i] = P[(mrow0 + i) * PW];
}
__device__ __forceinline__ void mlstm_conv_apply(const Frame& F, int l, int chq, const bf16 (&raw)[35], float (&out)[32]) {
    const float w0 = inp(F, 19)[(size_t)(l * 4 + 0) * 1024 + chq], w1 = inp(F, 19)[(size_t)(l * 4 + 1) * 1024 + chq], w2 = inp(F, 19)[(size_t)(l * 4 + 2) * 1024 + chq], w3 = inp(F, 19)[(size_t)(l * 4 + 3) * 1024 + chq], cb = inp(F, 20)[(size_t)l * 1024 + chq];
    float x0 = bf2f(raw[0]), x1 = bf2f(raw[1]), x2 = bf2f(raw[2]);
#pragma unroll
    for (int i = 0; i < 32; ++i) { const float x3 = bf2f(raw[3 + i]); out[i] = siluf_(w0 * x0 + w1 * x1 + w2 * x2 + w3 * x3 + cb); x0 = x1; x1 = x2; x2 = x3; }
}
__device__ __forceinline__ void mlstm_m1_item(Frame& F0, int l, int item) {
    Frame F = relaunder(F0);
    const int c = item % NC2, bh = item / NC2, h = bh % MH, b = bh / MH;
    const int lane = F.lane, w = F.wave, l15 = lane & 15, q = lane >> 4;
    LAS unsigned char* L = F.lds; const bf16* P = wsp<bf16>(F, WS_R);
    const size_t m0 = (size_t)b * SEQ + (size_t)c * 128;
    LAUNDER_S(L);
    const int d = lane + 64 * (w & 1), tg = w >> 1, tb = 32 * tg;
    bf16 kraw[35], vraw[32];
    mlstm_conv_load(F, m0 + tb, c * 128 + tb, 512 + h * 128 + d, kraw);
#pragma unroll
    for (int i = 0; i < 32; ++i) vraw[i] = P[(m0 + tb + i) * PW + PC_MV + h * 128 + d];
    if (w == 0) mlstm_gates<1>(F, l, b, h, c, 0.f);
    lds_barrier();
    LAUNDER_S(L);
    const f32x2 msc = *ldsp<f32x2>(L, LM_S + 7 * 512);
    float kc[32]; mlstm_conv_apply(F, l, 512 + h * 128 + d, kraw, kc);
    float ksum = 0.f;
#pragma unroll
    for (int i = 0; i < 32; ++i) { kc[i] *= *ldsp<float>(L, LM_S + 3 * 512 + (tb + i) * 4); ksum += kc[i]; }
    lds_barrier();
    {
#pragma unroll
        for (int g = 0; g < 4; ++g) { u32x4 o; o.x = pk2(kc[8 * g], kc[8 * g + 1]); o.y = pk2(kc[8 * g + 2], kc[8 * g + 3]); o.z = pk2(kc[8 * g + 4], kc[8 * g + 5]); o.w = pk2(kc[8 * g + 6], kc[8 * g + 7]);
            *ldsp<u32x4>(L, LM_A + (d * MP + tb + 8 * g) * 2) = o; }
        *ldsp<float>(L, LM_S + 4 * 512 + tg * 512 + d * 4) = ksum;
#pragma unroll
        for (int g = 0; g < 4; ++g) { u32x4 o; o.x = (unsigned)vraw[8 * g] | ((unsigned)vraw[8 * g + 1] << 16); o.y = (unsigned)vraw[8 * g + 2] | ((unsigned)vraw[8 * g + 3] << 16);
            o.z = (unsigned)vraw[8 * g + 4] | ((unsigned)vraw[8 * g + 5] << 16); o.w = (unsigned)vraw[8 * g + 6] | ((unsigned)vraw[8 * g + 7] << 16);
            *ldsp<u32x4>(L, LM_B + (d * MP + tb + 8 * g) * 2) = o; }
    }
    lds_barrier();
    LAUNDER_S(L);
    bf16* KVT = wsp<bf16>(F, WS_F + F_MC + (size_t)item * 65536);
    {
        f32x4 acc[8];
#pragma unroll
        for (int et = 0; et < 8; ++et) acc[et] = (f32x4){0.f, 0.f, 0.f, 0.f};
#pragma unroll
        for (int s = 0; s < 4; ++s) { const bf16x8 a = ldfragm(L, LM_A, 16 * w + l15, 32 * s + 8 * q);
#pragma unroll
            for (int et = 0; et < 8; ++et) acc[et] = mfma16(a, ldfragm(L, LM_B, 16 * et + l15, 32 * s + 8 * q), acc[et]); }
#pragma unroll
        for (int et = 0; et < 8; ++et) st4bf_g(KVT + (size_t)(16 * et + l15) * 128 + 16 * w + 4 * q, acc[et]);
    }
    if (F.tid < 128) { float s = 0.f;
#pragma unroll
        for (int g = 0; g < 4; ++g) s += *ldsp<float>(L, LM_S + 4 * 512 + g * 512 + F.tid * 4);
        wsp<float>(F, WS_F + F_KS)[(size_t)item * 128 + F.tid] = s; }
    if (F.tid == 0) { float* mscg = wsp<float>(F, WS_F + F_MSC) + (size_t)item * 4; mscg[0] = msc[0]; mscg[1] = msc[1]; }
    lds_barrier();
}
__device__ __forceinline__ void mlstm_m2(Frame& F0, int first_wg) {
    Frame F = relaunder(F0);
    const int nW = F.G - first_wg; if (F.bid < first_wg || nW <= 0) return;
    const int per = 4096 + 32;
    for (int idx = (F.bid - first_wg) * 512 + F.tid; idx < NB * MH * per; idx += nW * 512) {
        const int bh = idx / per, e4 = idx % per;
        float* msc = wsp<float>(F, WS_F + F_MSC) + (size_t)bh * NC2 * 4;
        f32x2 sc[NC2];
#pragma unroll
        for (int c = 0; c < NC2; ++c) sc[c] = *(const f32x2*)(msc + c * 4);
        float m = -INFINITY; f32x4 st = (f32x4){0.f, 0.f, 0.f, 0.f};
        if (e4 < 4096) {
            bf16* p = wsp<bf16>(F, WS_F + F_MC + (size_t)bh * NC2 * 65536) + 4 * e4;
            u32x2 kvr[NC2];
#pragma unroll
            for (int c = 0; c < NC2; ++c) kvr[c] = *(const u32x2*)(p + (size_t)c * 32768);
#pragma unroll
            for (int c = 0; c < NC2; ++c) { const f32x4 kv = (f32x4){bf2f((bf16)(kvr[c].x & 0xffffu)), bf2f((bf16)(kvr[c].x >> 16)), bf2f((bf16)(kvr[c].y & 0xffffu)), bf2f((bf16)(kvr[c].y >> 16))};
                st4bf_g(p + (size_t)c * 32768 + 16384, st);
                if (e4 == 0) msc[c * 4 + 2] = m;
                const float mn = fmaxf(sc[c][1] + m, sc[c][0]), keep = fexp(sc[c][1] + m - mn), w2 = fexp(sc[c][0] - mn);
                st = st * keep + kv * w2; m = mn; }
        } else {
            f32x4* p = (f32x4*)(wsp<float>(F, WS_F + F_KS) + (size_t)bh * NC2 * 128) + (e4 - 4096);
            constexpr int HB = NC2 < 16 ? NC2 : 16;
#pragma unroll
            for (int c0 = 0; c0 < NC2; c0 += HB) { f32x4 kvr[HB];
#pragma unroll
                for (int c = 0; c < HB; ++c) kvr[c] = p[(c0 + c) * 32];
#pragma unroll
                for (int c = 0; c < HB; ++c) { p[(c0 + c) * 32] = st;
                    const float mn = fmaxf(sc[c0 + c][1] + m, sc[c0 + c][0]), keep = fexp(sc[c0 + c][1] + m - mn), w2 = fexp(sc[c0 + c][0] - mn);
                    st = st * keep + kvr[c] * w2; m = mn; } }
        }
    }
}
__device__ __forceinline__ void mlstm_m3_item(Frame& F0, int l, int item) {
    Frame F = relaunder(F0);
    const int c = item % NC2, bh = item / NC2, h = bh % MH, b = bh / MH;
    const int lane = F.lane, w = F.wave, l15 = lane & 15, q = lane >> 4;
    LAS unsigned char* L = F.lds; bf16* P = wsp<bf16>(F, WS_R);
    const size_t m0 = (size_t)b * SEQ + (size_t)c * 128;
    LAUNDER_S(L);
    const int d = lane + 64 * (w & 1), tg = w >> 1, tb = 32 * tg;
    bf16 qraw[35], kraw[35], vraw[32];
    mlstm_conv_load(F, m0 + tb, c * 128 + tb, h * 128 + d, qraw);
    mlstm_conv_load(F, m0 + tb, c * 128 + tb, 512 + h * 128 + d, kraw);
#pragma unroll
    for (int i = 0; i < 32; ++i) vraw[i] = P[(m0 + tb + i) * PW + PC_MV + h * 128 + d];
    if (w == 0) mlstm_gates<3>(F, l, b, h, c, wsp<float>(F, WS_F + F_MSC)[(size_t)item * 4 + 2]);
    {
        float cv[32];
        mlstm_conv_apply(F, l, h * 128 + d, qraw, cv);
#pragma unroll
        for (int i = 0; i < 32; ++i) *ldsp<bf16>(L, LM_A + ((tb + i) * MP + d) * 2) = (bf16)f2bf(cv[i] * 0.08838834764831845f);
        mlstm_conv_apply(F, l, 512 + h * 128 + d, kraw, cv);
#pragma unroll
        for (int i = 0; i < 32; ++i) *ldsp<bf16>(L, LM_B + ((tb + i) * MP + d) * 2) = (bf16)f2bf(cv[i]);
#pragma unroll
        for (int g = 0; g < 4; ++g) { u32x4 o; o.x = (unsigned)vraw[8 * g] | ((unsigned)vraw[8 * g + 1] << 16); o.y = (unsigned)vraw[8 * g + 2] | ((unsigned)vraw[8 * g + 3] << 16);
            o.z = (unsigned)vraw[8 * g + 4] | ((unsigned)vraw[8 * g + 5] << 16); o.w = (unsigned)vraw[8 * g + 6] | ((unsigned)vraw[8 * g + 7] << 16);
            *ldsp<u32x4>(L, LM_C + (d * MP + tb + 8 * g) * 2) = o; }
    }
    lds_barrier();
    LAUNDER_S(L);
    const int lq = 16 * w + l15;
    f32x4 a1[9], a2[9];
#pragma unroll
    for (int et = 0; et < 9; ++et) { a1[et] = (f32x4){0.f, 0.f, 0.f, 0.f}; a2[et] = (f32x4){0.f, 0.f, 0.f, 0.f}; }
    {
        const bf16* CP = wsp<bf16>(F, WS_F + F_MC + (size_t)item * 65536) + 16384 + (size_t)l15 * 128 + 8 * q; const float* NP = wsp<float>(F, WS_F + F_KS) + (size_t)item * 128;
        bf16x8 ca[8], cb[8];
#pragma unroll
        for (int et = 0; et < 8; ++et) ca[et] = *(const bf16x8*)(CP + (size_t)et * 2048);
#pragma unroll
        for (int s = 0; s < 4; ++s) {
            if (s < 3) {
#pragma unroll
                for (int et = 0; et < 8; ++et) { if (s & 1) ca[et] = *(const bf16x8*)(CP + (size_t)et * 2048 + 32 * (s + 1)); else cb[et] = *(const bf16x8*)(CP + (size_t)et * 2048 + 32 * (s + 1)); } }
            EMU_FENCE();
            const bf16x8 bq = ldfragm(L, LM_A, lq, 32 * s + 8 * q);
#pragma unroll
            for (int et = 0; et < 8; ++et) a2[et] = mfma16((s & 1) ? cb[et] : ca[et], bq, a2[et]);
            const float* np = NP + 32 * s + 8 * q; const f32x4 n0 = *(const f32x4*)np, n1 = *(const f32x4*)(np + 4);
            u32x4 o; o.x = pk2(n0[0], n0[1]); o.y = pk2(n0[2], n0[3]); o.z = pk2(n1[0], n1[1]); o.w = pk2(n1[2], n1[3]);
            if (l15 != 0) o = (u32x4){0u, 0u, 0u, 0u};
            a2[8] = mfma16(__builtin_bit_cast(bf16x8, o), bq, a2[8]); }
    }
    {
        bf16x8 bq[4];
#pragma unroll
        for (int s = 0; s < 4; ++s) bq[s] = ldfragm(L, LM_A, lq, 32 * s + 8 * q);
        const float al = *ldsp<float>(L, LM_S + 4 * 512 + lq * 4);
        const int nsb = 2 * (w >> 1) + 2;
        for (int sb = 0; sb < nsb; ++sb) { f32x4 acc = (f32x4){0.f, 0.f, 0.f, 0.f};
            if (sb <= w) {
#pragma unroll
                for (int s = 0; s < 4; ++s) acc = mfma16(ldfragm(L, LM_B, 16 * sb + l15, 32 * s + 8 * q), bq[s], acc);
#pragma unroll
                for (int r = 0; r < 4; ++r) { const int ss = 16 * sb + 4 * q + r; acc[r] = ss <= lq ? acc[r] * fexp(al + *ldsp<float>(L, LM_S + 3 * 512 + ss * 4)) : 0.f; } }
            u32x2 o; o.x = pk2(acc[0], acc[1]); o.y = pk2(acc[2], acc[3]); *ldsp<u32x2>(L, LM_D + (lq * MP + 16 * sb + 4 * q) * 2) = o; }
    }
    WAVE_LDS_FENCE();
    LAUNDER_S(L);
    {
        const int ns = (w >> 1) + 1;
        for (int s = 0; s < ns; ++s) { const bf16x8 bs = ldfragm(L, LM_D, lq, 32 * s + 8 * q);
#pragma unroll
            for (int et = 0; et < 8; ++et) a1[et] = mfma16(ldfragm(L, LM_C, 16 * et + l15, 32 * s + 8 * q), bs, a1[et]);
            const short one = l15 == 0 ? (short)0x3F80 : (short)0; const bf16x8 ones = (bf16x8){one, one, one, one, one, one, one, one};
            a1[8] = mfma16(ones, bs, a1[8]); }
    }
    {
        const float inter = *ldsp<float>(L, LM_S + 5 * 512 + lq * 4), emt = *ldsp<float>(L, LM_S + 6 * 512 + lq * 4);
        const float den = __shfl(a1[8][0] + inter * a2[8][0], l15);
        const float rden = frcp(fmaxf(fabsf(den), emt));
        float s1 = 0.f;
#pragma unroll
        for (int et = 0; et < 8; ++et) { a1[et] = (a1[et] + a2[et] * inter) * rden; s1 += (a1[et][0] + a1[et][1]) + (a1[et][2] + a1[et][3]); }
        s1 += __shfl_xor(s1, 16); s1 += __shfl_xor(s1, 32);
        const float mean = s1 * (1.0f / 128.0f); float s2 = 0.f;
#pragma unroll
        for (int et = 0; et < 8; ++et) { a1[et] = a1[et] - mean; s2 += (a1[et][0] * a1[et][0] + a1[et][1] * a1[et][1]) + (a1[et][2] * a1[et][2] + a1[et][3] * a1[et][3]); }
        s2 += __shfl_xor(s2, 16); s2 += __shfl_xor(s2, 32);
        const float rstd = frsq(s2 * (1.0f / 128.0f) + 1e-5f);
        bf16* prow = P + (m0 + lq) * PW;
#pragma unroll
        for (int et = 0; et < 8; ++et) { const int e = 16 * et + 4 * q; const f32x4 lg = *(const f32x4*)(inp(F, 22) + (size_t)l * MW + h * 128 + e);
            const f32x4 og = ld4bf_g(prow + PC_MO + h * 128 + e); f32x4 o;
#pragma unroll
            for (int r = 0; r < 4; ++r) o[r] = sigmoidf_(og[r]) * (a1[et][r] * rstd * lg[r]);
            st4bf_g(prow + 512 + h * 128 + e, o); }
    }
    lds_barrier();
}

constexpr int NSTAGES = 2 + 10 * DEPTH + 1;
#ifndef PG8_SP2
#define PG8_SP2 true
#endif
#ifndef PG8_ALIGN
#define PG8_ALIGN true
#endif
__device__ __forceinline__ void run_stage(Frame& F0, int s) {
    Frame F = F0; LAUNDER(F.lane); LAUNDER_S(F.wave); LAUNDER_S(F.bid); LAUNDER_S(F.G); F.tid = F.wave * 64 + F.lane;
    int r = -1, l = 0;
    if (s >= 2 && s < NSTAGES - 1) { r = (s - 2) % 10; l = (s - 2) / 10; }
    unsigned char* wl = wlayer(F, l);
    bf16* XN = wsp<bf16>(F, WS_XN); bf16* R = wsp<bf16>(F, WS_R);
    float* bl = wsp<float>(F, WS_F + F_BIAS) + (size_t)l * BIAS_LAYER;
    if (s == 0) { ph_mod(F); ph_convert(F, 0, 0); return; }
    if (s == 1) { ph_prenorm(F, inp(F, 0), inp(F, 4), modp(F, 0, 1)); ph_bias(F, 0); return; }
    if (s == NSTAGES - 1) { ph_finalnorm(F, inp(F, 26)); return; }
    if (r == 0 || r == 8) {
        const int i = r == 0 ? 0 : 1;
        pg8::Gemm g{XN, (const bf16*)(wl + W_FFIN + i * W_FFIN_SZ), MTOK, 2 * FF, DM, DM}; pg8::StaticOrder S; S.init(MTOK, 2 * FF, F.G, F.bid);
        EpiSwiglu E{R, rowsq16(F), bl + i * BIAS_FF};
        pg8::gemm_phase<EpiSwiglu, pg8::StaticOrder, PG8_ALIGN, PG8_SP2>(F.lds, g, S, E); return;
    }
    if (r == 1 || r == 9 || r == 7) {
        const int i = r == 1 ? 0 : 1; const bool ffn = r != 7;
        const int nl = r == 9 ? l + 1 : l, nw = r == 1 ? 1 : (r == 7 ? 2 : 0);
        const bool has_next = nl < DEPTH;
        const bf16* Ap = ffn ? (const bf16*)R : (const bf16*)wsp<bf16>(F, WS_F + F_GV); const bf16* Bp = (const bf16*)(wl + (ffn ? W_FFOUT + i * W_FFOUT_SZ : W_WOUT)); const int Kd = ffn ? FF : DM;
        pg8::Gemm g{Ap, Bp, MTOK, DM, Kd, Kd}; pg8::StaticOrder S; S.init(MTOK, DM, F.G, F.bid);
        const float* xin = (l == 0 && r == 1) ? inp(F, 0) : (const float*)xout(F); float* xo = xout(F); const float* gt = modp(F, l, r == 1 ? 2 : (r == 7 ? 5 : 8));
        const float* csp = has_next ? wsp<float>(F, WS_F + F_CS) + (size_t)(nl * 3 + nw) * NB * DM : nullptr; float* rq = rowsq16(F);
        if (ffn) { EpiRes<true> E; E.Xin = xin; E.Xout = xo; E.gate = gt; E.XS = XN; E.csn = csp; E.rsq = rq;
            pg8::gemm_phase<EpiRes<true>, pg8::StaticOrder, false, PG8_SP2>(F.lds, g, S, E); }
        else { EpiRes<false> E; E.Xin = xin; E.Xout = xo; E.gate = gt; E.XS = XN; E.csn = csp; E.rsq = rq;
            pg8::gemm_phase<EpiRes<false>, pg8::StaticOrder, false, PG8_SP2>(F.lds, g, S, E); }
        return;
    }
    if (r == 2) {
        pg8::Gemm g{XN, (const bf16*)(wl + W_MIXIN), MTOK, PW, DM, DM}; pg8::StaticOrder S; S.init(MTOK, PW, F.G, F.bid);
        EpiBf<0> E{R, PW, nullptr, 0, rowsq16(F), bl + 2 * BIAS_FF, PW};
        pg8::gemm_phase<EpiBf<0>, pg8::StaticOrder, PG8_ALIGN, PG8_SP2>(F.lds, g, S, E); return;
    }
    if (r == 3) {
        { PSEC_B(1) PrepRaw raw; if (F.bid < NIT1) rwkv_prep_fetch(F, l, F.bid, raw);
          for (int it = F.bid; it < NIT1; it += F.G) rwkv_prep_item(F, l, it, raw, it + F.G < NIT1 ? it + F.G : -1); PSEC_E(F, 1) }
        { PSEC_B(2) for (int it = F.bid; it < NIT2; it += F.G) mlstm_m1_item(F, l, it); PSEC_E(F, 2) }
        return;
    }
    if (r == 4) {
        { PSEC_B(5) for (int bh = F.bid; bh < NB * RH; bh += F.G) rwkv_scan_bh(F, bh); PSEC_E(F, 5) }
        { PSEC_B(8) mlstm_m2(F, F.G > NB * RH ? NB * RH : 0); PSEC_E(F, 8) }
        if (l + 1 < DEPTH) ph_convert(F, l + 1, F.G > NB * RH ? NB * RH : 0);
        return;
    }
    if (r == 5) {
        if (l + 1 < DEPTH) ph_bias(F, l + 1);
        { PSEC_B(3) OutRaw oraw; if (F.bid < NIT1) rwkv_out_fetch(F, l, F.bid, oraw);
          for (int it = F.bid; it < NIT1; it += F.G) rwkv_out_item(F, l, it, oraw, it + F.G < NIT1 ? it + F.G : -1); PSEC_E(F, 3) }
        { PSEC_B(4) for (int it = F.bid; it < NIT2; it += F.G) mlstm_m3_item(F, l, it); PSEC_E(F, 4) }
        return;
    }
    if (r == 6) {
        bf16* SG = wsp<bf16>(F, WS_F + F_EV); bf16* TU = wsp<bf16>(F, WS_F + F_GV);
        { pg8::Gemm g{XN, (const bf16*)(wl + W_GATE), MTOK, 2048, DM, DM}; pg8::GateOrder S; S.init(MTOK, F.G, F.bid);
          EpiBf<1> E{SG, 2048, nullptr, 0, rowsq16(F), bl + 2 * BIAS_FF + BIAS_MIX, 2048};
          pg8::gemm_phase<EpiBf<1>, pg8::GateOrder, PG8_ALIGN, PG8_SP2>(F.lds, g, S, E); }
        { pg8::Gemm g{R, (const bf16*)(wl + W_BR), MTOK, DM, 512, PW}; pg8::StaticOrder S; S.init(MTOK, DM, F.G, F.bid);
          EpiBf<2> E{TU, DM, SG, 2048, nullptr, nullptr, 0};
          pg8::gemm_phase<EpiBf<2>, pg8::StaticOrder, false, PG8_SP2>(F.lds, g, S, E); }
        { pg8::Gemm g{R + 512, (const bf16*)(wl + W_BR + W_BR_SZ), MTOK, DM, 512, PW}; pg8::StaticOrder S; S.init(MTOK, DM, F.G, F.bid);
          EpiBf<3> E{TU, DM, SG + 1024, 2048, nullptr, nullptr, 0};
          pg8::gemm_phase<EpiBf<3>, pg8::StaticOrder, false, PG8_SP2>(F.lds, g, S, E); }
        return;
    }
}

struct Args { const float* in[27]; float* out; unsigned char* ws; int s_lo, s_hi; };

#ifndef EMU
#define XB_TMO      128
#define XB_XCNT(j)  (256  + 64 * (j))
#define XB_XSUB(j)  (1280 + 64 * (j))
#define XB_XGEN(j)  (2304 + 64 * (j))
#define XB_TOP      3328
#define XB_TOPGEN   3392
#define XCD_BAR_WORDS 3456
#define XB_SPIN_CAP (1u << 18)
#ifndef XB_POLL_SLEEP
#define XB_POLL_SLEEP 2
#endif

__device__ __forceinline__ unsigned xb_ld(unsigned* p)              { return __hip_atomic_load(p, __ATOMIC_RELAXED, __HIP_MEMORY_SCOPE_AGENT); }
__device__ __forceinline__ unsigned xb_add(unsigned* p, unsigned v) { return __hip_atomic_fetch_add(p, v, __ATOMIC_RELAXED, __HIP_MEMORY_SCOPE_AGENT); }
__device__ __forceinline__ unsigned xb_xcc_id() { return (unsigned)__builtin_amdgcn_s_getreg((3 << 11) | 20) & 0xFu; }
#define XB_SPIN(cond, bar) do { unsigned _sp = 0; while (cond) { __builtin_amdgcn_s_sleep(XB_POLL_SLEEP); \
    if ((++_sp & 255u) == 0u) { if (xb_ld(&(bar)[XB_TMO])) break; if (_sp > XB_SPIN_CAP) { atomicAdd(&(bar)[XB_TMO], 1u); break; } } } } while (0)

struct XcdBarrier {
    unsigned* bar; unsigned x;
    volatile LAS unsigned* st;
};

__device__ __forceinline__ XcdBarrier xcd_barrier_post(unsigned* bar, volatile LAS unsigned* st) {
    XcdBarrier b; b.bar = bar; b.x = xb_xcc_id(); b.st = st;
    if (threadIdx.x == 0) (void)xb_add(&bar[XB_XCNT(b.x)], 1u);
    return b;
}
__device__ __forceinline__ void xcd_barrier_complete(unsigned* bar, unsigned x, unsigned& nloc, unsigned& nx) {
    const unsigned G = gridDim.x * gridDim.y * gridDim.z;
    unsigned sum, cnt, mine, sp = 0u;
    for (;;) {
        sum = 0u; cnt = 0u; mine = 0u;
#pragma unroll
        for (unsigned j = 0; j < 16; ++j) { const unsigned c = xb_ld(&bar[XB_XCNT(j)]); sum += c; cnt += (c > 0u) ? 1u : 0u; mine = (j == x) ? c : mine; }
        if (sum == G) break;
        __builtin_amdgcn_s_sleep(1);
        if ((++sp & 255u) == 0u) { if (xb_ld(&bar[XB_TMO])) break; if (sp > XB_SPIN_CAP) { atomicAdd(&bar[XB_TMO], 1u); break; } }
    }
    nloc = mine > 0u ? mine : 1u; nx = cnt > 0u ? cnt : 1u;
}

__device__ __forceinline__ void xcd_barrier(const XcdBarrier& b) {
    asm volatile("s_waitcnt vmcnt(0)" ::: "memory");
    __syncthreads();
    if (threadIdx.x == 0) {
        unsigned* bar = b.bar;
        __builtin_amdgcn_s_waitcnt(0);
        unsigned nloc = b.st[0], nx = b.st[1];
        if (nloc == 0u) { xcd_barrier_complete(bar, b.x, nloc, nx); b.st[0] = nloc; b.st[1] = nx; }
        const unsigned old = xb_add(&bar[XB_XSUB(b.x)], 1u);
        const unsigned gen = old / nloc;
        if (old + 1u == (gen + 1u) * nloc) {
            __builtin_amdgcn_fence(__ATOMIC_RELEASE, "agent");
            asm volatile("s_waitcnt vmcnt(0)" ::: "memory");
            const unsigned og = xb_add(&bar[XB_TOP], 1u);
            const unsigned tg = og / nx;
            if (og + 1u == (tg + 1u) * nx) xb_add(&bar[XB_TOPGEN], 1u);
            else XB_SPIN(xb_ld(&bar[XB_TOPGEN]) == tg, bar);
            __builtin_amdgcn_fence(__ATOMIC_ACQUIRE, "agent");
            xb_add(&bar[XB_XGEN(b.x)], 1u);
            asm volatile("s_waitcnt vmcnt(0)" ::: "memory");
        } else {
            XB_SPIN(xb_ld(&bar[XB_XGEN(b.x)]) == gen, bar);
            __builtin_amdgcn_fence(__ATOMIC_ACQUIRE, "agent");
            asm volatile("s_waitcnt vmcnt(0)" ::: "memory");
        }
    }
    __syncthreads();
}

#ifndef PROBE_MASK
#define PROBE_MASK 0ull
#endif
#ifndef PROBE_AMP
#define PROBE_AMP 4
#endif
#ifndef MK_N_LAUNCHES
#define MK_N_LAUNCHES 1
#endif
__global__ void __launch_bounds__(NWAVES * 64, 2) mk_fwd(Args a) {
    extern __shared__ __attribute__((aligned(16))) unsigned char lds_raw[];
    Frame F;
    F.lds = (LAS unsigned char*)lds_raw;
    F.tid = threadIdx.x; F.lane = F.tid & 63; F.wave = __builtin_amdgcn_readfirstlane(F.tid >> 6); F.G = gridDim.x; F.bid = blockIdx.x;
    if (F.tid < 27) *(const float* LAS*)(F.lds + TBL_OFF + 8 * F.tid) = a.in[F.tid];
    if (F.tid == 27) *(float* LAS*)(F.lds + TBL_OFF + 8 * 27) = a.out;
    if (F.tid == 28) *(unsigned char* LAS*)(F.lds + TBL_OFF + 8 * 28) = a.ws;
    volatile LAS unsigned* MISC = (volatile LAS unsigned*)(F.lds + MISC_OFF);
    for (int u = F.tid; u < 64; u += NWAVES * 64) MISC[u] = 0u;
    __syncthreads();
    XcdBarrier bar; bar.bar = (unsigned*)(a.ws + WS_CTL) + CW_BAR; bar.x = 0; bar.st = nullptr;
    const int s_lo = (MK_N_LAUNCHES == 1) ? 0 : a.s_lo, s_hi = (MK_N_LAUNCHES == 1) ? NSTAGES : a.s_hi;
    if (s_hi - s_lo > 1) bar = xcd_barrier_post((unsigned*)(a.ws + WS_CTL) + CW_BAR, MISC + 8);
#if PROBE_MASK
    unsigned long long tacc = 0ull;
#endif
    for (int s = s_lo; s < s_hi; ++s) {
#if PROBE_MASK
        const unsigned long long t0 = __builtin_amdgcn_s_memrealtime();
#endif
        run_stage(F, s);
        if (s + 1 < s_hi) { XcdBarrier b2 = bar; asm volatile("" : "+s"(b2.bar));
            xcd_barrier(b2); }
#if PROBE_MASK
        if ((PROBE_MASK >> s) & 1ull) tacc += __builtin_amdgcn_s_memrealtime() - t0;
#endif
    }
#if PROBE_SEC
    if (threadIdx.x == 0) { const unsigned long long ts = *(LAS unsigned long long*)(F.lds + MISC_OFF + 64), t0 = __builtin_amdgcn_s_memrealtime(); while (__builtin_amdgcn_s_memrealtime() - t0 < (unsigned long long)PROBE_AMP * ts) __builtin_amdgcn_s_sleep(32); }
#endif
#if PROBE_MASK
    if (blockIdx.x == 0 && threadIdx.x == 0) { const unsigned long long t0 = __builtin_amdgcn_s_memrealtime(); while (__builtin_amdgcn_s_memrealtime() - t0 < (unsigned long long)PROBE_AMP * tacc) __builtin_amdgcn_s_sleep(32); }
#endif
}

extern "C" void kernel_launch(void* const* d_in, const int* in_sizes, int n_in, void* d_out, int out_size, void* d_ws, size_t ws_size, hipStream_t stream) {
    static int grid = 0;
    if (grid == 0) {
        if (n_in != 27 || in_sizes[0] != MTOK * DM || out_size != MTOK * DM || ws_size < WS_END) { fprintf(stderr, "kernel_launch: unexpected problem shape (n_in %d, in0 %d, out %d, ws %zu < %zu); nothing launched\n", n_in, n_in > 0 ? in_sizes[0] : -1, out_size, ws_size, (size_t)WS_END); grid = -1; return; }
        int dev = 0, cus = 0, per_cu = 0;
        if (hipGetDevice(&dev) != hipSuccess || hipDeviceGetAttribute(&cus, hipDeviceAttributeMultiprocessorCount, dev) != hipSuccess) { grid = -1; return; }
        if (hipFuncSetAttribute((const void*)mk_fwd, hipFuncAttributeMaxDynamicSharedMemorySize, LDS_BYTES) != hipSuccess) { fprintf(stderr, "kernel_launch: hipFuncSetAttribute failed\n"); grid = -1; return; }
        if (hipOccupancyMaxActiveBlocksPerMultiprocessor(&per_cu, (const void*)mk_fwd, NWAVES * 64, LDS_BYTES) != hipSuccess || per_cu < 1) { fprintf(stderr, "kernel_launch: occupancy query reports %d workgroups per CU\n", per_cu); }
        (void)hipGetLastError();
        grid = cus;
    }
    if (grid < 0) return;
    if (hipMemsetAsync((char*)d_ws + WS_CTL, 0, CTL_ZERO_BYTES, stream) != hipSuccess) return;
    Args a{};
    for (int i = 0; i < 27; ++i) a.in[i] = (const float*)d_in[i];
    a.out = (float*)d_out; a.ws = (unsigned char*)d_ws;
    if (MK_N_LAUNCHES == 1) { a.s_lo = 0; a.s_hi = NSTAGES; hipLaunchKernelGGL(mk_fwd, dim3(grid), dim3(NWAVES * 64), LDS_BYTES, stream, a); }
    else for (int s = 0; s < NSTAGES; ++s) { a.s_lo = s; a.s_hi = s + 1; hipLaunchKernelGGL(mk_fwd, dim3(grid), dim3(NWAVES * 64), LDS_BYTES, stream, a); }
}
#endif
```
